# Optimizing an MI355X kernel written in HIP

```python
import jax, jax.numpy as jnp
from jax import lax
import numpy as np

D_MODEL = 1024
BATCH = 4
SEQ = 4096
DEPTH = 4

ROPE_THETA = 500000.0
ROPE_DIM = 16
Q_BLOCK = 128
NORM_EPS = 1e-6

DSA_HEADS = 8
DSA_HEAD_DIM = 64
DSA_NOPE_DIM = DSA_HEAD_DIM - ROPE_DIM
DSA_KV_RANK = 128
DSA_V_DIM = 64
IDX_HEADS = 4
IDX_DIM = 64
INDEX_TOPK = 256

SB_HEADS = 8
SB_HEAD_DIM = 64

ML_HEADS = 4
ML_HEAD_DIM = 128
ML_CHUNK = 64
ML_CONV = 4

N_BRANCHES = 3
BRANCH_WIDTH = 512
DSA_Q_WIDTH = DSA_HEADS * DSA_HEAD_DIM
SB_WIDTH = SB_HEADS * SB_HEAD_DIM
ML_WIDTH = ML_HEADS * ML_HEAD_DIM

IN_WIDTHS = (
    DSA_Q_WIDTH,
    DSA_KV_RANK,
    ROPE_DIM,
    IDX_HEADS * IDX_DIM,
    IDX_DIM,
    IDX_HEADS,
    BRANCH_WIDTH,
    SB_WIDTH,
    SB_WIDTH,
    SB_WIDTH,
    BRANCH_WIDTH,
    2 * ML_WIDTH,
    ML_WIDTH,
    ML_HEADS,
    ML_HEADS,
    ML_WIDTH,
    BRANCH_WIDTH,
    N_BRANCHES * D_MODEL,
)
W_IN_COLS = sum(IN_WIDTHS)

kernel_name = 'hybrid_dsa_stickbreak_mlstm_trunk'


def rms_norm(x, w):
    x32 = x.astype(jnp.float32)
    y = x32 * lax.rsqrt(jnp.mean(x32 * x32, axis=-1, keepdims=True) + NORM_EPS)
    return (y * w.astype(jnp.float32)).astype(x.dtype)


def rope_tables(seq):
    pos = jnp.arange(seq, dtype=jnp.float32)
    inv = ROPE_THETA ** (-jnp.arange(0, ROPE_DIM, 2, dtype=jnp.float32) / ROPE_DIM)
    ang = pos[:, None] * inv[None, :]
    return jnp.cos(ang), jnp.sin(ang)


def partial_rope(x, cos, sin):
    half = ROPE_DIM // 2
    x1 = x[..., :half]
    x2 = x[..., half:ROPE_DIM]
    out = jnp.concatenate([x1 * cos - x2 * sin, x2 * cos + x1 * sin, x[..., ROPE_DIM:]], axis=-1)
    return out.astype(x.dtype)


def to_blocks(a):
    b, s = a.shape[:2]
    a = a.reshape((b, s // Q_BLOCK, Q_BLOCK) + a.shape[2:])
    return jnp.moveaxis(a, 1, 0)


def from_blocks(a):
    a = jnp.moveaxis(a, 0, 1)
    return a.reshape((a.shape[0], a.shape[1] * a.shape[2]) + a.shape[3:])


def dsa_attention(q, c_kv, k_rope, iq, ik, iw, w_uk, w_uv, kv_norm_w, cos, sin):
    bsz, seq = q.shape[:2]
    topk = min(INDEX_TOPK, seq // 4)
    c_kv = rms_norm(c_kv, kv_norm_w)
    q_rope = partial_rope(q[..., :ROPE_DIM], cos[:, None], sin[:, None])
    q_nope = q[..., ROPE_DIM:]
    k_rope = partial_rope(k_rope, cos, sin)
    iq = partial_rope(iq, cos[:, None], sin[:, None]).astype(jnp.float32)
    ik = partial_rope(ik, cos, sin).astype(jnp.float32)
    q_abs = jnp.einsum('bshn,rhn->bshr', q_nope, w_uk)
    q_cat = jnp.concatenate([q_abs, q_rope], axis=-1).astype(jnp.float32) * DSA_HEAD_DIM ** -0.5
    kv_cat = jnp.concatenate([c_kv, k_rope], axis=-1).astype(jnp.float32)
    key_pos = jnp.arange(seq)
    starts = jnp.arange(0, seq, Q_BLOCK)

    def block(args):
        qb, iqb, iwb, start = args
        q_pos = start + jnp.arange(Q_BLOCK)
        causal = key_pos[None, :] <= q_pos[:, None]
        score = jnp.einsum('bth,bths->bts', iwb,
                           jax.nn.relu(jnp.einsum('bthd,bsd->bths', iqb, ik)))
        score = jnp.where(causal[None], score, -jnp.inf)
        _, sel = lax.top_k(score, topk)
        kv_sel = jax.vmap(lambda kv, ix: kv[ix])(kv_cat, sel)
        valid = sel <= q_pos[None, :, None]
        logits = jnp.einsum('bthf,btkf->bthk', qb, kv_sel)
        logits = jnp.where(valid[:, :, None, :], logits, -jnp.inf)
        p = jax.nn.softmax(logits, axis=-1)
        return jnp.einsum('bthk,btkr->bthr', p, kv_sel[..., :DSA_KV_RANK])

    o_lat = from_blocks(lax.map(block, (to_blocks(q_cat), to_blocks(iq),
                                        to_blocks(iw.astype(jnp.float32)), starts)))
    o = jnp.einsum('bshr,rhv->bshv', o_lat, w_uv)
    return o.reshape(bsz, seq, DSA_HEADS * DSA_V_DIM)


def stick_breaking_attention(q, k, v):
    bsz, seq = q.shape[:2]
    qs = q.astype(jnp.float32) * SB_HEAD_DIM ** -0.5
    k32 = k.astype(jnp.float32)
    v32 = v.astype(jnp.float32)
    key_pos = jnp.arange(seq)
    starts = jnp.arange(0, seq, Q_BLOCK)

    def block(args):
        qb, start = args
        q_pos = start + jnp.arange(Q_BLOCK)
        strict = key_pos[None, :] < q_pos[:, None]
        z = jnp.einsum('bthd,bshd->bhts', qb, k32)
        log_stay = jnp.where(strict, jax.nn.log_sigmoid(-z), 0.0)
        log_after = lax.cumsum(log_stay, axis=3, reverse=True) - log_stay
        a = jnp.where(strict, jnp.exp(jax.nn.log_sigmoid(z) + log_after), 0.0)
        return jnp.einsum('bhts,bshd->bthd', a, v32)

    o = from_blocks(lax.map(block, (to_blocks(qs), starts)))
    return o.reshape(bsz, seq, SB_HEADS * SB_HEAD_DIM)


def causal_depthwise_conv(u, w):
    return lax.conv_general_dilated(u, w[:, None, :].astype(u.dtype), window_strides=(1,),
                                    padding=[(ML_CONV - 1, 0)],
                                    dimension_numbers=('NWC', 'WIO', 'NWC'),
                                    feature_group_count=u.shape[-1])


def mlstm_chunkwise(q, k, v, i_pre, f_pre):
    bsz, seq = q.shape[:2]
    nc = seq // ML_CHUNK

    def chunked(a):
        a = jnp.moveaxis(a.astype(jnp.float32), 2, 1)
        a = a.reshape((bsz, ML_HEADS, nc, ML_CHUNK) + a.shape[3:])
        return jnp.moveaxis(a, 2, 0)

    qc = chunked(q)
    kc = chunked(k.astype(jnp.float32) * ML_HEAD_DIM ** -0.5)
    vc = chunked(v)
    ic = chunked(i_pre)
    lfc = chunked(jax.nn.log_sigmoid(f_pre.astype(jnp.float32)))
    tril = jnp.tril(jnp.ones((ML_CHUNK, ML_CHUNK), dtype=bool))

    def step(carry, inp):
        c_mem, n_mem, m_prev = carry
        qb, kb, vb, ib, lfb = inp
        b = jnp.cumsum(lfb, axis=-1)
        log_d = jnp.where(tril, b[..., :, None] - b[..., None, :] + ib[..., None, :], -jnp.inf)
        log_inter = b + m_prev[..., None]
        m_row = jnp.maximum(jnp.max(log_d, axis=-1), log_inter)
        w_intra = jnp.exp(log_d - m_row[..., None])
        w_inter = jnp.exp(log_inter - m_row)
        s = jnp.einsum('bhtd,bhsd->bhts', qb, kb) * w_intra
        num = (jnp.einsum('bhts,bhse->bhte', s, vb)
               + w_inter[..., None] * jnp.einsum('bhtd,bhde->bhte', qb, c_mem))
        den = jnp.sum(s, axis=-1) + w_inter * jnp.einsum('bhtd,bhd->bht', qb, n_mem)
        h = num / jnp.maximum(jnp.abs(den), jnp.exp(-m_row))[..., None]
        b_last = b[..., -1]
        log_w = b_last[..., None] - b + ib
        m_new = jnp.maximum(b_last + m_prev, jnp.max(log_w, axis=-1))
        w_upd = jnp.exp(log_w - m_new[..., None])
        decay = jnp.exp(b_last + m_prev - m_new)
        c_mem = decay[..., None, None] * c_mem + jnp.einsum('bhs,bhsd,bhse->bhde', w_upd, kb, vb)
        n_mem = decay[..., None] * n_mem + jnp.einsum('bhs,bhsd->bhd', w_upd, kb)
        return (c_mem, n_mem, m_new), h

    init = (jnp.zeros((bsz, ML_HEADS, ML_HEAD_DIM, ML_HEAD_DIM), jnp.float32),
            jnp.zeros((bsz, ML_HEADS, ML_HEAD_DIM), jnp.float32),
            jnp.zeros((bsz, ML_HEADS), jnp.float32))
    _, h = lax.scan(step, init, (qc, kc, vc, ic, lfc))
    h = jnp.moveaxis(h, 0, 2).reshape(bsz, ML_HEADS, seq, ML_HEAD_DIM)
    return jnp.moveaxis(h, 1, 2)


def head_layer_norm(h, w):
    h = h.astype(jnp.float32)
    mu = jnp.mean(h, axis=-1, keepdims=True)
    var = jnp.mean(jnp.square(h - mu), axis=-1, keepdims=True)
    y = (h - mu) * lax.rsqrt(var + NORM_EPS)
    return y.reshape(h.shape[0], h.shape[1], -1) * w.astype(jnp.float32)


def hybrid_layer(x, w_in, w_uk, w_uv, kv_norm_w, conv_w, i_bias, f_bias, ml_norm_w,
                 w_branch, w_out, norm_w, cos, sin):
    bsz, seq, _ = x.shape
    h = rms_norm(x, norm_w)
    p = h @ w_in
    splits = [int(c) for c in np.cumsum(IN_WIDTHS)[:-1]]
    (dsa_q, dsa_ckv, dsa_krope, idx_q, idx_k, idx_w, dsa_z,
     sb_q, sb_k, sb_v, sb_z,
     ml_qk, ml_v, ml_i, ml_f, ml_o, ml_z, merge) = jnp.split(p, splits, axis=-1)

    def heads(a, n):
        return a.reshape(bsz, seq, n, -1)

    y_a = dsa_attention(heads(dsa_q, DSA_HEADS), dsa_ckv, dsa_krope, heads(idx_q, IDX_HEADS),
                        idx_k, idx_w, w_uk, w_uv, kv_norm_w, cos, sin)
    y_b = stick_breaking_attention(heads(sb_q, SB_HEADS), heads(sb_k, SB_HEADS), heads(sb_v, SB_HEADS))
    ml_q, ml_k = jnp.split(jax.nn.silu(causal_depthwise_conv(ml_qk, conv_w)), 2, axis=-1)
    h_c = mlstm_chunkwise(heads(ml_q, ML_HEADS), heads(ml_k, ML_HEADS), heads(ml_v, ML_HEADS),
                          ml_i + i_bias, ml_f + f_bias)
    y_c = head_layer_norm(h_c, ml_norm_w) * jax.nn.sigmoid(ml_o.astype(jnp.float32))

    branches = jnp.stack([y_a * jax.nn.silu(dsa_z), y_b * jax.nn.silu(sb_z),
                          y_c * jax.nn.silu(ml_z)], axis=2)
    proj = jnp.einsum('bsgc,gcd->bsgd', branches, w_branch)
    gates = jax.nn.sigmoid(merge.reshape(bsz, seq, N_BRANCHES, D_MODEL).astype(jnp.float32))
    mixed = jnp.sum(gates * proj, axis=2)
    return x + (mixed @ w_out).astype(x.dtype)


def setup_inputs(seed: int = 0) -> dict:
    key = jax.random.key(seed)
    ks = jax.random.split(key, 13)

    def nrm(k, shape, fan_in):
        return jax.random.normal(k, shape, jnp.float32) * fan_in ** -0.5

    x = jax.random.normal(ks[0], (BATCH, SEQ, D_MODEL), jnp.float32)
    w_in = nrm(ks[1], (DEPTH, D_MODEL, W_IN_COLS), D_MODEL)
    w_dsa_uk = nrm(ks[2], (DEPTH, DSA_KV_RANK, DSA_HEADS, DSA_NOPE_DIM), DSA_KV_RANK)
    w_dsa_uv = nrm(ks[3], (DEPTH, DSA_KV_RANK, DSA_HEADS, DSA_V_DIM), DSA_KV_RANK)
    dsa_kv_norm_w = 1.0 + 0.02 * jax.random.normal(ks[4], (DEPTH, DSA_KV_RANK), jnp.float32)
    ml_conv_w = nrm(ks[5], (DEPTH, ML_CONV, 2 * ML_WIDTH), ML_CONV)
    ml_i_bias = 0.1 * jax.random.normal(ks[6], (DEPTH, ML_HEADS), jnp.float32)
    ml_f_bias = (jnp.linspace(3.0, 6.0, ML_HEADS, dtype=jnp.float32)[None, :]
                 + 0.1 * jax.random.normal(ks[7], (DEPTH, ML_HEADS), jnp.float32))
    ml_norm_w = 1.0 + 0.02 * jax.random.normal(ks[8], (DEPTH, ML_WIDTH), jnp.float32)
    w_branch = nrm(ks[9], (DEPTH, N_BRANCHES, BRANCH_WIDTH, D_MODEL), BRANCH_WIDTH)
    w_out = nrm(ks[10], (DEPTH, D_MODEL, D_MODEL), D_MODEL)
    norm_w = 1.0 + 0.02 * jax.random.normal(ks[11], (DEPTH, D_MODEL), jnp.float32)
    final_norm_w = 1.0 + 0.02 * jax.random.normal(ks[12], (D_MODEL,), jnp.float32)
    return {'x': x, 'w_in': w_in, 'w_dsa_uk': w_dsa_uk, 'w_dsa_uv': w_dsa_uv,
            'dsa_kv_norm_w': dsa_kv_norm_w, 'ml_conv_w': ml_conv_w, 'ml_i_bias': ml_i_bias,
            'ml_f_bias': ml_f_bias, 'ml_norm_w': ml_norm_w, 'w_branch': w_branch,
            'w_out': w_out, 'norm_w': norm_w, 'final_norm_w': final_norm_w}


def reference(x, w_in, w_dsa_uk, w_dsa_uv, dsa_kv_norm_w, ml_conv_w, ml_i_bias, ml_f_bias,
              ml_norm_w, w_branch, w_out, norm_w, final_norm_w):
    cos, sin = rope_tables(x.shape[1])
    for l in range(DEPTH):
        x = hybrid_layer(x, w_in[l], w_dsa_uk[l], w_dsa_uv[l], dsa_kv_norm_w[l], ml_conv_w[l],
                         ml_i_bias[l], ml_f_bias[l], ml_norm_w[l], w_branch[l], w_out[l],
                         norm_w[l], cos, sin)
    return rms_norm(x, final_norm_w)
```

```cpp
#include <hip/hip_runtime.h>
#include <cstdio>
#include <cstdint>

#define LAS __attribute__((address_space(3)))
__device__ __forceinline__ unsigned opaque0() { unsigned z = 0; asm volatile("" : "+s"(z)); return z; }
#define LAUNDER_S(p) ((p) += opaque0())
typedef _Float16 f16;
typedef _Float16 f16x8 __attribute__((ext_vector_type(8)));
typedef _Float16 f16x4 __attribute__((ext_vector_type(4)));
typedef _Float16 f16x2 __attribute__((ext_vector_type(2)));
typedef float f32x4 __attribute__((ext_vector_type(4)));
typedef float f32x2 __attribute__((ext_vector_type(2)));
typedef float f32x16 __attribute__((ext_vector_type(16)));
typedef unsigned u32x4 __attribute__((ext_vector_type(4)));
typedef unsigned u32x2 __attribute__((ext_vector_type(2)));

constexpr int DM = 1024, NB = 4, SEQ = 4096, DEPTH = 4, MTOK = NB * SEQ;
constexpr int WIN_COLS = 9180;
constexpr int NA = 6144;
constexpr int NG = 3072;
constexpr float NORM_EPS = 1e-6f;
constexpr int C_DQ = 0, C_CKV = 512, C_KR = 640, C_IQ = 656, C_IK = 912, C_IW = 976, C_MI = 980, C_MF = 984;
constexpr int C_DZ = 1024, C_SQ = 1536, C_SK = 2048, C_SV = 2560, C_SZ = 3072, C_MQK = 3584, C_MV = 4608, C_MO = 5120, C_MZ = 5632;

#define XB_TMO      128
#define XB_XCNT(j)  (256  + 64 * (j))
#define XB_XSUB(j)  (1280 + 64 * (j))
#define XB_XGEN(j)  (2304 + 64 * (j))
#define XB_TOP      3328
#define XB_TOPGEN   3392
#define XCD_BAR_WORDS 3456
#define XB_SPIN_CAP (1u << 18)

__device__ __forceinline__ unsigned xb_ld(unsigned* p)              { return __hip_atomic_load(p, __ATOMIC_RELAXED, __HIP_MEMORY_SCOPE_AGENT); }
__device__ __forceinline__ unsigned xb_add(unsigned* p, unsigned v) { return __hip_atomic_fetch_add(p, v, __ATOMIC_RELAXED, __HIP_MEMORY_SCOPE_AGENT); }
__device__ __forceinline__ unsigned xb_xcc_id() { return (unsigned)__builtin_amdgcn_s_getreg((3 << 11) | 20) & 0xFu; }
#define XB_SPIN(cond, bar) do { unsigned _sp = 0; while (cond) { __builtin_amdgcn_s_sleep(1); \
    if ((++_sp & 255u) == 0u) { if (xb_ld(&(bar)[XB_TMO])) break; if (_sp > XB_SPIN_CAP) { atomicAdd(&(bar)[XB_TMO], 1u); break; } } } } while (0)

struct XcdBarrier { unsigned* bar; unsigned x; volatile LAS unsigned* st; };

__device__ __forceinline__ XcdBarrier xcd_barrier_post(unsigned* bar, volatile LAS unsigned* st) {
    XcdBarrier b; b.bar = bar; b.x = xb_xcc_id(); b.st = st;
    if (threadIdx.x == 0) (void)xb_add(&bar[XB_XCNT(b.x)], 1u);
    return b;
}
__device__ __forceinline__ void xcd_barrier_complete(unsigned* bar, unsigned x, unsigned& nloc, unsigned& nx) {
    const unsigned G = gridDim.x * gridDim.y * gridDim.z;
    unsigned sum, cnt, mine, sp = 0u;
    for (;;) {
        sum = 0u; cnt = 0u; mine = 0u;
#pragma unroll
        for (unsigned j = 0; j < 16; ++j) { const unsigned c = xb_ld(&bar[XB_XCNT(j)]); sum += c; cnt += (c > 0u) ? 1u : 0u; mine = (j == x) ? c : mine; }
        if (sum == G) break;
        __builtin_amdgcn_s_sleep(1);
        if ((++sp & 255u) == 0u) { if (xb_ld(&bar[XB_TMO])) break; if (sp > XB_SPIN_CAP) { atomicAdd(&bar[XB_TMO], 1u); break; } }
    }
    nloc = mine > 0u ? mine : 1u; nx = cnt > 0u ? cnt : 1u;
}
__device__ __forceinline__ void xcd_barrier(const XcdBarrier& b) {
    asm volatile("s_waitcnt vmcnt(0)" ::: "memory");
    __syncthreads();
    if (threadIdx.x == 0) {
        unsigned* bar = b.bar; LAUNDER_S(bar); const unsigned bx = b.x + opaque0();
        __builtin_amdgcn_s_waitcnt(0);
        unsigned nloc = b.st[0], nx = b.st[1];
        if (nloc == 0u) { xcd_barrier_complete(bar, bx, nloc, nx); b.st[0] = nloc; b.st[1] = nx; }
        const unsigned old = xb_add(&bar[XB_XSUB(bx)], 1u);
        const unsigned gen = old / nloc;
        if (old + 1u == (gen + 1u) * nloc) {
            __builtin_amdgcn_fence(__ATOMIC_RELEASE, "agent");
            asm volatile("s_waitcnt vmcnt(0)" ::: "memory");
            const unsigned og = xb_add(&bar[XB_TOP], 1u);
            const unsigned tg = og / nx;
            if (og + 1u == (tg + 1u) * nx) xb_add(&bar[XB_TOPGEN], 1u);
            else XB_SPIN(xb_ld(&bar[XB_TOPGEN]) == tg, bar);
            __builtin_amdgcn_fence(__ATOMIC_ACQUIRE, "agent");
            xb_add(&bar[XB_XGEN(bx)], 1u);
            asm volatile("s_waitcnt vmcnt(0)" ::: "memory");
        } else {
            XB_SPIN(xb_ld(&bar[XB_XGEN(bx)]) == gen, bar);
            __builtin_amdgcn_fence(__ATOMIC_ACQUIRE, "agent");
            asm volatile("s_waitcnt vmcnt(0)" ::: "memory");
        }
    }
    __syncthreads();
}

__device__ __forceinline__ float fast_exp(float x) { return __builtin_amdgcn_exp2f(x * 1.44269504088896340736f); }
__device__ __forceinline__ float fast_rcp(float x) { return __builtin_amdgcn_rcpf(x); }
__device__ __forceinline__ float sigmoidf_(float x) { return fast_rcp(1.0f + fast_exp(-x)); }
__device__ __forceinline__ float siluf_(float x) { return x * sigmoidf_(x); }
__device__ __forceinline__ float logsigmoidf_(float x) {
    return fminf(x, 0.0f) - log1pf(__expf(-fabsf(x)));
}

namespace pg8 {
constexpr int BM = 256, BK = 64, HALF = 128, HTB = HALF * BK * 2, STAGE_BYTES = 8 * HTB, NXCD = 8, WGM = 8;
__host__ __device__ __forceinline__ int lds_byte(int r, int c) { const int st = (r >> 4) * 2 + (c >> 5), rr = r & 15, cc = c & 31, ob = rr * 64 + cc * 2; return st * 1024 + (ob ^ (((ob >> 9) & 1) << 5)); }
__host__ __device__ __forceinline__ void stage_rc(int b, int& R, int& C) { const int st = b / 1024, sb = b % 1024, swz = sb ^ (((sb >> 9) & 1) << 5); R = (st >> 1) * 16 + swz / 64; C = (st & 1) * 32 + (swz % 64) / 2; }
__host__ __device__ __forceinline__ int perm32(int rho) { const int n = rho >> 4, i = rho & 15; return 8 * (i >> 2) + 4 * n + (i & 3); }

struct Unit { int pm, pn; };
struct Gemm { const f16* A; const f16* Bt; int M, N, K, lda, ldb; };

struct StaticOrder {
    int nM, nN, nwg, G, c;
    __host__ __device__ void init(int M, int N, int G_, int c_) { nM = M / BM; nN = N / BM; nwg = nM * nN; G = G_; c = c_; }
    __host__ __device__ bool next(int i, Unit& u) const {
        const long L = (long)i * G + c; if (L >= nwg) return false;
        int wgid = (int)L; { const int q = nwg / NXCD, r = nwg % NXCD, xcd = wgid % NXCD, off = wgid / NXCD; wgid = (xcd < r ? xcd * (q + 1) : r * (q + 1) + (xcd - r) * q) + off; }
        const int nig = WGM * nN, gid = wgid / nig, fm = gid * WGM, gsz = (nM - fm) < WGM ? (nM - fm) : WGM;
        u.pm = fm + ((wgid % nig) % gsz); u.pn = (wgid % nig) / gsz; return true;
    }
};

template <class Epi>
__device__ __forceinline__ void gemm_phase(LAS unsigned char* lds, const Gemm g, const StaticOrder& S, const Epi& E) {
    int tid = threadIdx.x; asm volatile("" : "+v"(tid));
    const int wid = __builtin_amdgcn_readfirstlane(tid >> 6), lane = tid & 63, wr = wid >> 2, wc = wid & 3, fr = lane & 15, fq = lane >> 4;
    const int K = g.K, nt = K / BK;
    unsigned voffA[2], voffB[2];
#pragma unroll
    for (int i = 0; i < 2; ++i) { int R, C; stage_rc(tid * 16 + i * 8192, R, C); const int Rb = (R & ~31) + perm32(R & 31);
        voffA[i] = (unsigned)(R * g.lda + C) * 2u; voffB[i] = (unsigned)(Rb * g.ldb + C) * 2u; }
    const size_t kstep = (size_t)(BK * 2);
    const size_t hstepA = (size_t)HALF * g.lda * 2, hstepB = (size_t)HALF * g.ldb * 2;
    const size_t tstepA = 2 * hstepA, tstepB = 2 * hstepB;
    const unsigned ldsw = (unsigned)wid * 1024u;
    const int aoff = lds_byte(wr * 64 + fr, fq * 8), boff = lds_byte(wc * 32 + fr, fq * 8);
#define PG8_SA(b, h) (((b) * 2 + (h)) * HTB)
#define PG8_SB(b, h) ((4 + (b) * 2 + (h)) * HTB)
#define PG8_STAGE(bufoff, gbase, voff) do { _Pragma("unroll") for (int _i = 0; _i < 2; ++_i) \
        __builtin_amdgcn_global_load_lds((const unsigned*)((const char*)(gbase) + (voff)[_i]), (LAS unsigned*)(lds + (bufoff) + ldsw + _i * 8192), 16, 0, 0); } while (0)
#define PG8_LDA(dst, b, h) do { _Pragma("unroll") for (int m = 0; m < 4; ++m) _Pragma("unroll") for (int k = 0; k < 2; ++k) dst[m][k] = *(const LAS f16x8*)(lds + PG8_SA(b, h) + aoff + m * 2048 + k * 1024); } while (0)
#define PG8_LDB(dst, b, h) do { _Pragma("unroll") for (int n = 0; n < 2; ++n) _Pragma("unroll") for (int k = 0; k < 2; ++k) dst[n][k] = *(const LAS f16x8*)(lds + PG8_SB(b, h) + boff + n * 2048 + k * 1024); } while (0)
#define PG8_MMA(ai, bj, At, Bt) do { __builtin_amdgcn_s_setprio(1); _Pragma("unroll") for (int m = 0; m < 4; ++m) _Pragma("unroll") for (int n = 0; n < 2; ++n) _Pragma("unroll") for (int k = 0; k < 2; ++k) \
        acc[ai][bj][m][n] = __builtin_amdgcn_mfma_f32_16x16x32_f16(Bt[n][k], At[m][k], acc[ai][bj][m][n], 0, 0, 0); __builtin_amdgcn_s_setprio(0); } while (0)
#define PG8_WAIT_V(n) asm volatile("s_waitcnt vmcnt(" #n ")" ::: "memory")
#define PG8_WAIT_L(n) asm volatile("s_waitcnt lgkmcnt(" #n ")" ::: "memory")
#define PG8_BAR __builtin_amdgcn_s_barrier()
#define PG8_SCHED __builtin_amdgcn_sched_barrier(0)
    Unit cur, nxt; int ui = 0;
    if (!S.next(0, cur)) return;
    f32x4 acc[2][2][4][2];
#pragma unroll
    for (int a = 0; a < 2; ++a)
#pragma unroll
        for (int b = 0; b < 2; ++b)
#pragma unroll
            for (int m = 0; m < 4; ++m)
#pragma unroll
                for (int n = 0; n < 2; ++n) acc[a][b][m][n] = (f32x4){0.f, 0.f, 0.f, 0.f};
    f16x8 At[4][2], B0[2][2], B1[2][2];
    const char* cA = (const char*)g.A + (size_t)cur.pm * tstepA; const char* cB = (const char*)g.Bt + (size_t)cur.pn * tstepB;
    PG8_STAGE(PG8_SB(0, 0), cB, voffB); PG8_STAGE(PG8_SA(0, 0), cA, voffA); PG8_STAGE(PG8_SB(0, 1), cB + hstepB, voffB); PG8_STAGE(PG8_SA(0, 1), cA + hstepA, voffA);
    if (wr == 1) PG8_BAR;
    PG8_WAIT_V(4); PG8_BAR;
    PG8_STAGE(PG8_SB(1, 0), cB + kstep, voffB); PG8_STAGE(PG8_SA(1, 0), cA + kstep, voffA); PG8_STAGE(PG8_SB(1, 1), cB + hstepB + kstep, voffB);
    PG8_WAIT_V(6); PG8_BAR;
    for (;;) {
        const bool has_next = S.next(ui + 1, nxt);
        const char* nA = has_next ? (const char*)g.A + (size_t)nxt.pm * tstepA : cA; const char* nB = has_next ? (const char*)g.Bt + (size_t)nxt.pn * tstepB : cB;
        for (int t = 0; t < nt; t += 2) {
            const bool last = (t == nt - 2);
            const char* a1 = cA + (size_t)(t + 1) * kstep;
            const char* a2 = last ? nA : cA + (size_t)(t + 2) * kstep; const char* b2 = last ? nB : cB + (size_t)(t + 2) * kstep;
            const char* a3 = a2 + kstep; const char* b3 = b2 + kstep;
            PG8_LDB(B0, 0, 0); PG8_SCHED; PG8_LDA(At, 0, 0); PG8_STAGE(PG8_SA(1, 1), a1 + hstepA, voffA);
            PG8_WAIT_L(8); PG8_BAR; PG8_WAIT_L(0); PG8_MMA(0, 0, At, B0); PG8_BAR; PG8_SCHED;
            PG8_LDB(B1, 0, 1); PG8_STAGE(PG8_SB(0, 0), b2, voffB);
            PG8_BAR; PG8_WAIT_L(0); PG8_MMA(0, 1, At, B1); PG8_BAR;
            PG8_LDA(At, 0, 1); PG8_STAGE(PG8_SA(0, 0), a2, voffA);
            PG8_BAR; PG8_WAIT_L(0); PG8_MMA(1, 0, At, B0); PG8_BAR; PG8_SCHED;
            PG8_STAGE(PG8_SB(0, 1), b2 + hstepB, voffB);
            PG8_WAIT_V(6); PG8_BAR; PG8_MMA(1, 1, At, B1); PG8_BAR;
            PG8_LDB(B0, 1, 0); PG8_SCHED; PG8_LDA(At, 1, 0); PG8_STAGE(PG8_SA(0, 1), a2 + hstepA, voffA);
            PG8_WAIT_L(8); PG8_BAR; PG8_WAIT_L(0); PG8_MMA(0, 0, At, B0); PG8_BAR; PG8_SCHED;
            PG8_LDB(B1, 1, 1); PG8_STAGE(PG8_SB(1, 0), b3, voffB);
            PG8_BAR; PG8_WAIT_L(0); PG8_MMA(0, 1, At, B1); PG8_BAR;
            PG8_LDA(At, 1, 1); PG8_STAGE(PG8_SA(1, 0), a3, voffA);
            PG8_BAR; PG8_WAIT_L(0); PG8_MMA(1, 0, At, B0); PG8_BAR; PG8_SCHED;
            PG8_STAGE(PG8_SB(1, 1), b3 + hstepB, voffB);
            PG8_WAIT_V(6); PG8_BAR; PG8_MMA(1, 1, At, B1); PG8_BAR;
        }
        E(acc, cur, wr, wc, fr, fq);
        if (!has_next) break;
#pragma unroll
        for (int a = 0; a < 2; ++a)
#pragma unroll
            for (int b = 0; b < 2; ++b)
#pragma unroll
                for (int m = 0; m < 4; ++m)
#pragma unroll
                    for (int n = 0; n < 2; ++n) acc[a][b][m][n] = (f32x4){0.f, 0.f, 0.f, 0.f};
        cur = nxt; cA = nA; cB = nB; ++ui;
    }
    PG8_WAIT_V(0);
    if (wr == 0) PG8_BAR;
    PG8_BAR;
#undef PG8_SA
#undef PG8_SB
#undef PG8_STAGE
#undef PG8_LDA
#undef PG8_LDB
#undef PG8_MMA
#undef PG8_WAIT_V
#undef PG8_WAIT_L
#undef PG8_BAR
#undef PG8_SCHED
}

__device__ __forceinline__ unsigned pk_f16(float a, float b) { f16x2 v; v.x = (f16)a; v.y = (f16)b; return __builtin_bit_cast(unsigned, v); }
__device__ __forceinline__ float row_rstd(const float* ss, int row) {
    const f32x4* p = (const f32x4*)(ss + (size_t)row * 16);
    const f32x4 a = p[0], b = p[1], c = p[2], d = p[3];
    const float s = ((a[0] + a[1]) + (a[2] + a[3])) + ((b[0] + b[1]) + (b[2] + b[3])) + ((c[0] + c[1]) + (c[2] + c[3])) + ((d[0] + d[1]) + (d[2] + d[3]));
    return 1.0f / sqrtf(s * (1.0f / DM) + NORM_EPS);
}

struct EpiScaleF16 {
    f16* O; int ldc; const float* ss;
    __device__ __forceinline__ void operator()(const f32x4 (&acc)[2][2][4][2], const Unit& u, int wr, int wc, int fr, int fq) const {
        const int row0 = u.pm * BM + wr * 64 + fr, col0 = u.pn * BM + wc * 32 + 8 * fq;
#pragma unroll
        for (int ai = 0; ai < 2; ++ai)
#pragma unroll
            for (int m = 0; m < 4; ++m) { const int row = row0 + ai * HALF + m * 16; const float rs = row_rstd(ss, row); f16* rowp = O + (size_t)row * ldc + col0;
#pragma unroll
                for (int bj = 0; bj < 2; ++bj) { const f32x4 v0 = acc[ai][bj][m][0] * rs, v1 = acc[ai][bj][m][1] * rs;
                    u32x4 w; w.x = pk_f16(v0[0], v0[1]); w.y = pk_f16(v0[2], v0[3]); w.z = pk_f16(v1[0], v1[1]); w.w = pk_f16(v1[2], v1[3]);
                    *(u32x4*)(rowp + bj * HALF) = w; } }
    }
};
template <int MODE> struct EpiGate {
    const f16* gate; int ldg; float* mix32; f16* mix16;
    __device__ __forceinline__ void operator()(const f32x4 (&acc)[2][2][4][2], const Unit& u, int wr, int wc, int fr, int fq) const {
        const int row0 = u.pm * BM + wr * 64 + fr, col0 = u.pn * BM + wc * 32 + 8 * fq;
#pragma unroll
        for (int ai = 0; ai < 2; ++ai)
#pragma unroll
            for (int m = 0; m < 4; ++m) { const int row = row0 + ai * HALF + m * 16;
#pragma unroll
                for (int bj = 0; bj < 2; ++bj) { const int col = col0 + bj * HALF;
                    const f16x8 gv = *(const f16x8*)(gate + (size_t)row * ldg + col);
                    f32x4 v0 = acc[ai][bj][m][0], v1 = acc[ai][bj][m][1];
#pragma unroll
                    for (int j = 0; j < 4; ++j) { v0[j] *= sigmoidf_((float)gv[j]); v1[j] *= sigmoidf_((float)gv[4 + j]); }
                    float* mp = mix32 + (size_t)row * DM + col;
                    if (MODE >= 1) { v0 += *(const f32x4*)mp; v1 += *(const f32x4*)(mp + 4); }
                    if (MODE <= 1) { *(f32x4*)mp = v0; *(f32x4*)(mp + 4) = v1; }
                    else { u32x4 w; w.x = pk_f16(v0[0], v0[1]); w.y = pk_f16(v0[2], v0[3]); w.z = pk_f16(v1[0], v1[1]); w.w = pk_f16(v1[2], v1[3]);
                        *(u32x4*)(mix16 + (size_t)row * DM + col) = w; } } }
    }
};
struct EpiResid {
    const float* xin; float* xout; f16* x16; float* ss;
    __device__ __forceinline__ void operator()(const f32x4 (&acc)[2][2][4][2], const Unit& u, int wr, int wc, int fr, int fq) const {
        const int row0 = u.pm * BM + wr * 64 + fr, col0 = u.pn * BM + wc * 32 + 8 * fq;
#pragma unroll
        for (int ai = 0; ai < 2; ++ai)
#pragma unroll
            for (int m = 0; m < 4; ++m) { const int row = row0 + ai * HALF + m * 16; float sq = 0.f;
#pragma unroll
                for (int bj = 0; bj < 2; ++bj) { const size_t off = (size_t)row * DM + col0 + bj * HALF;
                    const f32x4 v0 = acc[ai][bj][m][0] + *(const f32x4*)(xin + off), v1 = acc[ai][bj][m][1] + *(const f32x4*)(xin + off + 4);
                    *(f32x4*)(xout + off) = v0; *(f32x4*)(xout + off + 4) = v1;
                    u32x4 w; w.x = pk_f16(v0[0], v0[1]); w.y = pk_f16(v0[2], v0[3]); w.z = pk_f16(v1[0], v1[1]); w.w = pk_f16(v1[2], v1[3]);
                    *(u32x4*)(x16 + off) = w;
                    sq += (v0[0] * v0[0] + v0[1] * v0[1]) + (v0[2] * v0[2] + v0[3] * v0[3]) + (v1[0] * v1[0] + v1[1] * v1[1]) + (v1[2] * v1[2] + v1[3] * v1[3]); }
                sq += __shfl_xor(sq, 16); sq += __shfl_xor(sq, 32);
                if (fq == 0) ss[(size_t)row * 16 + u.pn * 4 + wc] = sq; }
    }
};
}

constexpr size_t WS_CTL   = 0;
constexpr size_t CTL_BYTES = 65536;
constexpr size_t WS_WINT  = WS_CTL + CTL_BYTES;
constexpr size_t WS_WBRT  = WS_WINT + (size_t)DEPTH * 9216 * 1024 * 2;
constexpr size_t WS_WOUTT = WS_WBRT + (size_t)DEPTH * 3 * 1024 * 512 * 2;
constexpr size_t WS_WUK   = WS_WOUTT + (size_t)DEPTH * 1024 * 1024 * 2;
constexpr size_t WS_WUV   = WS_WUK + (size_t)DEPTH * 8 * 128 * 64 * 2;
constexpr size_t WS_ROPE  = WS_WUV + (size_t)DEPTH * 8 * 64 * 128 * 2;
constexpr size_t WS_X16   = WS_ROPE + (size_t)SEQ * 16 * 4;
constexpr size_t WS_SS    = WS_X16 + (size_t)MTOK * DM * 2;
constexpr size_t WS_P16   = WS_SS + (size_t)MTOK * 16 * 4;
constexpr size_t WS_G16   = WS_P16;
constexpr size_t WS_MIX32 = WS_P16 + (size_t)MTOK * NG * 2;
constexpr size_t WS_MIX16 = WS_MIX32 + (size_t)MTOK * DM * 4;
constexpr size_t WS_QC    = WS_P16 + (size_t)MTOK * NA * 2;
constexpr size_t WS_KV    = WS_QC + (size_t)MTOK * 8 * 160 * 2;
constexpr size_t WS_IQ    = WS_KV + (size_t)MTOK * 160 * 2;
constexpr size_t WS_IK    = WS_IQ + (size_t)MTOK * 256 * 2;
constexpr size_t WS_IW    = WS_IK + (size_t)MTOK * 64 * 2;
constexpr size_t WS_MLQ   = WS_IW + (size_t)MTOK * 4 * 4;
constexpr size_t WS_MLK   = WS_MLQ + (size_t)MTOK * 512 * 2;
constexpr size_t WS_VT    = WS_MLK + (size_t)MTOK * 512 * 2;
constexpr size_t WS_MLVT  = WS_VT + (size_t)MTOK * 512 * 2;
constexpr size_t WS_GATE  = WS_MLVT + (size_t)MTOK * 512 * 2;
constexpr size_t WS_CHS   = WS_GATE + (size_t)MTOK * 8 * 4;
constexpr size_t WS_DN    = WS_CHS + (size_t)16 * 64 * 4 * 4;
constexpr size_t WS_Y3    = WS_DN + (size_t)16 * 64 * 128 * 4;
constexpr size_t WS_DCT   = WS_Y3 + (size_t)MTOK * 1536 * 2;
constexpr size_t WS_END   = WS_DCT + (size_t)16 * 64 * 16384 * 2;

constexpr int LDS_STAGE = 131072;
constexpr int LDS_BYTES = 147456;
constexpr int LDS_MISC  = LDS_STAGE;
constexpr int NTHREADS = 512;

struct Args {
    const float* x; const float* w_in; const float* w_uk; const float* w_uv; const float* kvn_w; const float* conv_w; const float* i_bias; const float* f_bias;
    const float* mln_w; const float* w_branch; const float* w_out; const float* norm_w; const float* fnorm_w;
    float* out; unsigned char* ws;
};

__device__ __forceinline__ int win_src_col(int n) {
    if (n < 980) return n;
    if (n < 984) return 5076 + (n - 980);
    if (n < 988) return 5080 + (n - 984);
    if (n < 1024) return -1;
    if (n < 1536) return 980 + (n - 1024);
    if (n < 3584) return 1492 + (n - 1536);
    if (n < 4608) return 3540 + (n - 3584);
    if (n < 5120) return 4564 + (n - 4608);
    if (n < 5632) return 5084 + (n - 5120);
    if (n < 6144) return 5596 + (n - 5632);
    return 6108 + (n - 6144);
}

template <bool WINMAP>
__device__ __forceinline__ void conv_tile(LAS float* t, const float* src, int src_ld, int k0, int n0, f16* dst, int dst_ld, const float* scale) {
    int tid = threadIdx.x; asm volatile("" : "+v"(tid)); const int c = tid & 63, r0 = tid >> 6;
    const int sc = WINMAP ? win_src_col(n0 + c) : (n0 + c);
#pragma unroll
    for (int i = 0; i < 8; ++i) { const int r = r0 + 8 * i; float v = sc >= 0 ? src[(size_t)(k0 + r) * src_ld + sc] : 0.f; if (scale) v *= scale[k0 + r]; t[r * 65 + c] = v; }
    __syncthreads();
#pragma unroll
    for (int i = 0; i < 8; ++i) { const int n = r0 + 8 * i; dst[(size_t)(n0 + n) * dst_ld + k0 + c] = (f16)t[c * 65 + n]; }
    __syncthreads();
}

__device__ __forceinline__ void p0_prologue(const Args& a, LAS unsigned char* lds) {
    LAS float* t = (LAS float*)lds;
    unsigned char* ws = a.ws; LAUNDER_S(ws);
    const int G = gridDim.x, bid = blockIdx.x; int tid = threadIdx.x; asm volatile("" : "+v"(tid));
    constexpr int T_WIN = DEPTH * 16 * 144, T_WBR = DEPTH * 3 * 8 * 16, T_WOUT = DEPTH * 16 * 16, T_WUV = DEPTH * 2 * 8;
    for (int u = bid; u < T_WIN + T_WBR + T_WOUT + T_WUV; u += G) {
        if (u < T_WIN) { const int l = u / (16 * 144), r = u % (16 * 144), kt = r / 144, nt = r % 144;
            conv_tile<true>(t, a.w_in + (size_t)l * DM * WIN_COLS, WIN_COLS, kt * 64, nt * 64, (f16*)(ws + WS_WINT) + (size_t)l * 9216 * 1024, 1024, a.norm_w + l * DM);
        } else if (u < T_WIN + T_WBR) { const int v = u - T_WIN, lg = v / 128, r = v % 128, kt = r / 16, nt = r % 16;
            conv_tile<false>(t, a.w_branch + (size_t)lg * 512 * 1024, 1024, kt * 64, nt * 64, (f16*)(ws + WS_WBRT) + (size_t)lg * 1024 * 512, 512, nullptr);
        } else if (u < T_WIN + T_WBR + T_WOUT) { const int v = u - T_WIN - T_WBR, l = v / 256, r = v % 256, kt = r / 16, nt = r % 16;
            conv_tile<false>(t, a.w_out + (size_t)l * DM * DM, DM, kt * 64, nt * 64, (f16*)(ws + WS_WOUTT) + (size_t)l * DM * DM, DM, nullptr);
        } else { const int v = u - T_WIN - T_WBR - T_WOUT, l = v / 16, r = v % 16, kt = r / 8, nt = r % 8;
            conv_tile<false>(t, a.w_uv + (size_t)l * 128 * 512, 512, kt * 64, nt * 64, (f16*)(ws + WS_WUV) + (size_t)l * 512 * 128, 128, nullptr);
        }
    }
    const size_t gtid = (size_t)bid * NTHREADS + tid, gsz = (size_t)G * NTHREADS;
    for (size_t i = gtid; i < (size_t)DEPTH * 8 * 128 * 64; i += gsz) { const int k = i & 63, r = (i >> 6) & 127, h = (i >> 13) & 7, l = (int)(i >> 16);
        ((f16*)(ws + WS_WUK))[i] = k < 48 ? (f16)a.w_uk[(((size_t)l * 128 + r) * 8 + h) * 48 + k] : (f16)0.f; }
    for (size_t i = gtid; i < (size_t)SEQ * 8; i += gsz) { const int pos = (int)(i >> 3), j = (int)(i & 7);
        const double inv[8] = {1.0, 0.19392274474868576, 0.03760603093086393, 0.007292664737217109, 0.001414213562373095, 0.0002742481756762073, 5.318295896944988e-05, 1.031338537721246e-05};
        double iv = inv[0];
#pragma unroll
        for (int q = 1; q < 8; ++q) iv = (j == q) ? inv[q] : iv;
        const double x = (double)pos * iv, n = rint(x * 0.15915494309189535);
        const double r = (x - n * 6.283185307179586) - n * 2.4492935982947064e-16;
        float* rp = (float*)(ws + WS_ROPE) + (size_t)pos * 16;
        rp[j] = cosf((float)r); rp[8 + j] = sinf((float)r); }
    { const int wave = tid >> 6, lane = tid & 63;
      for (int row = bid * 8 + wave; row < MTOK; row += G * 8) {
        const float* xr = a.x + (size_t)row * DM; f16* o = (f16*)(ws + WS_X16) + (size_t)row * DM; float sq = 0.f;
#pragma unroll
        for (int i = 0; i < 4; ++i) { const f32x4 v = *(const f32x4*)(xr + i * 256 + lane * 4); sq += (v[0] * v[0] + v[1] * v[1]) + (v[2] * v[2] + v[3] * v[3]);
            u32x2 w; w.x = pg8::pk_f16(v[0], v[1]); w.y = pg8::pk_f16(v[2], v[3]); *(u32x2*)(o + i * 256 + lane * 4) = w; }
#pragma unroll
        for (int o2 = 32; o2 >= 1; o2 >>= 1) sq += __shfl_xor(sq, o2);
        if (lane < 16) ((float*)(ws + WS_SS))[(size_t)row * 16 + lane] = lane == 0 ? sq : 0.f;
      } }
}

__device__ __forceinline__ void sb_attn_unit(const f16* __restrict__ P16, const f16* __restrict__ VT, f16* __restrict__ Y3, int b, int h, int qt, int lane) {
    const int q0 = qt * 32, hh = lane >> 5, ln = lane & 31;
    const size_t rowq = (size_t)(b * SEQ + q0 + ln) * NA;
    f16x8 qf[4];
#pragma unroll
    for (int s = 0; s < 4; ++s) qf[s] = *(const f16x8*)(P16 + rowq + C_SQ + h * 64 + 16 * s + 8 * hh);
    f32x16 o0, o1;
#pragma unroll
    for (int r = 0; r < 16; ++r) { o0[r] = 0.f; o1[r] = 0.f; }
    float carry = 1.0f;
    const f16* vt = VT + ((size_t)(b * 8 + h) * 64) * SEQ;
    const int query = q0 + ln;
    for (int kt = qt; kt >= 0; --kt) {
        const int k0 = kt * 32;
        const f16* kp = P16 + (size_t)(b * SEQ + k0 + ln) * NA + C_SK + h * 64 + 8 * hh;
        f32x16 z;
#pragma unroll
        for (int r = 0; r < 16; ++r) z[r] = 0.f;
#pragma unroll
        for (int s = 0; s < 4; ++s) { const f16x8 kf = *(const f16x8*)(kp + 16 * s); z = __builtin_amdgcn_mfma_f32_32x32x16_f16(kf, qf[s], z, 0, 0, 0); }
        float av[16], p[4], pp[4];
#pragma unroll
        for (int a = 0; a < 4; ++a) {
            float st[4], be[4];
#pragma unroll
            for (int c = 0; c < 4; ++c) { const int key = k0 + c + 8 * a + 4 * hh; const bool valid = key < query;
                const float zz = fminf(z[4 * a + c] * 0.125f, 80.f); const float u = fast_exp(zz); const float s_ = fast_rcp(1.0f + u);
                st[c] = valid ? s_ : 1.0f; be[c] = valid ? u * s_ : 0.0f; }
            const float s2 = st[3], s1 = s2 * st[2], s0 = s1 * st[1];
            p[a] = s0 * st[0];
            av[4 * a + 3] = be[3]; av[4 * a + 2] = be[2] * s2; av[4 * a + 1] = be[1] * s1; av[4 * a + 0] = be[0] * s0;
        }
#pragma unroll
        for (int a = 0; a < 4; ++a) pp[a] = __shfl_xor(p[a], 32);
        const float T0 = p[0] * pp[0], T1 = p[1] * pp[1], T2 = p[2] * pp[2], T3 = p[3] * pp[3];
        float grp[4];
        grp[3] = carry; grp[2] = carry * T3; grp[1] = grp[2] * T2; grp[0] = grp[1] * T1;
        const float ncarry = grp[0] * T0;
        if (hh == 0) {
#pragma unroll
            for (int a = 0; a < 4; ++a) grp[a] *= pp[a];
        }
        f16x8 bf0, bf1;
#pragma unroll
        for (int j = 0; j < 8; ++j) { bf0[j] = (f16)(av[j] * grp[j >> 2]); bf1[j] = (f16)(av[8 + j] * grp[2 + (j >> 2)]); }
#pragma unroll
        for (int dt = 0; dt < 2; ++dt) {
            const f16* vp = vt + (size_t)(32 * dt + ln) * SEQ + k0 + 4 * hh;
            f16x8 a0, a1;
            { const f16x4 lo = *(const f16x4*)(vp), hi = *(const f16x4*)(vp + 8); a0 = __builtin_shufflevector(lo, hi, 0, 1, 2, 3, 4, 5, 6, 7); }
            { const f16x4 lo = *(const f16x4*)(vp + 16), hi = *(const f16x4*)(vp + 24); a1 = __builtin_shufflevector(lo, hi, 0, 1, 2, 3, 4, 5, 6, 7); }
            if (dt == 0) { o0 = __builtin_amdgcn_mfma_f32_32x32x16_f16(a0, bf0, o0, 0, 0, 0); o0 = __builtin_amdgcn_mfma_f32_32x32x16_f16(a1, bf1, o0, 0, 0, 0); }
            else         { o1 = __builtin_amdgcn_mfma_f32_32x32x16_f16(a0, bf0, o1, 0, 0, 0); o1 = __builtin_amdgcn_mfma_f32_32x32x16_f16(a1, bf1, o1, 0, 0, 0); }
        }
        carry = ncarry;
        if (__all(carry < 1e-30f)) break;
    }
    const size_t rowt = (size_t)(b * SEQ + query);
#pragma unroll
    for (int dt = 0; dt < 2; ++dt)
#pragma unroll
        for (int a = 0; a < 4; ++a) { const int dim = 32 * dt + 8 * a + 4 * hh;
            const f16x4 zg = *(const f16x4*)(P16 + rowt * NA + C_SZ + h * 64 + dim);
            f16x4 y;
#pragma unroll
            for (int c = 0; c < 4; ++c) { const float ov = dt == 0 ? o0[4 * a + c] : o1[4 * a + c]; y[c] = (f16)(ov * siluf_((float)zg[c])); }
            *(f16x4*)(Y3 + rowt * 1536 + 512 + h * 64 + dim) = y; }
}

__device__ __forceinline__ void transpose_slab(LAS unsigned char* lds, const f16* __restrict__ P16, int coff, int b, int s0, f16* __restrict__ dstT);

__device__ __forceinline__ void phase_b_unit(const Args& a, LAS unsigned char* lds, int l, int b, int ck) {
    int tid = threadIdx.x; asm volatile("" : "+v"(tid));
    const int wave = __builtin_amdgcn_readfirstlane(tid >> 6), lane = tid & 63;
    unsigned char* ws = a.ws; LAUNDER_S(ws);
    const f16* __restrict__ P16 = (const f16*)(ws + WS_P16);
    const int s0 = ck * 64; const size_t tok0 = (size_t)b * SEQ + s0;
    const float* __restrict__ rope = (const float*)(ws + WS_ROPE);

    transpose_slab(lds, P16, C_SV, b, s0, (f16*)(ws + WS_VT));
    transpose_slab(lds, P16, C_MV, b, s0, (f16*)(ws + WS_MLVT));

    { f16* KV = (f16*)(ws + WS_KV);
      for (int i = 0; i < 8; ++i) { const int s = wave * 8 + i; const size_t t = tok0 + s; const f16* pr = P16 + t * NA;
        const f16x2 xv = *(const f16x2*)(pr + C_CKV + 2 * lane); const float x0 = (float)xv[0], x1 = (float)xv[1];
        float sq = x0 * x0 + x1 * x1;
#pragma unroll
        for (int o = 32; o >= 1; o >>= 1) sq += __shfl_xor(sq, o);
        const float rs = 1.0f / sqrtf(sq * (1.0f / 128.0f) + NORM_EPS);
        const float w0 = a.kvn_w[l * 128 + 2 * lane], w1 = a.kvn_w[l * 128 + 2 * lane + 1];
        f16x2 o2; o2[0] = (f16)(x0 * rs * w0); o2[1] = (f16)(x1 * rs * w1);
        *(f16x2*)(KV + t * 160 + 2 * lane) = o2;
        if (lane < 8) { const float c = rope[(s0 + s) * 16 + lane], sn = rope[(s0 + s) * 16 + 8 + lane];
            const float k1 = (float)pr[C_KR + lane], k2 = (float)pr[C_KR + 8 + lane];
            KV[t * 160 + 128 + lane] = (f16)(k1 * c - k2 * sn); KV[t * 160 + 136 + lane] = (f16)(k2 * c + k1 * sn); }
        else if (lane < 16) { f16x2 z; z[0] = (f16)0.f; z[1] = (f16)0.f; *(f16x2*)(KV + t * 160 + 144 + 2 * (lane - 8)) = z; }
      } }
    { f16* IQ = (f16*)(ws + WS_IQ); f16* IK = (f16*)(ws + WS_IK); float* IW = (float*)(ws + WS_IW);
      for (int i = 0; i < 40; ++i) { const int e = tid + 512 * i, s = e / 320, c = e % 320;
        const size_t t = tok0 + s; const f16* pr = P16 + t * NA + C_IQ;
        const int d = c & 63; float v;
        if (d < 16) { const int j = d & 7; const float cs = rope[(s0 + s) * 16 + j], sn = rope[(s0 + s) * 16 + 8 + j];
            const float x1 = (float)pr[c - d + j], x2 = (float)pr[c - d + 8 + j];
            v = d < 8 ? x1 * cs - x2 * sn : x2 * cs + x1 * sn; }
        else v = (float)pr[c];
        if (c < 256) IQ[t * 256 + c] = (f16)v; else IK[t * 64 + (c - 256)] = (f16)v; }
      if (tid < 256) { const int s = tid >> 2, h = tid & 3; IW[(tok0 + s) * 4 + h] = (float)P16[(tok0 + s) * NA + C_IW + h]; } }
    { const int h = wave, fr = lane & 15, fq = lane >> 4; f16* QC = (f16*)(ws + WS_QC);
      const f16* Wk = (const f16*)(ws + WS_WUK) + ((size_t)(l * 8 + h) * 128) * 64;
      f16x8 af[4][2];
#pragma unroll
      for (int mt = 0; mt < 4; ++mt)
#pragma unroll
        for (int ks = 0; ks < 2; ++ks) af[mt][ks] = *(const f16x8*)(P16 + (tok0 + 16 * mt + fr) * NA + C_DQ + h * 64 + 16 + 32 * ks + 8 * fq);
#pragma unroll
      for (int rt = 0; rt < 8; ++rt) {
        const f16x8 b0 = *(const f16x8*)(Wk + (size_t)(16 * rt + fr) * 64 + 8 * fq), b1 = *(const f16x8*)(Wk + (size_t)(16 * rt + fr) * 64 + 32 + 8 * fq);
#pragma unroll
        for (int mt = 0; mt < 4; ++mt) { f32x4 acc = (f32x4){0.f, 0.f, 0.f, 0.f};
            acc = __builtin_amdgcn_mfma_f32_16x16x32_f16(af[mt][0], b0, acc, 0, 0, 0); acc = __builtin_amdgcn_mfma_f32_16x16x32_f16(af[mt][1], b1, acc, 0, 0, 0);
#pragma unroll
            for (int r = 0; r < 4; ++r) QC[((tok0 + 16 * mt + 4 * fq + r) * 8 + h) * 160 + 16 * rt + fr] = (f16)(acc[r] * 0.125f); }
      }
      { const size_t t = tok0 + lane; const f16* pr = P16 + t * NA + C_DQ + h * 64; f16* qo = QC + (t * 8 + h) * 160 + 128;
#pragma unroll
        for (int j = 0; j < 8; ++j) { const float cs = rope[(s0 + lane) * 16 + j], sn = rope[(s0 + lane) * 16 + 8 + j]; const float x1 = (float)pr[j], x2 = (float)pr[8 + j];
            qo[j] = (f16)((x1 * cs - x2 * sn) * 0.125f); qo[8 + j] = (f16)((x2 * cs + x1 * sn) * 0.125f); qo[16 + j] = (f16)0.f; qo[24 + j] = (f16)0.f; } } }

    LAS float* wf = (LAS float*)(lds + 73728);
    if (wave < 4) { const int h = wave; const size_t t = tok0 + lane;
        const float iv = (float)P16[t * NA + C_MI + h] + a.i_bias[l * 4 + h];
        const float fv = (float)P16[t * NA + C_MF + h] + a.f_bias[l * 4 + h];
        float bcum = logsigmoidf_(fv);
#pragma unroll
        for (int o = 1; o < 64; o <<= 1) { const float u = __shfl_up(bcum, o); if (lane >= o) bcum += u; }
        const float blast = __shfl(bcum, 63);
        const float lw = blast - bcum + iv; float ml = lw;
#pragma unroll
        for (int o = 32; o >= 1; o >>= 1) ml = fmaxf(ml, __shfl_xor(ml, o));
        f32x2 gg; gg[0] = bcum; gg[1] = iv - bcum; *(f32x2*)((float*)(ws + WS_GATE) + (t * 4 + h) * 2) = gg;
        wf[h * 64 + lane] = __expf(lw - ml);
        if (lane == 0) { f32x4 cs; cs[0] = blast; cs[1] = ml; cs[2] = 0.f; cs[3] = 0.f; *(f32x4*)((float*)(ws + WS_CHS) + ((size_t)(b * 4 + h) * 64 + ck) * 4) = cs; } }
    __syncthreads();
    constexpr int RST = 144;
    { const float* cw = a.conv_w + (size_t)l * 4 * 1024;
      const float wq0 = cw[tid], wq1 = cw[1024 + tid], wq2 = cw[2048 + tid], wq3 = cw[3072 + tid];
      const float wk0 = cw[512 + tid], wk1 = cw[1024 + 512 + tid], wk2 = cw[2048 + 512 + tid], wk3 = cw[3072 + 512 + tid];
      float q0 = 0.f, q1 = 0.f, q2 = 0.f, k0 = 0.f, k1 = 0.f, k2 = 0.f;
      if (ck > 0) { const f16* pr = P16 + (tok0 - 3) * NA + C_MQK; q0 = (float)pr[tid]; k0 = (float)pr[512 + tid]; q1 = (float)pr[NA + tid]; k1 = (float)pr[NA + 512 + tid]; q2 = (float)pr[2 * NA + tid]; k2 = (float)pr[2 * NA + 512 + tid]; }
      f16* MLQ = (f16*)(ws + WS_MLQ); f16* MLK = (f16*)(ws + WS_MLK); const int hrow = tid >> 7;
      for (int s = 0; s < 64; ++s) { const f16* pr = P16 + (tok0 + s) * NA + C_MQK; const float q3 = (float)pr[tid], k3 = (float)pr[512 + tid];
        const float qc = siluf_(wq0 * q0 + wq1 * q1 + wq2 * q2 + wq3 * q3), kc = siluf_(wk0 * k0 + wk1 * k1 + wk2 * k2 + wk3 * k3) * 0.08838834764831845f;
        MLQ[(tok0 + s) * 512 + tid] = (f16)qc; MLK[(tok0 + s) * 512 + tid] = (f16)kc;
        *(LAS f16*)(lds + tid * RST + s * 2) = (f16)(kc * wf[hrow * 64 + s]);
        q0 = q1; q1 = q2; q2 = q3; k0 = k1; k1 = k2; k2 = k3; } }
    __syncthreads();
    { const int et = wave & 3, dt0 = (wave >> 2) * 2, ln = lane & 31, hh = lane >> 5;
      const f16* MVT = (const f16*)(ws + WS_MLVT); f16* DCT = (f16*)(ws + WS_DCT);
      for (int h = 0; h < 4; ++h) {
        f32x16 acc0, acc1;
#pragma unroll
        for (int r = 0; r < 16; ++r) { acc0[r] = 0.f; acc1[r] = 0.f; }
        const f16* vrow = MVT + ((size_t)(b * 512 + h * 128 + 32 * et + ln)) * SEQ + s0 + 8 * hh;
#pragma unroll
        for (int ks = 0; ks < 4; ++ks) { const f16x8 af = *(const f16x8*)(vrow + 16 * ks);
            const f16x8 b0 = *(const LAS f16x8*)(lds + (h * 128 + 32 * dt0 + ln) * RST + (16 * ks + 8 * hh) * 2);
            const f16x8 b1 = *(const LAS f16x8*)(lds + (h * 128 + 32 * (dt0 + 1) + ln) * RST + (16 * ks + 8 * hh) * 2);
            acc0 = __builtin_amdgcn_mfma_f32_32x32x16_f16(af, b0, acc0, 0, 0, 0); acc1 = __builtin_amdgcn_mfma_f32_32x32x16_f16(af, b1, acc1, 0, 0, 0); }
        f16* dst = DCT + ((size_t)(b * 4 + h) * 64 + ck) * 16384;
#pragma unroll
        for (int r = 0; r < 16; ++r) { const int e = 32 * et + (r & 3) + 8 * (r >> 2) + 4 * hh;
            dst[e * 128 + 32 * dt0 + ln] = (f16)acc0[r]; dst[e * 128 + 32 * (dt0 + 1) + ln] = (f16)acc1[r]; }
      }
      { float sn = 0.f;
#pragma unroll
        for (int i = 0; i < 8; ++i) { const f16x8 v = *(const LAS f16x8*)(lds + tid * RST + i * 16);
#pragma unroll
            for (int j = 0; j < 8; ++j) sn += (float)v[j]; }
        ((float*)(ws + WS_DN))[((size_t)(b * 4 + (tid >> 7)) * 64 + ck) * 128 + (tid & 127)] = sn; } }
    __syncthreads();
}

__device__ __forceinline__ void mlstm_scan(const Args& a, LAS unsigned char* lds) {
    int tid = threadIdx.x; asm volatile("" : "+v"(tid));
    unsigned char* ws = a.ws; LAUNDER_S(ws);
    LAS float* tabA = (LAS float*)lds; LAS float* tabC = tabA + 64;
    for (int v = blockIdx.x; v < 256; v += gridDim.x) {
        const int bh = v >> 4, part = v & 15;
        float* chs = (float*)(ws + WS_CHS) + (size_t)bh * 64 * 4;
        if (tid == 0) { float m = 0.f;
            for (int k = 0; k < 64; ++k) { const float bl = chs[k * 4], ml = chs[k * 4 + 1]; const float mn = fmaxf(bl + m, ml);
                tabA[k] = __expf(bl + m - mn); tabC[k] = __expf(ml - mn); if (part == 0) chs[k * 4 + 2] = m; m = mn; } }
        __syncthreads();
        f16x2* p = (f16x2*)((f16*)(ws + WS_DCT) + (size_t)bh * 64 * 16384 + part * 1024 + tid * 2);
        float c0 = 0.f, c1 = 0.f;
        for (int k0 = 0; k0 < 64; k0 += 8) { f16x2 d[8];
#pragma unroll
            for (int j = 0; j < 8; ++j) d[j] = p[(size_t)(k0 + j) * 8192];
#pragma unroll
            for (int j = 0; j < 8; ++j) { f16x2 o; o[0] = (f16)c0; o[1] = (f16)c1; p[(size_t)(k0 + j) * 8192] = o;
                const float aa = tabA[k0 + j], cc = tabC[k0 + j]; c0 = aa * c0 + cc * (float)d[j][0]; c1 = aa * c1 + cc * (float)d[j][1]; } }
        if (part == 0 && tid < 128) { float* pn = (float*)(ws + WS_DN) + (size_t)bh * 64 * 128 + tid; float n = 0.f;
            for (int k = 0; k < 64; ++k) { const float d = pn[k * 128]; pn[k * 128] = n; n = tabA[k] * n + tabC[k] * d; } }
        __syncthreads();
    }
}

__device__ __forceinline__ void mlstm_out_unit(const Args& a, LAS unsigned char* wlds  , int l, int b, int ck, int h, int th, int lane) {
    unsigned char* ws = a.ws; LAUNDER_S(ws);
    const int ln = lane & 31, hh = lane >> 5, s0 = ck * 64; const size_t tok0 = (size_t)b * SEQ + s0;
    const int bh = b * 4 + h;
    const f16* __restrict__ MLQ = (const f16*)(ws + WS_MLQ); const f16* __restrict__ MLK = (const f16*)(ws + WS_MLK);
    const f16* __restrict__ MVT = (const f16*)(ws + WS_MLVT) + ((size_t)(b * 512 + h * 128)) * SEQ + s0;
    const f16* __restrict__ CT = (const f16*)(ws + WS_DCT) + ((size_t)bh * 64 + ck) * 16384;
    const float* __restrict__ NS = (const float*)(ws + WS_DN) + ((size_t)bh * 64 + ck) * 128;
    const float mk = ((const float*)(ws + WS_CHS))[((size_t)bh * 64 + ck) * 4 + 2];
    LAS float* gtab = (LAS float*)wlds;
    LAS float* ntab = gtab + 64;
    const f32x2 bg = *(const f32x2*)((const float*)(ws + WS_GATE) + ((tok0 + lane) * 4 + h) * 2);
    float pmx = bg[1];
#pragma unroll
    for (int o = 1; o < 64; o <<= 1) { const float u = __shfl_up(pmx, o); if (lane >= o) pmx = fmaxf(pmx, u); }
    gtab[lane] = bg[1]; ntab[lane] = NS[lane]; ntab[64 + lane] = NS[64 + lane];
    const int tl = 32 * th + ln;
    const float bt = __shfl(bg[0], tl), Mt = fmaxf(__shfl(pmx, tl), mk);
    const float w_inter = __expf(mk - Mt), m_row = bt + Mt;
    f16x8 qf[8]; float qn = 0.f;
#pragma unroll
    for (int ks = 0; ks < 8; ++ks) { qf[ks] = *(const f16x8*)(MLQ + (tok0 + tl) * 512 + h * 128 + 16 * ks + 8 * hh);
#pragma unroll
        for (int j = 0; j < 8; ++j) qn += (float)qf[ks][j] * ntab[16 * ks + 8 * hh + j]; }
    qn += __shfl_xor(qn, 32);
    f32x16 acc[4];
#pragma unroll
    for (int et = 0; et < 4; ++et)
#pragma unroll
        for (int r = 0; r < 16; ++r) acc[et][r] = 0.f;
#pragma unroll
    for (int et = 0; et < 4; ++et)
#pragma unroll
        for (int ks = 0; ks < 8; ++ks) { const f16x8 cf = *(const f16x8*)(CT + (size_t)(32 * et + ln) * 128 + 16 * ks + 8 * hh);
            acc[et] = __builtin_amdgcn_mfma_f32_32x32x16_f16(cf, qf[ks], acc[et], 0, 0, 0); }
#pragma unroll
    for (int et = 0; et < 4; ++et)
#pragma unroll
        for (int r = 0; r < 16; ++r) acc[et][r] *= w_inter;
    float den = 0.f;
    for (int st = 0; st <= th; ++st) {
        f32x16 z;
#pragma unroll
        for (int r = 0; r < 16; ++r) z[r] = 0.f;
#pragma unroll
        for (int ks = 0; ks < 8; ++ks) { const f16x8 kf = *(const f16x8*)(MLK + (tok0 + 32 * st + ln) * 512 + h * 128 + 16 * ks + 8 * hh);
            z = __builtin_amdgcn_mfma_f32_32x32x16_f16(kf, qf[ks], z, 0, 0, 0); }
        f16x8 bf0, bf1;
#pragma unroll
        for (int aa = 0; aa < 4; ++aa) { const f32x4 gv = *(const LAS f32x4*)(gtab + 32 * st + 8 * aa + 4 * hh);
#pragma unroll
            for (int c = 0; c < 4; ++c) { const int s = 32 * st + 8 * aa + 4 * hh + c; const float w = s <= tl ? __expf(gv[c] - Mt) : 0.f; const float sw = z[4 * aa + c] * w; den += sw;
                if (aa < 2) bf0[4 * aa + c] = (f16)sw; else bf1[4 * (aa - 2) + c] = (f16)sw; } }
#pragma unroll
        for (int et = 0; et < 4; ++et) { const f16* vp = MVT + (size_t)(32 * et + ln) * SEQ + 32 * st + 4 * hh;
            f16x8 a0, a1;
            { const f16x4 lo = *(const f16x4*)(vp), hi = *(const f16x4*)(vp + 8); a0 = __builtin_shufflevector(lo, hi, 0, 1, 2, 3, 4, 5, 6, 7); }
            { const f16x4 lo = *(const f16x4*)(vp + 16), hi = *(const f16x4*)(vp + 24); a1 = __builtin_shufflevector(lo, hi, 0, 1, 2, 3, 4, 5, 6, 7); }
            acc[et] = __builtin_amdgcn_mfma_f32_32x32x16_f16(a0, bf0, acc[et], 0, 0, 0); acc[et] = __builtin_amdgcn_mfma_f32_32x32x16_f16(a1, bf1, acc[et], 0, 0, 0); }
    }
    den += __shfl_xor(den, 32);
    den += w_inter * qn;
    const float inv = 1.0f / fmaxf(fabsf(den), __expf(-m_row));
    float sm = 0.f;
#pragma unroll
    for (int et = 0; et < 4; ++et)
#pragma unroll
        for (int r = 0; r < 16; ++r) { acc[et][r] *= inv; sm += acc[et][r]; }
    sm += __shfl_xor(sm, 32);
    const float mu = sm * (1.0f / 128.0f); float vs = 0.f;
#pragma unroll
    for (int et = 0; et < 4; ++et)
#pragma unroll
        for (int r = 0; r < 16; ++r) { const float d = acc[et][r] - mu; vs += d * d; }
    vs += __shfl_xor(vs, 32);
    const float rstd = 1.0f / sqrtf(vs * (1.0f / 128.0f) + NORM_EPS);
    const f16* __restrict__ P16 = (const f16*)(ws + WS_P16); f16* Y3 = (f16*)(ws + WS_Y3);
    const size_t t = tok0 + tl;
#pragma unroll
    for (int et = 0; et < 4; ++et)
#pragma unroll
        for (int aa = 0; aa < 4; ++aa) { const int e = 32 * et + 8 * aa + 4 * hh;
            const f16x4 og = *(const f16x4*)(P16 + t * NA + C_MO + h * 128 + e), zg = *(const f16x4*)(P16 + t * NA + C_MZ + h * 128 + e);
            const f32x4 nw = *(const f32x4*)(a.mln_w + l * 512 + h * 128 + e);
            f16x4 y;
#pragma unroll
            for (int c = 0; c < 4; ++c) y[c] = (f16)((acc[et][4 * aa + c] - mu) * rstd * nw[c] * sigmoidf_((float)og[c]) * siluf_((float)zg[c]));
            *(f16x4*)(Y3 + t * 1536 + 1024 + h * 128 + e) = y; }
}

constexpr int DL_HIST = 0;
constexpr int DL_STAGE_W = 8704;
constexpr int DL_SELB = 69632;
constexpr int DL_EQB  = DL_SELB + 8192;
constexpr int DL_LIST = DL_EQB + 8192;
constexpr int DL_QST  = DL_LIST + 8192;
constexpr int DL_OL   = DL_QST + 512;
constexpr int DL_END  = DL_OL + 32768;
static_assert(DL_END <= LDS_BYTES - 16, "DSA LDS map");

__device__ __forceinline__ void dsa_unit(const Args& a, LAS unsigned char* lds, int l, int b, int j) {
    int tid = threadIdx.x; asm volatile("" : "+v"(tid));
    const int wave = __builtin_amdgcn_readfirstlane(tid >> 6), lane = tid & 63, fr = lane & 15, fq = lane >> 4;
    unsigned char* ws = a.ws; LAUNDER_S(ws);
    const int t0 = 16 * j; const size_t tokb = (size_t)b * SEQ;
    const f16* __restrict__ IQ = (const f16*)(ws + WS_IQ); const f16* __restrict__ IK = (const f16*)(ws + WS_IK); const float* __restrict__ IW = (const float*)(ws + WS_IW);
    LAS unsigned* hist = (LAS unsigned*)(lds + DL_HIST); LAS unsigned* selb = (LAS unsigned*)(lds + DL_SELB); LAS unsigned* eqb = (LAS unsigned*)(lds + DL_EQB);
    LAS unsigned short* list = (LAS unsigned short*)(lds + DL_LIST); LAS unsigned* qst = (LAS unsigned*)(lds + DL_QST); LAS unsigned* nselp = qst + 64;

    if (tid < 16) { const int t = t0 + tid; const unsigned need = (unsigned)(t + 1 < 256 ? t + 1 : 256); qst[tid * 4 + 0] = 0u; qst[tid * 4 + 1] = 0u; qst[tid * 4 + 2] = need; qst[tid * 4 + 3] = 0u; nselp[tid] = need; }
    for (int i = tid; i < 4096; i += NTHREADS) selb[i] = 0u;

    u32x4 sk[32];
    {
        f16x8 iqf[4][2]; float iw[4];
#pragma unroll
        for (int h = 0; h < 4; ++h) { iw[h] = IW[(tokb + t0 + fr) * 4 + h];
#pragma unroll
            for (int ks = 0; ks < 2; ++ks) iqf[h][ks] = *(const f16x8*)(IQ + (tokb + t0 + fr) * 256 + h * 64 + 32 * ks + 8 * fq); }
        const int ntm0 = (j >= wave ? ((j - wave) >> 3) + 1 : 0) + (int)opaque0();
#pragma unroll
        for (int i = 0; i < 32; ++i) {
            const int kt = wave + 8 * i;
            if (i < ntm0) {
                const f16* kp = IK + (tokb + 16 * kt + fr) * 64 + 8 * fq;
                const f16x8 a0 = *(const f16x8*)kp, a1 = *(const f16x8*)(kp + 32);
                f32x4 sc = (f32x4){0.f, 0.f, 0.f, 0.f};
#pragma unroll
                for (int h = 0; h < 4; ++h) { f32x4 c = (f32x4){0.f, 0.f, 0.f, 0.f};
                    c = __builtin_amdgcn_mfma_f32_16x16x32_f16(a0, iqf[h][0], c, 0, 0, 0); c = __builtin_amdgcn_mfma_f32_16x16x32_f16(a1, iqf[h][1], c, 0, 0, 0);
#pragma unroll
                    for (int r = 0; r < 4; ++r) sc[r] += iw[h] * fmaxf(c[r], 0.f); }
#pragma unroll
                for (int r = 0; r < 4; ++r) { const int kidx = 16 * kt + 4 * fq + r; const float s = sc[r] + 0.0f;
                    const unsigned u = __float_as_uint(s); const unsigned uk = (u & 0x80000000u) ? ~u : (u | 0x80000000u);
                    sk[i][r] = kidx <= t0 + fr ? uk : 0u; }
            } else sk[i] = (u32x4){0u, 0u, 0u, 0u};
        }
    }
    for (int lvl = 0; lvl < 3; ++lvl) {
        const int shift = lvl == 0 ? 21 : (lvl == 1 ? 10 : 0); const unsigned dmask = lvl == 2 ? 0x3FFu : 0x7FFu; const int nbins = lvl == 2 ? 1024 : 2048;
        { u32x4* hz = (u32x4*)0; (void)hz;
#pragma unroll
          for (int i = 0; i < 8; ++i) *(LAS u32x4*)(lds + DL_HIST + (tid + NTHREADS * i) * 16) = (u32x4){0u, 0u, 0u, 0u}; }
        __syncthreads();
        { const unsigned mask = qst[fr * 4 + 0], val = qst[fr * 4 + 1], done = qst[fr * 4 + 3];
          unsigned oz = 0u; asm volatile("" : "+v"(oz));
          const int ntm = (j >= wave ? ((j - wave) >> 3) + 1 : 0) + (int)opaque0();
          if (!done) {
#pragma unroll
            for (int i = 0; i < 32; ++i) { if (i < ntm) {
#pragma unroll
                for (int r = 0; r < 4; ++r) { const unsigned uk = sk[i][r] ^ oz;
                    if (uk != 0u && (uk & mask) == val) { const unsigned d = (uk >> shift) & dmask;
                        __hip_atomic_fetch_add(hist + fr * 1024 + (d >> 1), (d & 1u) ? 65536u : 1u, __ATOMIC_RELAXED, __HIP_MEMORY_SCOPE_WORKGROUP); } } } }
          } }
        __syncthreads();
        for (int qq = 0; qq < 2; ++qq) { const int q = 2 * wave + qq;
            const unsigned mask = qst[q * 4 + 0], val = qst[q * 4 + 1], need = qst[q * 4 + 2], done = qst[q * 4 + 3];
            if (done) continue;
            const int nb = nbins >> 6, base = nbins - (lane + 1) * nb;
            unsigned cw[16]; unsigned s = 0;
#pragma unroll
            for (int i = 0; i < 16; ++i) { cw[i] = (i < (nb >> 1)) ? hist[q * 1024 + (base >> 1) + i] : 0u; s += (cw[i] & 0xFFFFu) + (cw[i] >> 16); }
            unsigned incl = s;
#pragma unroll
            for (int o = 1; o < 64; o <<= 1) { const unsigned u = __shfl_up(incl, o); if (lane >= o) incl += u; }
            const unsigned long long bal = __ballot(incl >= need);
            const int Lc = bal ? (int)__builtin_ctzll(bal) : 63;
            unsigned dstar = 0, above = incl - s, ceq = 0; bool found = false;
#pragma unroll
            for (int i = 15; i >= 0; --i) {
#pragma unroll
                for (int hf = 1; hf >= 0; --hf) { const unsigned c = hf ? (cw[i] >> 16) : (cw[i] & 0xFFFFu);
                    if (i < (nb >> 1) && !found) { if (above + c >= need) { found = true; dstar = (unsigned)(base + 2 * i + hf); ceq = c; } else above += c; } } }
            dstar = __shfl(dstar, Lc); above = __shfl(above, Lc); ceq = __shfl(ceq, Lc);
            if (lane == 0) { const unsigned nn = need - above;
                qst[q * 4 + 0] = mask | (dmask << shift); qst[q * 4 + 1] = val | (dstar << shift); qst[q * 4 + 2] = nn; qst[q * 4 + 3] = (ceq == nn) ? 1u : 0u; }
        }
        __syncthreads();
    }
    { const unsigned mask = qst[fr * 4 + 0], val = qst[fr * 4 + 1], done = qst[fr * 4 + 3];
      unsigned oz = 0u; asm volatile("" : "+v"(oz));
      const int ntm = (j >= wave ? ((j - wave) >> 3) + 1 : 0) + (int)opaque0();
#pragma unroll
      for (int i = 0; i < 32; ++i) { if (i < ntm) {
#pragma unroll
          for (int r = 0; r < 4; ++r) { const unsigned uk = sk[i][r] ^ oz; const unsigned kidx = (unsigned)(16 * (wave + 8 * i) + 4 * fq + r);
              if (uk != 0u) { const unsigned hb = uk & mask;
                  if (hb > val || (hb == val && done)) __hip_atomic_fetch_or(selb + fr * 128 + (kidx >> 5), 1u << (kidx & 31u), __ATOMIC_RELAXED, __HIP_MEMORY_SCOPE_WORKGROUP);
                  else if (hb == val) __hip_atomic_fetch_or(eqb + fr * 128 + (kidx >> 5), 1u << (kidx & 31u), __ATOMIC_RELAXED, __HIP_MEMORY_SCOPE_WORKGROUP); } } } } }
    __syncthreads();
    for (int qq = 0; qq < 2; ++qq) { const int q = 2 * wave + qq;
        const unsigned need = qst[q * 4 + 2], done = qst[q * 4 + 3], nsel = nselp[q];
        unsigned long long w = (unsigned long long)selb[q * 128 + 2 * lane] | ((unsigned long long)selb[q * 128 + 2 * lane + 1] << 32);
        if (!done) { unsigned long long e = (unsigned long long)eqb[q * 128 + 2 * lane] | ((unsigned long long)eqb[q * 128 + 2 * lane + 1] << 32);
            const unsigned pc = (unsigned)__builtin_popcountll(e); unsigned incl = pc;
#pragma unroll
            for (int o = 1; o < 64; o <<= 1) { const unsigned u = __shfl_up(incl, o); if (lane >= o) incl += u; }
            const unsigned before = incl - pc;
            if (before >= need) e = 0ull;
            else if (incl > need) { unsigned keep = need - before; while ((unsigned)__builtin_popcountll(e) > keep) e &= ~(1ull << (63 - __builtin_clzll(e))); }
            w |= e; }
        const unsigned pc = (unsigned)__builtin_popcountll(w); unsigned incl = pc;
#pragma unroll
        for (int o = 1; o < 64; o <<= 1) { const unsigned u = __shfl_up(incl, o); if (lane >= o) incl += u; }
        unsigned pos = incl - pc;
#pragma unroll
        for (int i = 0; i < 4; ++i) { const unsigned p = (unsigned)(lane + 64 * i); if (p >= nsel) list[q * 256 + p] = 0; }
        while (w) { const int bit = __builtin_ctzll(w); w &= w - 1ull; if (pos < 256u) list[q * 256 + pos] = (unsigned short)(64 * lane + bit); ++pos; }
    }
    __syncthreads();

    const f16* __restrict__ KV = (const f16*)(ws + WS_KV); const f16* __restrict__ QC = (const f16*)(ws + WS_QC);
    LAS unsigned char* stg = lds + DL_HIST + wave * DL_STAGE_W;
    const unsigned tr_addr = (unsigned)(uintptr_t)stg + (unsigned)((4 * fq + ((lane & 15) >> 2)) * 272 + (lane & 3) * 8);
    for (int qq = 0; qq < 2; ++qq) { const int q = 2 * wave + qq; const size_t tok = tokb + t0 + q; const int nsel = (int)nselp[q];
        f16x8 qc[5];
#pragma unroll
        for (int ks = 0; ks < 5; ++ks) { if (fr < 8) qc[ks] = *(const f16x8*)(QC + (tok * 8 + fr) * 160 + 32 * ks + 8 * fq); else {
#pragma unroll
            for (int e = 0; e < 8; ++e) qc[ks][e] = (f16)0.f; } }
        f32x4 acc[8];
#pragma unroll
        for (int c = 0; c < 8; ++c) acc[c] = (f32x4){0.f, 0.f, 0.f, 0.f};
        float m_run = -INFINITY, l_run = 0.f;
        for (int pp = 0; pp < 8 && 32 * pp < nsel; ++pp) {
            const int idxA = list[q * 256 + 32 * pp + fr], idxB = list[q * 256 + 32 * pp + 16 + fr];
            const f16* ka = KV + (tokb + idxA) * 160 + 8 * fq; const f16* kb = KV + (tokb + idxB) * 160 + 8 * fq;
            f16x8 fa[5], fb[5];
#pragma unroll
            for (int ks = 0; ks < 5; ++ks) { fa[ks] = *(const f16x8*)(ka + 32 * ks); fb[ks] = *(const f16x8*)(kb + 32 * ks); }
            f32x4 c0 = (f32x4){0.f, 0.f, 0.f, 0.f}, c1 = (f32x4){0.f, 0.f, 0.f, 0.f};
#pragma unroll
            for (int ks = 0; ks < 5; ++ks) { c0 = __builtin_amdgcn_mfma_f32_16x16x32_f16(fa[ks], qc[ks], c0, 0, 0, 0); c1 = __builtin_amdgcn_mfma_f32_16x16x32_f16(fb[ks], qc[ks], c1, 0, 0, 0); }
            float mx = -INFINITY;
#pragma unroll
            for (int r = 0; r < 4; ++r) { if (32 * pp + 4 * fq + r >= nsel) c0[r] = -INFINITY; if (32 * pp + 16 + 4 * fq + r >= nsel) c1[r] = -INFINITY; mx = fmaxf(mx, fmaxf(c0[r], c1[r])); }
            mx = fmaxf(mx, __shfl_xor(mx, 16)); mx = fmaxf(mx, __shfl_xor(mx, 32));
            const float mn = fmaxf(m_run, mx); const float scale = __expf(m_run - mn);
            float ps = 0.f; f16x8 pf;
#pragma unroll
            for (int r = 0; r < 4; ++r) { const float p0 = __expf(c0[r] - mn), p1 = __expf(c1[r] - mn); ps += p0 + p1; pf[r] = (f16)p0; pf[4 + r] = (f16)p1; }
            ps += __shfl_xor(ps, 16); ps += __shfl_xor(ps, 32);
            l_run = l_run * scale + ps; m_run = mn;
#pragma unroll
            for (int c = 0; c < 8; ++c) acc[c] *= scale;
#pragma unroll
            for (int ks = 0; ks < 4; ++ks) { *(LAS f16x8*)(stg + fr * 272 + (32 * ks + 8 * fq) * 2) = fa[ks]; *(LAS f16x8*)(stg + (16 + fr) * 272 + (32 * ks + 8 * fq) * 2) = fb[ks]; }
            u32x2 t0_[8], t1_[8];
            asm volatile("s_waitcnt lgkmcnt(0)\n\t"
                "ds_read_b64_tr_b16 %0, %16 offset:0\n\t"    "ds_read_b64_tr_b16 %1, %16 offset:32\n\t"   "ds_read_b64_tr_b16 %2, %16 offset:64\n\t"   "ds_read_b64_tr_b16 %3, %16 offset:96\n\t"
                "ds_read_b64_tr_b16 %4, %16 offset:128\n\t"  "ds_read_b64_tr_b16 %5, %16 offset:160\n\t"  "ds_read_b64_tr_b16 %6, %16 offset:192\n\t"  "ds_read_b64_tr_b16 %7, %16 offset:224\n\t"
                "ds_read_b64_tr_b16 %8, %16 offset:4352\n\t" "ds_read_b64_tr_b16 %9, %16 offset:4384\n\t" "ds_read_b64_tr_b16 %10, %16 offset:4416\n\t" "ds_read_b64_tr_b16 %11, %16 offset:4448\n\t"
                "ds_read_b64_tr_b16 %12, %16 offset:4480\n\t" "ds_read_b64_tr_b16 %13, %16 offset:4512\n\t" "ds_read_b64_tr_b16 %14, %16 offset:4544\n\t" "ds_read_b64_tr_b16 %15, %16 offset:4576\n\t"
                "s_waitcnt lgkmcnt(0)"
                : "=&v"(t0_[0]), "=&v"(t0_[1]), "=&v"(t0_[2]), "=&v"(t0_[3]), "=&v"(t0_[4]), "=&v"(t0_[5]), "=&v"(t0_[6]), "=&v"(t0_[7]),
                  "=&v"(t1_[0]), "=&v"(t1_[1]), "=&v"(t1_[2]), "=&v"(t1_[3]), "=&v"(t1_[4]), "=&v"(t1_[5]), "=&v"(t1_[6]), "=&v"(t1_[7])
                : "v"(tr_addr) : "memory");
#pragma unroll
            for (int c = 0; c < 8; ++c) { u32x4 av; av.x = t0_[c].x; av.y = t0_[c].y; av.z = t1_[c].x; av.w = t1_[c].y;
                acc[c] = __builtin_amdgcn_mfma_f32_16x16x32_f16(__builtin_bit_cast(f16x8, av), pf, acc[c], 0, 0, 0); }
        }
        const float inv = 1.0f / l_run;
        if (fr < 8) {
#pragma unroll
            for (int c = 0; c < 8; ++c) { f16x4 o; o[0] = (f16)(acc[c][0] * inv); o[1] = (f16)(acc[c][1] * inv); o[2] = (f16)(acc[c][2] * inv); o[3] = (f16)(acc[c][3] * inv);
                *(LAS f16x4*)(lds + DL_OL + ((q * 8 + fr) * 128 + 16 * c + 4 * fq) * 2) = o; } }
    }
    __syncthreads();
    { const int h = wave; const f16* Wv = (const f16*)(ws + WS_WUV) + ((size_t)(l * 8 + h) * 64) * 128;
      const f16* __restrict__ P16 = (const f16*)(ws + WS_P16); f16* Y3 = (f16*)(ws + WS_Y3);
      f16x8 af[4];
#pragma unroll
      for (int ks = 0; ks < 4; ++ks) af[ks] = *(const LAS f16x8*)(lds + DL_OL + ((fr * 8 + h) * 128 + 32 * ks + 8 * fq) * 2);
#pragma unroll
      for (int n = 0; n < 4; ++n) { f32x4 c = (f32x4){0.f, 0.f, 0.f, 0.f};
#pragma unroll
          for (int ks = 0; ks < 4; ++ks) { const f16x8 bf = *(const f16x8*)(Wv + (size_t)(16 * n + fr) * 128 + 32 * ks + 8 * fq); c = __builtin_amdgcn_mfma_f32_16x16x32_f16(af[ks], bf, c, 0, 0, 0); }
#pragma unroll
          for (int r = 0; r < 4; ++r) { const size_t tok = tokb + t0 + 4 * fq + r; const int col = h * 64 + 16 * n + fr;
              Y3[tok * 1536 + col] = (f16)(c[r] * siluf_((float)P16[tok * NA + C_DZ + col])); } } }
    __syncthreads();
}

__device__ __forceinline__ void transpose_slab(LAS unsigned char* lds, const f16* __restrict__ P16, int coff, int b, int s0, f16* __restrict__ dstT) {
    constexpr int RS = 1040;
    const int tid = threadIdx.x;
#pragma unroll
    for (int i = 0; i < 8; ++i) { const int id = tid + 512 * i, row = id >> 6, cc = id & 63;
        *(LAS u32x4*)(lds + row * RS + cc * 16) = *(const u32x4*)(P16 + (size_t)(b * SEQ + s0 + row) * NA + coff + cc * 8); }
    __syncthreads();
    f16* d = dstT + ((size_t)(b * 512 + tid)) * SEQ + s0;
#pragma unroll
    for (int i = 0; i < 8; ++i) { f16x8 v;
#pragma unroll
        for (int j = 0; j < 8; ++j) v[j] = *(const LAS f16*)(lds + (i * 8 + j) * RS + tid * 2);
        *(f16x8*)(d + i * 8) = v; }
    __syncthreads();
}

__device__ __forceinline__ void final_norm(const Args& a) {
    const int G = gridDim.x, bid = blockIdx.x; int tid = threadIdx.x; asm volatile("" : "+v"(tid)); const int wave = tid >> 6, lane = tid & 63;
    unsigned char* ws = a.ws; LAUNDER_S(ws);
    const float* X = a.out; const float* ss = (const float*)(ws + WS_SS);
    for (int row = bid * 8 + wave; row < MTOK; row += G * 8) {
        const float rs = pg8::row_rstd(ss, row);
#pragma unroll
        for (int i = 0; i < 4; ++i) { const int c = i * 256 + lane * 4; const f32x4 v = *(const f32x4*)(X + (size_t)row * DM + c), w = *(const f32x4*)(a.fnorm_w + c);
            *(f32x4*)(a.out + (size_t)row * DM + c) = v * rs * w; }
    }
}

__device__ __forceinline__ void zero_y3(const Args& a) {
    unsigned char* ws = a.ws; LAUNDER_S(ws);
    u32x4* p = (u32x4*)(ws + WS_Y3); const size_t n = (size_t)MTOK * 1536 * 2 / 16;
    for (size_t i = (size_t)blockIdx.x * NTHREADS + threadIdx.x; i < n; i += (size_t)gridDim.x * NTHREADS) p[i] = (u32x4){0u, 0u, 0u, 0u};
}

#ifndef PH_P0
#define PH_P0 1
#endif
#ifndef PH_A
#define PH_A 1
#endif
#ifndef PH_B
#define PH_B 1
#endif
#ifndef PH_C
#define PH_C 1
#endif
#ifndef PH_A2
#define PH_A2 1
#endif
#ifndef PH_D
#define PH_D 1
#endif
#ifndef PH_E
#define PH_E 1
#endif
__global__ void __launch_bounds__(NTHREADS, 2) fwd(Args a) {
    extern __shared__ __attribute__((aligned(16))) unsigned char lds_raw[];
    LAS unsigned char* lds = (LAS unsigned char*)lds_raw;
    const int tid = threadIdx.x, G = gridDim.x, bid = blockIdx.x;
    if (tid < 4) ((LAS unsigned*)(lds + LDS_BYTES - 16))[tid] = 0u;
    __syncthreads();
    unsigned char* ws = a.ws;
    XcdBarrier bar = xcd_barrier_post((unsigned*)(ws + WS_CTL), (volatile LAS unsigned*)(lds + LDS_BYTES - 16));

#if PH_P0
    p0_prologue(a, lds);
#endif
    xcd_barrier(bar);

    for (int l = 0; l < DEPTH; ++l) {
        LAUNDER_S(ws);
        f16* P16 = (f16*)(ws + WS_P16); f16* X16 = (f16*)(ws + WS_X16); float* X32 = a.out; float* SS = (float*)(ws + WS_SS);
        f16* Y3 = (f16*)(ws + WS_Y3);
        const f16* WinT = (const f16*)(ws + WS_WINT) + (size_t)l * 9216 * 1024;
#if PH_A
        { pg8::Gemm g{X16, WinT, MTOK, NA, DM, DM, DM}; pg8::StaticOrder S; S.init(MTOK, NA, G, bid);
          pg8::EpiScaleF16 E{P16, NA, SS}; pg8::gemm_phase(lds, g, S, E); }
        xcd_barrier(bar);
#endif
#if PH_B
        for (int u = bid; u < MTOK / 64; u += G) phase_b_unit(a, lds, l, u >> 6, u & 63);
        xcd_barrier(bar);
#endif
#if PH_C
        mlstm_scan(a, lds);
        { int t_ = threadIdx.x; asm volatile("" : "+v"(t_)); const int lane_ = t_ & 63, wave_ = __builtin_amdgcn_readfirstlane(t_ >> 6);
          for (int u = bid * 8 + wave_; u < NB * 8 * 128; u += G * 8) { const int qt = u & 127, h = (u >> 7) & 7, b = u >> 10;
            sb_attn_unit(P16, (const f16*)(ws + WS_VT), Y3, b, h, qt, lane_); } }
        for (int v = bid; v < 256; v += G) { const int p = v & 127, hf = v >> 7;
            for (int k4 = 0; k4 < 4; ++k4) dsa_unit(a, lds, l, 2 * hf + (k4 >> 1), (k4 & 1) ? 255 - p : p); }
        xcd_barrier(bar);
        { int t_ = threadIdx.x; asm volatile("" : "+v"(t_)); const int lane_ = t_ & 63, wave_ = __builtin_amdgcn_readfirstlane(t_ >> 6);
          for (int u = bid * 8 + wave_; u < 2048; u += G * 8) mlstm_out_unit(a, lds + wave_ * 1024, l, u >> 9, (u >> 3) & 63, (u >> 1) & 3, u & 1, lane_); }
        xcd_barrier(bar);
#endif
#if PH_A2
        { pg8::Gemm g{X16, WinT + (size_t)NA * DM, MTOK, NG, DM, DM, DM}; pg8::StaticOrder S; S.init(MTOK, NG, G, bid);
          pg8::EpiScaleF16 E{(f16*)(ws + WS_G16), NG, SS}; pg8::gemm_phase(lds, g, S, E); }
        xcd_barrier(bar);
#endif
#if PH_D
        { const f16* Wb = (const f16*)(ws + WS_WBRT) + (size_t)l * 3 * 1024 * 512; const f16* G16 = (const f16*)(ws + WS_G16);
          float* mix32 = (float*)(ws + WS_MIX32); f16* mix16 = (f16*)(ws + WS_MIX16);
          pg8::StaticOrder S; S.init(MTOK, DM, G, bid);
          { pg8::Gemm g{Y3, Wb, MTOK, DM, 512, 1536, 512}; pg8::EpiGate<0> E{G16, NG, mix32, mix16}; pg8::gemm_phase(lds, g, S, E); }
          { pg8::Gemm g{Y3 + 512, Wb + (size_t)1024 * 512, MTOK, DM, 512, 1536, 512}; pg8::EpiGate<1> E{G16 + 1024, NG, mix32, mix16}; pg8::gemm_phase(lds, g, S, E); }
          { pg8::Gemm g{Y3 + 1024, Wb + (size_t)2 * 1024 * 512, MTOK, DM, 512, 1536, 512}; pg8::EpiGate<2> E{G16 + 2048, NG, mix32, mix16}; pg8::gemm_phase(lds, g, S, E); } }
        xcd_barrier(bar);
#endif
#if PH_E
        { pg8::Gemm g{(const f16*)(ws + WS_MIX16), (const f16*)(ws + WS_WOUTT) + (size_t)l * DM * DM, MTOK, DM, DM, DM, DM}; pg8::StaticOrder S; S.init(MTOK, DM, G, bid);
          pg8::EpiResid E{l == 0 ? a.x : X32, X32, X16, SS}; pg8::gemm_phase(lds, g, S, E); }
        xcd_barrier(bar);
#endif
    }
    final_norm(a);
}

__global__ void fill_kernel(float* out, int n, float v) { for (int i = blockIdx.x * blockDim.x + threadIdx.x; i < n; i += gridDim.x * blockDim.x) out[i] = (i & 1) ? v : -v; }

extern "C" void kernel_launch(void* const* d_in, const int* in_sizes, int n_in, void* d_out, int out_size, void* d_ws, size_t ws_size, hipStream_t stream) {
    static int grid = 0;
    if (grid == 0) {
        int dev = 0, cus = 0;
        if (hipGetDevice(&dev) != hipSuccess || hipDeviceGetAttribute(&cus, hipDeviceAttributeMultiprocessorCount, dev) != hipSuccess) { grid = -1; }
        else if (hipFuncSetAttribute((const void*)fwd, hipFuncAttributeMaxDynamicSharedMemorySize, LDS_BYTES) != hipSuccess) { grid = -2; }
        else grid = cus;
        (void)hipGetLastError();
    }
    if (ws_size < WS_END || n_in != 13 || grid <= 0) {
        hipLaunchKernelGGL(fill_kernel, dim3(256), dim3(256), 0, stream, (float*)d_out, out_size, ws_size < WS_END ? 100.f : 30.f);
        return;
    }
    (void)hipMemsetAsync((char*)d_ws + WS_CTL, 0, CTL_BYTES, stream);
    Args a{};
    a.x = (const float*)d_in[0]; a.w_in = (const float*)d_in[1]; a.w_uk = (const float*)d_in[2]; a.w_uv = (const float*)d_in[3]; a.kvn_w = (const float*)d_in[4];
    a.conv_w = (const float*)d_in[5]; a.i_bias = (const float*)d_in[6]; a.f_bias = (const float*)d_in[7]; a.mln_w = (const float*)d_in[8]; a.w_branch = (const float*)d_in[9];
    a.w_out = (const float*)d_in[10]; a.norm_w = (const float*)d_in[11]; a.fnorm_w = (const float*)d_in[12];
    a.out = (float*)d_out; a.ws = (unsigned char*)d_ws;
    hipLaunchKernelGGL(fwd, dim3(grid), dim3(NTHREADS), LDS_BYTES, stream, a);
}
```

```cpp
#include <hip/hip_runtime.h>
#include <cstdio>
#include <cstdint>

#define LAS __attribute__((address_space(3)))
__device__ __forceinline__ unsigned opaque0() { unsigned z = 0; asm volatile("" : "+s"(z)); return z; }
#define LAUNDER_S(p) ((p) += opaque0())
typedef _Float16 f16;
typedef _Float16 f16x8 __attribute__((ext_vector_type(8)));
typedef _Float16 f16x4 __attribute__((ext_vector_type(4)));
typedef _Float16 f16x2 __attribute__((ext_vector_type(2)));
typedef float f32x4 __attribute__((ext_vector_type(4)));
typedef float f32x2 __attribute__((ext_vector_type(2)));
typedef float f32x16 __attribute__((ext_vector_type(16)));
typedef unsigned u32x4 __attribute__((ext_vector_type(4)));
typedef unsigned u32x2 __attribute__((ext_vector_type(2)));

constexpr int DM = 1024, NB = 4, SEQ = 4096, DEPTH = 4, MTOK = NB * SEQ;
constexpr int WIN_COLS = 9180;
constexpr int NA = 6144;
constexpr int NG = 3072;
constexpr float NORM_EPS = 1e-6f;
constexpr int C_DQ = 0, C_CKV = 512, C_KR = 640, C_IQ = 656, C_IK = 912, C_IW = 976, C_MI = 980, C_MF = 984;
constexpr int C_DZ = 1024, C_SQ = 1536, C_SK = 2048, C_SV = 2560, C_SZ = 3072, C_MQK = 3584, C_MV = 4608, C_MO = 5120, C_MZ = 5632;

#define XB_TMO      128
#define XB_XCNT(j)  (256  + 64 * (j))
#define XB_XSUB(j)  (1280 + 64 * (j))
#define XB_XGEN(j)  (2304 + 64 * (j))
#define XB_TOP      3328
#define XB_TOPGEN   3392
#define XCD_BAR_WORDS 3456
#define XB_SPIN_CAP (1u << 18)

__device__ __forceinline__ unsigned xb_ld(unsigned* p)              { return __hip_atomic_load(p, __ATOMIC_RELAXED, __HIP_MEMORY_SCOPE_AGENT); }
__device__ __forceinline__ unsigned xb_add(unsigned* p, unsigned v) { return __hip_atomic_fetch_add(p, v, __ATOMIC_RELAXED, __HIP_MEMORY_SCOPE_AGENT); }
__device__ __forceinline__ unsigned xb_xcc_id() { return (unsigned)__builtin_amdgcn_s_getreg((3 << 11) | 20) & 0xFu; }
#define XB_SPIN(cond, bar) do { unsigned _sp = 0; while (cond) { __builtin_amdgcn_s_sleep(1); \
    if ((++_sp & 255u) == 0u) { if (xb_ld(&(bar)[XB_TMO])) break; if (_sp > XB_SPIN_CAP) { atomicAdd(&(bar)[XB_TMO], 1u); break; } } } } while (0)

__device__ __forceinline__ int lane_id_() { return (int)__builtin_amdgcn_mbcnt_hi(~0u, __builtin_amdgcn_mbcnt_lo(~0u, opaque0())); }
#define TIDX(wv) ((wv) * 64 + lane_id_())
struct XcdBarrier { unsigned* bar; unsigned x; volatile LAS unsigned* st; int wv; };

__device__ __forceinline__ XcdBarrier xcd_barrier_post(unsigned* bar, volatile LAS unsigned* st, int wv) {
    XcdBarrier b; b.bar = bar; b.x = xb_xcc_id(); b.st = st; b.wv = wv;
    if (TIDX(wv) == 0) (void)xb_add(&bar[XB_XCNT(b.x)], 1u);
    return b;
}
__device__ __forceinline__ void xcd_barrier_complete(unsigned* bar, unsigned x, unsigned& nloc, unsigned& nx) {
    const unsigned G = gridDim.x * gridDim.y * gridDim.z;
    unsigned sum, cnt, mine, sp = 0u;
    for (;;) {
        sum = 0u; cnt = 0u; mine = 0u;
#pragma unroll
        for (unsigned j = 0; j < 16; ++j) { const unsigned c = xb_ld(&bar[XB_XCNT(j)]); sum += c; cnt += (c > 0u) ? 1u : 0u; mine = (j == x) ? c : mine; }
        if (sum == G) break;
        __builtin_amdgcn_s_sleep(1);
        if ((++sp & 255u) == 0u) { if (xb_ld(&bar[XB_TMO])) break; if (sp > XB_SPIN_CAP) { atomicAdd(&bar[XB_TMO], 1u); break; } }
    }
    nloc = mine > 0u ? mine : 1u; nx = cnt > 0u ? cnt : 1u;
}
__device__ __forceinline__ void xcd_barrier(const XcdBarrier& b) {
    asm volatile("s_waitcnt vmcnt(0)" ::: "memory");
    __syncthreads();
    if (TIDX(b.wv) == 0) {
        unsigned* bar = b.bar; LAUNDER_S(bar); const unsigned bx = b.x + opaque0();
        __builtin_amdgcn_s_waitcnt(0);
        unsigned nloc = b.st[0], nx = b.st[1];
        if (nloc == 0u) { xcd_barrier_complete(bar, bx, nloc, nx); b.st[0] = nloc; b.st[1] = nx; }
        const unsigned old = xb_add(&bar[XB_XSUB(bx)], 1u);
        const unsigned gen = old / nloc;
        if (old + 1u == (gen + 1u) * nloc) {
            __builtin_amdgcn_fence(__ATOMIC_RELEASE, "agent");
            asm volatile("s_waitcnt vmcnt(0)" ::: "memory");
            const unsigned og = xb_add(&bar[XB_TOP], 1u);
            const unsigned tg = og / nx;
            if (og + 1u == (tg + 1u) * nx) xb_add(&bar[XB_TOPGEN], 1u);
            else XB_SPIN(xb_ld(&bar[XB_TOPGEN]) == tg, bar);
            __builtin_amdgcn_fence(__ATOMIC_ACQUIRE, "agent");
            xb_add(&bar[XB_XGEN(bx)], 1u);
            asm volatile("s_waitcnt vmcnt(0)" ::: "memory");
        } else {
            XB_SPIN(xb_ld(&bar[XB_XGEN(bx)]) == gen, bar);
            __builtin_amdgcn_fence(__ATOMIC_ACQUIRE, "agent");
            asm volatile("s_waitcnt vmcnt(0)" ::: "memory");
        }
    }
    __syncthreads();
}


__device__ __forceinline__ float shx(float v, int m, int lane) { return __builtin_bit_cast(float, __builtin_amdgcn_ds_bpermute((lane ^ m) << 2, __builtin_bit_cast(int, v))); }
__device__ __forceinline__ unsigned shx(unsigned v, int m, int lane) { return (unsigned)__builtin_amdgcn_ds_bpermute((lane ^ m) << 2, (int)v); }
__device__ __forceinline__ float shu(float v, int o, int lane) { return __builtin_bit_cast(float, __builtin_amdgcn_ds_bpermute((lane - o) << 2, __builtin_bit_cast(int, v))); }
__device__ __forceinline__ unsigned shu(unsigned v, int o, int lane) { return (unsigned)__builtin_amdgcn_ds_bpermute((lane - o) << 2, (int)v); }
__device__ __forceinline__ float shi(float v, int src) { return __builtin_bit_cast(float, __builtin_amdgcn_ds_bpermute(src << 2, __builtin_bit_cast(int, v))); }
__device__ __forceinline__ unsigned shi(unsigned v, int src) { return (unsigned)__builtin_amdgcn_ds_bpermute(src << 2, (int)v); }

#define PIN4(a) asm volatile("" :: "v"((a)[0]), "v"((a)[1]), "v"((a)[2]), "v"((a)[3]))
#define PIN8(a) asm volatile("" :: "v"((a)[0]), "v"((a)[1]), "v"((a)[2]), "v"((a)[3]), "v"((a)[4]), "v"((a)[5]), "v"((a)[6]), "v"((a)[7]))

__device__ __forceinline__ float fast_exp(float x) { return __builtin_amdgcn_exp2f(x * 1.44269504088896340736f); }
__device__ __forceinline__ float fast_rcp(float x) { return __builtin_amdgcn_rcpf(x); }
__device__ __forceinline__ float sigmoidf_(float x) { return fast_rcp(1.0f + fast_exp(-x)); }
__device__ __forceinline__ float siluf_(float x) { return x * sigmoidf_(x); }
__device__ __forceinline__ float logsigmoidf_(float x) {
    return fminf(x, 0.0f) - log1pf(__expf(-fabsf(x)));
}

namespace pg8 {
constexpr int BM = 256, BK = 64, HALF = 128, HTB = HALF * BK * 2, STAGE_BYTES = 8 * HTB, NXCD = 8, WGM = 8;
__host__ __device__ __forceinline__ int lds_byte(int r, int c) { const int st = (r >> 4) * 2 + (c >> 5), rr = r & 15, cc = c & 31, ob = rr * 64 + cc * 2; return st * 1024 + (ob ^ (((ob >> 9) & 1) << 5)); }
__host__ __device__ __forceinline__ void stage_rc(int b, int& R, int& C) { const int st = b / 1024, sb = b % 1024, swz = sb ^ (((sb >> 9) & 1) << 5); R = (st >> 1) * 16 + swz / 64; C = (st & 1) * 32 + (swz % 64) / 2; }
__host__ __device__ __forceinline__ int perm32(int rho) { const int n = rho >> 4, i = rho & 15; return 8 * (i >> 2) + 4 * n + (i & 3); }

struct Unit { int pm, pn, ord; };
struct Gemm { const f16* A; const f16* Bt; int M, N, K, lda, ldb; };

struct StaticOrder {
    int nM, nN, nwg, G, c;
    __host__ __device__ void init(int M, int N, int G_, int c_) { nM = M / BM; nN = N / BM; nwg = nM * nN; G = G_; c = c_; }
    __host__ __device__ bool next(int i, Unit& u) const {
        const long L = (long)i * G + c; if (L >= nwg) return false;
        int wgid = (int)L; { const int q = nwg / NXCD, r = nwg % NXCD, xcd = wgid % NXCD, off = wgid / NXCD; wgid = (xcd < r ? xcd * (q + 1) : r * (q + 1) + (xcd - r) * q) + off; }
        const int nig = WGM * nN, gid = wgid / nig, fm = gid * WGM, gsz = (nM - fm) < WGM ? (nM - fm) : WGM;
        u.pm = fm + ((wgid % nig) % gsz); u.pn = (wgid % nig) / gsz; u.ord = i; return true;
    }
};

#ifndef GEMM_SP2
#define GEMM_SP2 true
#endif
#ifndef GEMM_ALIGN
#define GEMM_ALIGN true
#endif
template <class Epi, bool MID = false, bool SP2 = GEMM_SP2, bool ALIGN_EPI = GEMM_ALIGN>
__device__ __forceinline__ void gemm_phase(LAS unsigned char* lds, const Gemm g, const StaticOrder& S, const Epi& E, int wv) {
    int tid = TIDX(wv); asm volatile("" : "+v"(tid));
    const int wid = __builtin_amdgcn_readfirstlane(tid >> 6), lane = tid & 63, wr = wid >> 2, wc = wid & 3, fr = lane & 15, fq = lane >> 4;
    const int K = g.K, nt = K / BK;
    unsigned voffA[2], voffB[2];
#pragma unroll
    for (int i = 0; i < 2; ++i) { int R, C; stage_rc(tid * 16 + i * 8192, R, C); const int Rb = (R & ~31) + perm32(R & 31);
        voffA[i] = (unsigned)(R * g.lda + C) * 2u; voffB[i] = (unsigned)(Rb * g.ldb + C) * 2u; }
    const size_t kstep = (size_t)(BK * 2);
    const size_t hstepA = (size_t)HALF * g.lda * 2, hstepB = (size_t)HALF * g.ldb * 2;
    const size_t tstepA = 2 * hstepA, tstepB = 2 * hstepB;
    const unsigned ldsw = (unsigned)wid * 1024u;
    const int aoff = lds_byte(wr * 64 + fr, fq * 8), boff = lds_byte(wc * 32 + fr, fq * 8);
#define PG8_SA(b, h) (((b) * 2 + (h)) * HTB)
#define PG8_SB(b, h) ((4 + (b) * 2 + (h)) * HTB)
#define PG8_STAGE(bufoff, gbase, voff) do { _Pragma("unroll") for (int _i = 0; _i < 2; ++_i) \
        __builtin_amdgcn_global_load_lds((const unsigned*)((const char*)(gbase) + (voff)[_i]), (LAS unsigned*)(lds + (bufoff) + ldsw + _i * 8192), 16, 0, 0); } while (0)
#define PG8_LDA(dst, b, h) do { _Pragma("unroll") for (int m = 0; m < 4; ++m) _Pragma("unroll") for (int k = 0; k < 2; ++k) dst[m][k] = *(const LAS f16x8*)(lds + PG8_SA(b, h) + aoff + m * 2048 + k * 1024); } while (0)
#define PG8_LDB(dst, b, h) do { _Pragma("unroll") for (int n = 0; n < 2; ++n) _Pragma("unroll") for (int k = 0; k < 2; ++k) dst[n][k] = *(const LAS f16x8*)(lds + PG8_SB(b, h) + boff + n * 2048 + k * 1024); } while (0)
#define PG8_MMA(ai, bj, At, Bt) do { __builtin_amdgcn_s_setprio(1); _Pragma("unroll") for (int m = 0; m < 4; ++m) _Pragma("unroll") for (int n = 0; n < 2; ++n) _Pragma("unroll") for (int k = 0; k < 2; ++k) \
        acc[ai][bj][m][n] = __builtin_amdgcn_mfma_f32_16x16x32_f16(Bt[n][k], At[m][k], acc[ai][bj][m][n], 0, 0, 0); __builtin_amdgcn_s_setprio(0); } while (0)
#define PG8_WAIT_V(n) asm volatile("s_waitcnt vmcnt(" #n ")" ::: "memory")
#define PG8_WAIT_L(n) asm volatile("s_waitcnt lgkmcnt(" #n ")" ::: "memory")
#define PG8_BAR __builtin_amdgcn_s_barrier()
#define PG8_SCHED __builtin_amdgcn_sched_barrier(0)
    Unit cur, nxt; int ui = 0;
    if (!S.next(0, cur)) return;
#ifdef TIMING
    if (blockIdx.x == 0 && tid == 0) { LAS unsigned long long* ts_ = (LAS unsigned long long*)(lds + 147456 - 512); ts_[26] = __builtin_amdgcn_s_memtime(); }
#endif
    f32x4 acc[2][2][4][2];
#pragma unroll
    for (int a = 0; a < 2; ++a)
#pragma unroll
        for (int b = 0; b < 2; ++b)
#pragma unroll
            for (int m = 0; m < 4; ++m)
#pragma unroll
                for (int n = 0; n < 2; ++n) acc[a][b][m][n] = (f32x4){0.f, 0.f, 0.f, 0.f};
    f16x8 At[4][2], B0[2][2], B1[2][2];
    const char* cA = (const char*)g.A + (size_t)cur.pm * tstepA; const char* cB = (const char*)g.Bt + (size_t)cur.pn * tstepB;
    if constexpr (SP2) {
        PG8_STAGE(PG8_SB(0, 0), cB, voffB); PG8_STAGE(PG8_SB(0, 1), cB + hstepB, voffB); PG8_STAGE(PG8_SA(0, 0), cA, voffA); PG8_STAGE(PG8_SA(0, 1), cA + hstepA, voffA);
        if (wr == 1) PG8_BAR;
        PG8_WAIT_V(2); PG8_BAR;
        PG8_STAGE(PG8_SB(1, 0), cB + kstep, voffB); PG8_STAGE(PG8_SA(1, 0), cA + kstep, voffA); PG8_STAGE(PG8_SB(1, 1), cB + hstepB + kstep, voffB);
        PG8_WAIT_V(6); PG8_BAR;
    } else {
        PG8_STAGE(PG8_SB(0, 0), cB, voffB); PG8_STAGE(PG8_SA(0, 0), cA, voffA); PG8_STAGE(PG8_SB(0, 1), cB + hstepB, voffB); PG8_STAGE(PG8_SA(0, 1), cA + hstepA, voffA);
        if (wr == 1) PG8_BAR;
        PG8_WAIT_V(4); PG8_BAR;
        PG8_STAGE(PG8_SB(1, 0), cB + kstep, voffB); PG8_STAGE(PG8_SA(1, 0), cA + kstep, voffA); PG8_STAGE(PG8_SB(1, 1), cB + hstepB + kstep, voffB);
        PG8_WAIT_V(6); PG8_BAR;
    }
    for (;;) {
        const bool has_next = S.next(ui + 1, nxt);
        const char* nA = has_next ? (const char*)g.A + (size_t)nxt.pm * tstepA : cA; const char* nB = has_next ? (const char*)g.Bt + (size_t)nxt.pn * tstepB : cB;
        for (int t = 0; t < nt; t += 2) {
            if constexpr (MID) { if (t == 8 || t == 16) E.mid(acc, cur, t >> 3, wr, wc, fr, fq); }
            const bool last = (t == nt - 2);
            const char* a1 = cA + (size_t)(t + 1) * kstep;
            const char* a2 = last ? nA : cA + (size_t)(t + 2) * kstep; const char* b2 = last ? nB : cB + (size_t)(t + 2) * kstep;
            const char* a3 = a2 + kstep; const char* b3 = b2 + kstep;
            if constexpr (SP2) {
            PG8_LDB(B0, 0, 0); PG8_LDB(B1, 0, 1); PG8_SCHED; PG8_LDA(At, 0, 0); PG8_STAGE(PG8_SA(1, 1), a1 + hstepA, voffA);
            PG8_WAIT_V(8); PG8_WAIT_L(0); PG8_BAR; PG8_MMA(0, 0, At, B0); PG8_MMA(0, 1, At, B1); PG8_BAR; PG8_SCHED;
            PG8_LDA(At, 0, 1); PG8_STAGE(PG8_SB(0, 0), b2, voffB); PG8_STAGE(PG8_SB(0, 1), b2 + hstepB, voffB); PG8_STAGE(PG8_SA(0, 0), a2, voffA);
            PG8_WAIT_V(8); PG8_WAIT_L(0); PG8_BAR; PG8_MMA(1, 0, At, B0); PG8_MMA(1, 1, At, B1); PG8_BAR; PG8_SCHED;
            PG8_LDB(B0, 1, 0); PG8_LDB(B1, 1, 1); PG8_SCHED; PG8_LDA(At, 1, 0); PG8_STAGE(PG8_SA(0, 1), a2 + hstepA, voffA);
            PG8_WAIT_V(8); PG8_WAIT_L(0); PG8_BAR; PG8_MMA(0, 0, At, B0); PG8_MMA(0, 1, At, B1); PG8_BAR; PG8_SCHED;
            PG8_LDA(At, 1, 1); PG8_STAGE(PG8_SB(1, 0), b3, voffB); PG8_STAGE(PG8_SB(1, 1), b3 + hstepB, voffB); PG8_STAGE(PG8_SA(1, 0), a3, voffA);
            PG8_WAIT_V(8); PG8_WAIT_L(0); PG8_BAR; PG8_MMA(1, 0, At, B0); PG8_MMA(1, 1, At, B1); PG8_BAR; PG8_SCHED;
            } else {
            PG8_LDB(B0, 0, 0); PG8_SCHED; PG8_LDA(At, 0, 0); PG8_STAGE(PG8_SA(1, 1), a1 + hstepA, voffA);
            PG8_WAIT_L(8); PG8_BAR; PG8_WAIT_L(0); PG8_MMA(0, 0, At, B0); PG8_BAR; PG8_SCHED;
            PG8_LDB(B1, 0, 1); PG8_STAGE(PG8_SB(0, 0), b2, voffB);
            PG8_BAR; PG8_WAIT_L(0); PG8_MMA(0, 1, At, B1); PG8_BAR;
            PG8_LDA(At, 0, 1); PG8_STAGE(PG8_SA(0, 0), a2, voffA);
            PG8_BAR; PG8_WAIT_L(0); PG8_MMA(1, 0, At, B0); PG8_BAR; PG8_SCHED;
            PG8_STAGE(PG8_SB(0, 1), b2 + hstepB, voffB);
            PG8_WAIT_V(6); PG8_BAR; PG8_MMA(1, 1, At, B1); PG8_BAR;
            PG8_LDB(B0, 1, 0); PG8_SCHED; PG8_LDA(At, 1, 0); PG8_STAGE(PG8_SA(0, 1), a2 + hstepA, voffA);
            PG8_WAIT_L(8); PG8_BAR; PG8_WAIT_L(0); PG8_MMA(0, 0, At, B0); PG8_BAR; PG8_SCHED;
            PG8_LDB(B1, 1, 1); PG8_STAGE(PG8_SB(1, 0), b3, voffB);
            PG8_BAR; PG8_WAIT_L(0); PG8_MMA(0, 1, At, B1); PG8_BAR;
            PG8_LDA(At, 1, 1); PG8_STAGE(PG8_SA(1, 0), a3, voffA);
            PG8_BAR; PG8_WAIT_L(0); PG8_MMA(1, 0, At, B0); PG8_BAR; PG8_SCHED;
            PG8_STAGE(PG8_SB(1, 1), b3 + hstepB, voffB);
            PG8_WAIT_V(6); PG8_BAR; PG8_MMA(1, 1, At, B1); PG8_BAR;
            }
        }
        if constexpr (ALIGN_EPI) { if (wr == 0) PG8_BAR; }
#ifdef TIMING
        if (blockIdx.x == 0 && tid == 0) { LAS unsigned long long* ts_ = (LAS unsigned long long*)(lds + 147456 - 512); const unsigned long long t_ = wall_clock64(); ts_[28] += t_ - ts_[16]; ts_[16] = t_;
            const unsigned long long c_ = __builtin_amdgcn_s_memtime(); ts_[27] += (c_ - ts_[26]) / 100ull; }
#endif
        E(acc, cur, wr, wc, fr, fq);
#ifdef TIMING
        if (blockIdx.x == 0 && tid == 0) { LAS unsigned long long* ts_ = (LAS unsigned long long*)(lds + 147456 - 512); const unsigned long long t_ = wall_clock64(); ts_[29] += t_ - ts_[16]; ts_[16] = t_; ts_[26] = __builtin_amdgcn_s_memtime(); }
#endif
        if (!has_next) break;
#pragma unroll
        for (int a = 0; a < 2; ++a)
#pragma unroll
            for (int b = 0; b < 2; ++b)
#pragma unroll
                for (int m = 0; m < 4; ++m)
#pragma unroll
                    for (int n = 0; n < 2; ++n) acc[a][b][m][n] = (f32x4){0.f, 0.f, 0.f, 0.f};
        cur = nxt; cA = nA; cB = nB; ++ui;
        if constexpr (ALIGN_EPI) { if (wr == 1) PG8_BAR; }
    }
    PG8_WAIT_V(0);
    if constexpr (!ALIGN_EPI) { if (wr == 0) PG8_BAR; }
    PG8_BAR;
#undef PG8_SA
#undef PG8_SB
#undef PG8_STAGE
#undef PG8_LDA
#undef PG8_LDB
#undef PG8_MMA
#undef PG8_WAIT_V
#undef PG8_WAIT_L
#undef PG8_BAR
#undef PG8_SCHED
}

__device__ __forceinline__ unsigned pk_f16(float a, float b) { f16x2 v; v.x = (f16)a; v.y = (f16)b; return __builtin_bit_cast(unsigned, v); }
__device__ __forceinline__ float row_rstd(const float* ss, int row) {
    const f32x4* p = (const f32x4*)(ss + (size_t)row * 16);
    const f32x4 a = p[0], b = p[1], c = p[2], d = p[3];
    const float s = ((a[0] + a[1]) + (a[2] + a[3])) + ((b[0] + b[1]) + (b[2] + b[3])) + ((c[0] + c[1]) + (c[2] + c[3])) + ((d[0] + d[1]) + (d[2] + d[3]));
    return 1.0f / sqrtf(s * (1.0f / DM) + NORM_EPS);
}

constexpr int RS_SLOTS = 14;
__device__ __forceinline__ void rs_tables(LAS float* rs, const float* ss, const StaticOrder& S, int wv) {
    int tid = TIDX(wv); asm volatile("" : "+v"(tid));
    LAS unsigned char* slot = (LAS unsigned char*)(rs + RS_SLOTS * BM);
    Unit u; int ns = 0, prev = -1;
    for (int i = 0; i < 64 && S.next(i, u); ++i) {
        if (u.pm != prev) { if (ns < RS_SLOTS) { if (tid < BM) rs[ns * BM + tid] = row_rstd(ss, u.pm * BM + tid); ++ns; } prev = u.pm; }
        if (tid == 0) slot[i] = (unsigned char)(ns - 1);
    }
    __syncthreads();
}
template <bool SIG> struct EpiScaleF16T {
    f16* O; int ldc; const LAS float* rs;
    __device__ __forceinline__ void operator()(const f32x4 (&acc)[2][2][4][2], const Unit& u, int wr, int wc, int fr, int fq) const {
        const int row0 = u.pm * BM + wr * 64 + fr, col0 = u.pn * BM + wc * 32 + 8 * fq;
        const __amdgpu_buffer_rsrc_t orsrc = __builtin_amdgcn_make_buffer_rsrc((void*)O, 0, MTOK * ldc * 2, 0x00020000);
        float rsv[8];
        { const LAS float* rp = rs + (int)((const LAS unsigned char*)(rs + RS_SLOTS * BM))[u.ord] * BM + wr * 64 + fr;
#pragma unroll
          for (int k = 0; k < 8; ++k) rsv[k] = rp[(k >> 2) * HALF + (k & 3) * 16]; }
#pragma unroll
        for (int ai = 0; ai < 2; ++ai)
#pragma unroll
            for (int m = 0; m < 4; ++m) { const int row = row0 + ai * HALF + m * 16; const float rs = rsv[ai * 4 + m]; const int rowb = (row * ldc + col0) * 2;
#pragma unroll
                for (int bj = 0; bj < 2; ++bj) { f32x4 v0 = acc[ai][bj][m][0] * rs, v1 = acc[ai][bj][m][1] * rs;
                    if (SIG) {
#pragma unroll
                        for (int j = 0; j < 4; ++j) { v0[j] = fmaxf(sigmoidf_(v0[j]), 6.103515625e-05f); v1[j] = fmaxf(sigmoidf_(v1[j]), 6.103515625e-05f); } }
                    u32x4 w; w.x = pk_f16(v0[0], v0[1]); w.y = pk_f16(v0[2], v0[3]); w.z = pk_f16(v1[0], v1[1]); w.w = pk_f16(v1[2], v1[3]);
                    __builtin_amdgcn_raw_buffer_store_b128(w, orsrc, rowb + bj * HALF * 2, 0, 16); } }
    }
};
typedef EpiScaleF16T<false> EpiScaleF16;
struct EpiMerge {
    const f16* gate; f16* mix16;
    __device__ __forceinline__ void mid(f32x4 (&acc)[2][2][4][2], const Unit& u, int seg, int wr, int wc, int fr, int fq) const {
        int row0 = u.pm * BM + wr * 64 + fr; const int col0 = u.pn * BM + wc * 32 + 8 * fq;
        asm volatile("" : "+v"(row0));
#define EM_LD(GA, GB, Q4) do { _Pragma("unroll") for (int i = 0; i < 4; ++i) { const int ai = (Q4) >> 1, m = ((Q4) & 1) * 2 + (i >> 1), bj = i & 1; \
            const f16* gp = gate + (size_t)(row0 + ai * HALF + m * 16) * NG + (seg - 1) * 1024 + col0 + bj * HALF; GA[i] = *(const f16x8*)gp; GB[i] = *(const f16x8*)(gp + 1024); } } while (0)
#define EM_AP(GA, GB, Q4) do { PIN4(GA); PIN4(GB); _Pragma("unroll") for (int i = 0; i < 4; ++i) { const int ai = (Q4) >> 1, m = ((Q4) & 1) * 2 + (i >> 1), bj = i & 1; \
            _Pragma("unroll") for (int j = 0; j < 4; ++j) { acc[ai][bj][m][0][j] *= (float)GA[i][j] * fast_rcp((float)GB[i][j]); acc[ai][bj][m][1][j] *= (float)GA[i][4 + j] * fast_rcp((float)GB[i][4 + j]); } } } while (0)
        f16x8 ga0[4], gb0[4], ga1[4], gb1[4];
        EM_LD(ga0, gb0, 0); EM_LD(ga1, gb1, 1); __builtin_amdgcn_sched_barrier(0);
        EM_AP(ga0, gb0, 0); __builtin_amdgcn_sched_barrier(0); EM_LD(ga0, gb0, 2); __builtin_amdgcn_sched_barrier(0);
        EM_AP(ga1, gb1, 1); __builtin_amdgcn_sched_barrier(0); EM_LD(ga1, gb1, 3); __builtin_amdgcn_sched_barrier(0);
        EM_AP(ga0, gb0, 2); EM_AP(ga1, gb1, 3);
#undef EM_LD
#undef EM_AP
    }
    __device__ __forceinline__ void operator()(const f32x4 (&acc)[2][2][4][2], const Unit& u, int wr, int wc, int fr, int fq) const {
        const int row0 = u.pm * BM + wr * 64 + fr, col0 = u.pn * BM + wc * 32 + 8 * fq;
        f16x8 gvA[8], gvB[8];
#pragma unroll
        for (int i = 0; i < 8; ++i) { gvA[i] = *(const f16x8*)(gate + (size_t)(row0 + (i >> 1) * 16) * NG + 2048 + col0 + (i & 1) * HALF);
                                      gvB[i] = *(const f16x8*)(gate + (size_t)(row0 + HALF + (i >> 1) * 16) * NG + 2048 + col0 + (i & 1) * HALF); }
        __builtin_amdgcn_sched_barrier(0);
#pragma unroll
        for (int ai = 0; ai < 2; ++ai) {
            if (ai == 0) PIN8(gvA); else PIN8(gvB);
#pragma unroll
            for (int m = 0; m < 4; ++m) { const int row = row0 + ai * HALF + m * 16;
#pragma unroll
                for (int bj = 0; bj < 2; ++bj) { const int col = col0 + bj * HALF;
                    const f16x8 gv = ai == 0 ? gvA[m * 2 + bj] : gvB[m * 2 + bj];
                    f32x4 v0 = acc[ai][bj][m][0], v1 = acc[ai][bj][m][1];
#pragma unroll
                    for (int j = 0; j < 4; ++j) { v0[j] *= (float)gv[j]; v1[j] *= (float)gv[4 + j]; }
                    u32x4 w; w.x = pk_f16(v0[0], v0[1]); w.y = pk_f16(v0[2], v0[3]); w.z = pk_f16(v1[0], v1[1]); w.w = pk_f16(v1[2], v1[3]);
                    *(u32x4*)(mix16 + (size_t)row * DM + col) = w; } } }
    }
};
struct EpiResid {
    f16* x16; float* ss;
    __device__ __forceinline__ void operator()(const f32x4 (&acc)[2][2][4][2], const Unit& u, int wr, int wc, int fr, int fq) const {
        const int row0 = u.pm * BM + wr * 64 + fr, col0 = u.pn * BM + wc * 32 + 8 * fq;
        f16x8 xvA[8], xvB[8];
#pragma unroll
        for (int i = 0; i < 8; ++i) { xvA[i] = *(const f16x8*)(x16 + (size_t)(row0 + (i >> 1) * 16) * DM + col0 + (i & 1) * HALF);
                                      xvB[i] = *(const f16x8*)(x16 + (size_t)(row0 + HALF + (i >> 1) * 16) * DM + col0 + (i & 1) * HALF); }
        __builtin_amdgcn_sched_barrier(0);
#pragma unroll
        for (int ai = 0; ai < 2; ++ai) {
            if (ai == 0) PIN8(xvA); else PIN8(xvB);
#pragma unroll
            for (int m = 0; m < 4; ++m) { const int row = row0 + ai * HALF + m * 16; float sq = 0.f;
#pragma unroll
                for (int bj = 0; bj < 2; ++bj) { const size_t off = (size_t)row * DM + col0 + bj * HALF; const f16x8 xr = ai == 0 ? xvA[m * 2 + bj] : xvB[m * 2 + bj];
                    f32x4 v0 = acc[ai][bj][m][0], v1 = acc[ai][bj][m][1];
#pragma unroll
                    for (int j = 0; j < 4; ++j) { v0[j] += (float)xr[j]; v1[j] += (float)xr[4 + j]; }
                    u32x4 w; w.x = pk_f16(v0[0], v0[1]); w.y = pk_f16(v0[2], v0[3]); w.z = pk_f16(v1[0], v1[1]); w.w = pk_f16(v1[2], v1[3]);
                    *(u32x4*)(x16 + off) = w;
                    sq += (v0[0] * v0[0] + v0[1] * v0[1]) + (v0[2] * v0[2] + v0[3] * v0[3]) + (v1[0] * v1[0] + v1[1] * v1[1]) + (v1[2] * v1[2] + v1[3] * v1[3]); }
                { const int ln_ = fq * 16 + fr; sq += shx(sq, 16, ln_); sq += shx(sq, 32, ln_); }
                if (fq == 0) ss[(size_t)row * 16 + u.pn * 4 + wc] = sq; }
        }
    }
};
}

constexpr size_t WS_CTL   = 0;
constexpr size_t CTL_BYTES = 65536;
constexpr size_t WS_WINT  = WS_CTL + CTL_BYTES;
constexpr size_t WS_WBRT  = WS_WINT + (size_t)DEPTH * 9216 * 1024 * 2;
constexpr size_t WS_WOUTT = WS_WBRT + (size_t)DEPTH * 3 * 1024 * 512 * 2;
constexpr size_t WS_WUK   = WS_WOUTT + (size_t)DEPTH * 1024 * 1024 * 2;
constexpr size_t WS_WUV   = WS_WUK + (size_t)DEPTH * 8 * 128 * 64 * 2;
constexpr size_t WS_ROPE  = WS_WUV + (size_t)DEPTH * 8 * 64 * 128 * 2;
constexpr size_t WS_X16   = WS_ROPE + (size_t)SEQ * 16 * 4;
constexpr size_t WS_SS    = WS_X16 + (size_t)MTOK * DM * 2;
constexpr size_t WS_P16   = WS_SS + (size_t)MTOK * 16 * 4;
constexpr size_t WS_G16   = WS_P16;
constexpr size_t WS_MIX16 = WS_P16 + (size_t)MTOK * NG * 2;
constexpr size_t WS_QC    = WS_P16 + (size_t)MTOK * NA * 2;
constexpr size_t WS_KV    = WS_QC + (size_t)MTOK * 8 * 160 * 2;
constexpr size_t WS_IQ    = WS_KV + (size_t)MTOK * 160 * 2;
constexpr size_t WS_IK    = WS_IQ + (size_t)MTOK * 256 * 2;
constexpr size_t WS_IW    = WS_IK + (size_t)MTOK * 64 * 2;
constexpr size_t WS_MLQ   = WS_IW + (size_t)MTOK * 4 * 4;
constexpr size_t WS_MLK   = WS_MLQ + (size_t)MTOK * 512 * 2;
constexpr size_t WS_VT    = WS_MLK + (size_t)MTOK * 512 * 2;
constexpr size_t WS_MLVT  = WS_VT + (size_t)MTOK * 512 * 2;
constexpr size_t WS_GATE  = WS_MLVT + (size_t)MTOK * 512 * 2;
constexpr size_t WS_CHS   = WS_GATE + (size_t)MTOK * 8 * 4;
constexpr size_t WS_DN    = WS_CHS + (size_t)16 * 64 * 4 * 4;
constexpr size_t WS_Y3    = WS_DN + (size_t)16 * 64 * 128 * 4;
constexpr size_t WS_DCT   = WS_Y3 + (size_t)MTOK * 1536 * 2;
constexpr size_t WS_END   = WS_DCT + (size_t)16 * 64 * 16384 * 2;

constexpr int LDS_STAGE = 131072;
constexpr int LDS_BYTES = 147456;
constexpr int LDS_MISC  = LDS_STAGE;
constexpr int NTHREADS = 512;

struct Args {
    const float* x; const float* w_in; const float* w_uk; const float* w_uv; const float* kvn_w; const float* conv_w; const float* i_bias; const float* f_bias;
    const float* mln_w; const float* w_branch; const float* w_out; const float* norm_w; const float* fnorm_w;
    float* out; unsigned char* ws;
    int wv, pad_;
};

__device__ __forceinline__ int win_src_col(int n) {
    if (n < 980) return n;
    if (n < 984) return 5076 + (n - 980);
    if (n < 988) return 5080 + (n - 984);
    if (n < 1024) return -1;
    if (n < 1536) return 980 + (n - 1024);
    if (n < 3584) return 1492 + (n - 1536);
    if (n < 4608) return 3540 + (n - 3584);
    if (n < 5120) return 4564 + (n - 4608);
    if (n < 5632) return 5084 + (n - 5120);
    if (n < 6144) return 5596 + (n - 5632);
    return 6108 + (n - 6144);
}

struct ConvTile { const float* src; const float* scale; f16* dst; int src_ld, dst_ld, k0, n0, winmap; };
__device__ __forceinline__ ConvTile conv_desc(const Args& a, unsigned char* ws, int u) {
    constexpr int T_WIN = DEPTH * 16 * 144, T_WBR = DEPTH * 3 * 8 * 16, T_WOUT = DEPTH * 16 * 16;
    ConvTile d;
    if (u < T_WIN) { const int l = u / (16 * 144), r = u % (16 * 144), kt = r / 144, nt = r % 144;
        d.src = a.w_in + (size_t)l * DM * WIN_COLS; d.src_ld = WIN_COLS; d.k0 = kt * 64; d.n0 = nt * 64; d.dst = (f16*)(ws + WS_WINT) + (size_t)l * 9216 * 1024; d.dst_ld = 1024; d.scale = a.norm_w + l * DM; d.winmap = 1;
    } else if (u < T_WIN + T_WBR) { const int v = u - T_WIN, lg = v / 128, r = v % 128, kt = r / 16, nt = r % 16;
        d.src = a.w_branch + (size_t)lg * 512 * 1024; d.src_ld = 1024; d.k0 = kt * 64; d.n0 = nt * 64; d.dst = (f16*)(ws + WS_WBRT) + (size_t)(lg / 3) * 1024 * 1536 + (lg % 3) * 512; d.dst_ld = 1536; d.scale = nullptr; d.winmap = 0;
    } else if (u < T_WIN + T_WBR + T_WOUT) { const int v = u - T_WIN - T_WBR, l = v / 256, r = v % 256, kt = r / 16, nt = r % 16;
        d.src = a.w_out + (size_t)l * DM * DM; d.src_ld = DM; d.k0 = kt * 64; d.n0 = nt * 64; d.dst = (f16*)(ws + WS_WOUTT) + (size_t)l * DM * DM; d.dst_ld = DM; d.scale = nullptr; d.winmap = 0;
    } else { const int v = u - T_WIN - T_WBR - T_WOUT, l = v / 16, r = v % 16, kt = r / 8, nt = r % 8;
        d.src = a.w_uv + (size_t)l * 128 * 512; d.src_ld = 512; d.k0 = kt * 64; d.n0 = nt * 64; d.dst = (f16*)(ws + WS_WUV) + (size_t)l * 512 * 128; d.dst_ld = 128; d.scale = nullptr; d.winmap = 0; }
    return d;
}
__device__ __forceinline__ void conv_load(const ConvTile& d, int tid, float (&vv)[8], float (&sv)[8]) {
    const int c = tid & 63, r0 = tid >> 6; const int sc = d.winmap ? win_src_col(d.n0 + c) : (d.n0 + c); const int scl = sc >= 0 ? sc : 0;
    const float* sp = d.scale ? d.scale : d.src;
#pragma unroll
    for (int i = 0; i < 8; ++i) { const int r = r0 + 8 * i; vv[i] = d.src[(size_t)(d.k0 + r) * d.src_ld + scl]; sv[i] = sp[d.k0 + r]; }
}

__device__ __forceinline__ void p0_prologue(const Args& a, LAS unsigned char* lds) {
    LAS float* t = (LAS float*)lds;
    unsigned char* ws = a.ws; LAUNDER_S(ws);
    const int G = gridDim.x, bid = blockIdx.x; int tid = TIDX(a.wv); asm volatile("" : "+v"(tid));
    constexpr int T_ALL = DEPTH * 16 * 144 + DEPTH * 3 * 8 * 16 + DEPTH * 16 * 16 + DEPTH * 2 * 8;
    { float nv[8], ns[8]; conv_load(conv_desc(a, ws, bid < T_ALL ? bid : 0), tid, nv, ns);
      for (int u = bid; u < T_ALL; u += G) {
        const ConvTile d = conv_desc(a, ws, u);
        float vv[8];
        { const int cc = tid & 63; const bool pad = d.winmap && win_src_col(d.n0 + cc) < 0; const bool hs = d.scale != nullptr;
#pragma unroll
          for (int i = 0; i < 8; ++i) vv[i] = pad ? 0.f : (hs ? nv[i] * ns[i] : nv[i]); }
        conv_load(conv_desc(a, ws, u + G < T_ALL ? u + G : u), tid, nv, ns);
        const int c = tid & 63, r0 = tid >> 6;
#pragma unroll
        for (int i = 0; i < 8; ++i) t[(r0 + 8 * i) * 65 + c] = vv[i];
        __syncthreads();
        { const int n = tid >> 3, kg = tid & 7; f16x8 v;
#pragma unroll
          for (int j = 0; j < 8; ++j) v[j] = (f16)t[(8 * kg + j) * 65 + n];
          *(f16x8*)(d.dst + (size_t)(d.n0 + n) * d.dst_ld + d.k0 + 8 * kg) = v; }
        __syncthreads();
      } }
    const size_t gtid = (size_t)bid * NTHREADS + tid, gsz = (size_t)G * NTHREADS;
    for (size_t i = gtid; i < (size_t)DEPTH * 8 * 128 * 64; i += gsz) { const int k = i & 63, r = (i >> 6) & 127, h = (i >> 13) & 7, l = (int)(i >> 16);
        ((f16*)(ws + WS_WUK))[i] = k < 48 ? (f16)a.w_uk[(((size_t)l * 128 + r) * 8 + h) * 48 + k] : (f16)0.f; }
    for (size_t i = gtid; i < (size_t)SEQ * 8; i += gsz) { const int pos = (int)(i >> 3), j = (int)(i & 7);
        const double inv[8] = {1.0, 0.19392274474868576, 0.03760603093086393, 0.007292664737217109, 0.001414213562373095, 0.0002742481756762073, 5.318295896944988e-05, 1.031338537721246e-05};
        double iv = inv[0];
#pragma unroll
        for (int q = 1; q < 8; ++q) iv = (j == q) ? inv[q] : iv;
        const double x = (double)pos * iv, n = rint(x * 0.15915494309189535);
        const double r = (x - n * 6.283185307179586) - n * 2.4492935982947064e-16;
        float* rp = (float*)(ws + WS_ROPE) + (size_t)pos * 16;
        rp[j] = cosf((float)r); rp[8 + j] = sinf((float)r); }
    { const int wave = tid >> 6, lane = tid & 63;
      for (int row = bid * 8 + wave; row < MTOK; row += G * 8) {
        const float* xr = a.x + (size_t)row * DM; f16* o = (f16*)(ws + WS_X16) + (size_t)row * DM; float sq = 0.f;
#pragma unroll
        for (int i = 0; i < 4; ++i) { const f32x4 v = *(const f32x4*)(xr + i * 256 + lane * 4); sq += (v[0] * v[0] + v[1] * v[1]) + (v[2] * v[2] + v[3] * v[3]);
            u32x2 w; w.x = pg8::pk_f16(v[0], v[1]); w.y = pg8::pk_f16(v[2], v[3]); *(u32x2*)(o + i * 256 + lane * 4) = w; }
#pragma unroll
        for (int o2 = 32; o2 >= 1; o2 >>= 1) sq += shx(sq, o2, lane);
        if (lane < 16) ((float*)(ws + WS_SS))[(size_t)row * 16 + lane] = lane == 0 ? sq : 0.f;
      } }
}

__device__ __forceinline__ void sb_attn_unit(const f16* __restrict__ P16, const f16* __restrict__ VT, f16* __restrict__ Y3, int b, int h, int qt, int lane_in) {
    int lane = lane_in; asm volatile("" : "+v"(lane));
    const int q0 = qt * 32, hh = lane >> 5, ln = lane & 31;
    const size_t rowq = (size_t)(b * SEQ + q0 + ln) * NA;
    f16x8 qf[4];
#pragma unroll
    for (int s = 0; s < 4; ++s) qf[s] = *(const f16x8*)(P16 + rowq + C_SQ + h * 64 + 16 * s + 8 * hh);
    f32x16 o0, o1;
#pragma unroll
    for (int r = 0; r < 16; ++r) { o0[r] = 0.f; o1[r] = 0.f; }
    float carry = 1.0f;
    const f16* vt = VT + ((size_t)(b * 8 + h) * 64) * SEQ;
    const int query = q0 + ln;
    for (int kt = qt; kt >= 0; --kt) {
        const int k0 = kt * 32;
        const f16* kp = P16 + (size_t)(b * SEQ + k0 + ln) * NA + C_SK + h * 64 + 8 * hh;
        f32x16 z;
#pragma unroll
        for (int r = 0; r < 16; ++r) z[r] = 0.f;
        { f16x8 kfa[4];
#pragma unroll
          for (int s = 0; s < 4; ++s) kfa[s] = *(const f16x8*)(kp + 16 * s);
          PIN4(kfa);
#pragma unroll
          for (int s = 0; s < 4; ++s) z = __builtin_amdgcn_mfma_f32_32x32x16_f16(kfa[s], qf[s], z, 0, 0, 0); }
        float av[16], p[4], pp[4];
#pragma unroll
        for (int a = 0; a < 4; ++a) {
            float st[4], be[4];
#pragma unroll
            for (int c = 0; c < 4; ++c) { const int key = k0 + c + 8 * a + 4 * hh; const bool valid = key < query;
                const float zz = fminf(z[4 * a + c] * 0.125f, 80.f); const float u = fast_exp(zz); const float s_ = fast_rcp(1.0f + u);
                st[c] = valid ? s_ : 1.0f; be[c] = valid ? u * s_ : 0.0f; }
            const float s2 = st[3], s1 = s2 * st[2], s0 = s1 * st[1];
            p[a] = s0 * st[0];
            av[4 * a + 3] = be[3]; av[4 * a + 2] = be[2] * s2; av[4 * a + 1] = be[1] * s1; av[4 * a + 0] = be[0] * s0;
        }
#pragma unroll
        for (int a = 0; a < 4; ++a) pp[a] = shx(p[a], 32, lane);
        const float T0 = p[0] * pp[0], T1 = p[1] * pp[1], T2 = p[2] * pp[2], T3 = p[3] * pp[3];
        float grp[4];
        grp[3] = carry; grp[2] = carry * T3; grp[1] = grp[2] * T2; grp[0] = grp[1] * T1;
        const float ncarry = grp[0] * T0;
        if (hh == 0) {
#pragma unroll
            for (int a = 0; a < 4; ++a) grp[a] *= pp[a];
        }
        f16x8 bf0, bf1;
#pragma unroll
        for (int j = 0; j < 8; ++j) { bf0[j] = (f16)(av[j] * grp[j >> 2]); bf1[j] = (f16)(av[8 + j] * grp[2 + (j >> 2)]); }
        { f16x8 va[4];
#pragma unroll
          for (int dt = 0; dt < 2; ++dt) { const f16* vp = vt + (size_t)(32 * dt + ln) * SEQ + k0 + 4 * hh;
            { const f16x4 lo = *(const f16x4*)(vp), hi = *(const f16x4*)(vp + 8); va[2 * dt] = __builtin_shufflevector(lo, hi, 0, 1, 2, 3, 4, 5, 6, 7); }
            { const f16x4 lo = *(const f16x4*)(vp + 16), hi = *(const f16x4*)(vp + 24); va[2 * dt + 1] = __builtin_shufflevector(lo, hi, 0, 1, 2, 3, 4, 5, 6, 7); } }
          PIN4(va);
          o0 = __builtin_amdgcn_mfma_f32_32x32x16_f16(va[0], bf0, o0, 0, 0, 0); o0 = __builtin_amdgcn_mfma_f32_32x32x16_f16(va[1], bf1, o0, 0, 0, 0);
          o1 = __builtin_amdgcn_mfma_f32_32x32x16_f16(va[2], bf0, o1, 0, 0, 0); o1 = __builtin_amdgcn_mfma_f32_32x32x16_f16(va[3], bf1, o1, 0, 0, 0); }
        carry = ncarry;
        if (__all(carry < 1e-30f)) break;
    }
    const size_t rowt = (size_t)(b * SEQ + query);
    f16x4 zgv[8];
#pragma unroll
    for (int i = 0; i < 8; ++i) zgv[i] = *(const f16x4*)(P16 + rowt * NA + C_SZ + h * 64 + 32 * (i >> 2) + 8 * (i & 3) + 4 * hh);
#pragma unroll
    for (int dt = 0; dt < 2; ++dt)
#pragma unroll
        for (int a = 0; a < 4; ++a) { const int dim = 32 * dt + 8 * a + 4 * hh;
            f16x4 y;
#pragma unroll
            for (int c = 0; c < 4; ++c) { const float ov = dt == 0 ? o0[4 * a + c] : o1[4 * a + c]; y[c] = (f16)(ov * siluf_((float)zgv[4 * dt + a][c])); }
            *(f16x4*)(Y3 + rowt * 1536 + 512 + h * 64 + dim) = y; }
}

__device__ __forceinline__ void transpose_slab(LAS unsigned char* lds, const f16* __restrict__ P16, int coff, int b, int s0, f16* __restrict__ dstT, int wv);

#ifdef TIMING
#define BSTAMP(k) do { if (blockIdx.x == 0 && TIDX(a.wv) == 0) { LAS unsigned long long* ts_ = (LAS unsigned long long*)(lds + LDS_BYTES - 512); const unsigned long long t_ = wall_clock64(); ts_[k] += t_ - ts_[16]; ts_[16] = t_; } } while (0)
#else
#define BSTAMP(k) do {} while (0)
#endif
__device__ __forceinline__ void phase_b_unit(const Args& a, LAS unsigned char* lds, int l, int b, int ck) {
    int tid = TIDX(a.wv); asm volatile("" : "+v"(tid));
    const int wave = __builtin_amdgcn_readfirstlane(tid >> 6), lane = tid & 63;
    unsigned char* ws = a.ws; LAUNDER_S(ws);
    const f16* __restrict__ P16 = (const f16*)(ws + WS_P16);
    const int s0 = ck * 64; const size_t tok0 = (size_t)b * SEQ + s0;
    const float* __restrict__ rope = (const float*)(ws + WS_ROPE);

    transpose_slab(lds, P16, C_SV, b, s0, (f16*)(ws + WS_VT), a.wv);
    transpose_slab(lds, P16, C_MV, b, s0, (f16*)(ws + WS_MLVT), a.wv);

    BSTAMP(18);
    { f16* __restrict__ KV = (f16*)(ws + WS_KV);
      const float w0 = a.kvn_w[l * 128 + 2 * lane], w1 = a.kvn_w[l * 128 + 2 * lane + 1];
      f16x2 xv[8]; float k1[8], k2[8], rc[8], rsn[8];
#pragma unroll
      for (int i = 0; i < 8; ++i) { const int s = wave * 8 + i; const f16* pr = P16 + (tok0 + s) * NA;
        xv[i] = *(const f16x2*)(pr + C_CKV + 2 * lane); k1[i] = (float)pr[C_KR + (lane & 7)]; k2[i] = (float)pr[C_KR + 8 + (lane & 7)];
        rc[i] = rope[(s0 + s) * 16 + (lane & 7)]; rsn[i] = rope[(s0 + s) * 16 + 8 + (lane & 7)]; }
      PIN8(xv); PIN8(k1); PIN8(k2); PIN8(rc); PIN8(rsn);
#pragma unroll
      for (int i = 0; i < 8; ++i) { const int s = wave * 8 + i; const size_t t = tok0 + s;
        const float x0 = (float)xv[i][0], x1 = (float)xv[i][1];
        float sq = x0 * x0 + x1 * x1;
#pragma unroll
        for (int o = 32; o >= 1; o >>= 1) sq += shx(sq, o, lane);
        const float rs = 1.0f / sqrtf(sq * (1.0f / 128.0f) + NORM_EPS);
        f16x2 o2; o2[0] = (f16)(x0 * rs * w0); o2[1] = (f16)(x1 * rs * w1);
        *(f16x2*)(KV + t * 160 + 2 * lane) = o2;
        if (lane < 8) { KV[t * 160 + 128 + lane] = (f16)(k1[i] * rc[i] - k2[i] * rsn[i]); KV[t * 160 + 136 + lane] = (f16)(k2[i] * rc[i] + k1[i] * rsn[i]); }
        else if (lane < 16) { f16x2 z; z[0] = (f16)0.f; z[1] = (f16)0.f; *(f16x2*)(KV + t * 160 + 144 + 2 * (lane - 8)) = z; }
      } }
    { f16* __restrict__ IQ = (f16*)(ws + WS_IQ); f16* __restrict__ IK = (f16*)(ws + WS_IK); float* __restrict__ IW = (float*)(ws + WS_IW);
      f16x8 vv[5], ov[5]; f32x4 rca[5], rcb[5], rsa[5], rsb[5];
#pragma unroll
      for (int i = 0; i < 5; ++i) { const int e = tid + 512 * i, s = e / 40, c0 = (e % 40) * 8; const f16* pr = P16 + (tok0 + s) * NA + C_IQ;
        vv[i] = *(const f16x8*)(pr + c0); ov[i] = *(const f16x8*)(pr + (c0 ^ 8));
        const float* rp = rope + (s0 + s) * 16; rca[i] = *(const f32x4*)rp; rcb[i] = *(const f32x4*)(rp + 4); rsa[i] = *(const f32x4*)(rp + 8); rsb[i] = *(const f32x4*)(rp + 12); }
      asm volatile("" :: "v"(vv[0]), "v"(vv[1]), "v"(vv[2]), "v"(vv[3]), "v"(vv[4]), "v"(ov[0]), "v"(ov[1]), "v"(ov[2]), "v"(ov[3]), "v"(ov[4]));
      asm volatile("" :: "v"(rca[0]), "v"(rca[1]), "v"(rca[2]), "v"(rca[3]), "v"(rca[4]), "v"(rcb[0]), "v"(rcb[1]), "v"(rcb[2]), "v"(rcb[3]), "v"(rcb[4]));
      asm volatile("" :: "v"(rsa[0]), "v"(rsa[1]), "v"(rsa[2]), "v"(rsa[3]), "v"(rsa[4]), "v"(rsb[0]), "v"(rsb[1]), "v"(rsb[2]), "v"(rsb[3]), "v"(rsb[4]));
#pragma unroll
      for (int i = 0; i < 5; ++i) { const int e = tid + 512 * i, s = e / 40, c0 = (e % 40) * 8; const size_t t = tok0 + s; const int d0 = c0 & 63;
        f16x8 v = vv[i];
        if (d0 < 16) {
#pragma unroll
            for (int jj = 0; jj < 8; ++jj) { const float cs = jj < 4 ? rca[i][jj & 3] : rcb[i][jj & 3], sn = jj < 4 ? rsa[i][jj & 3] : rsb[i][jj & 3];
                v[jj] = (f16)(d0 == 0 ? (float)vv[i][jj] * cs - (float)ov[i][jj] * sn : (float)vv[i][jj] * cs + (float)ov[i][jj] * sn); } }
        if (c0 < 256) *(f16x8*)(IQ + t * 256 + c0) = v; else *(f16x8*)(IK + t * 64 + (c0 - 256)) = v; }
      if (tid < 256) { const int s = tid >> 2, h = tid & 3; IW[(tok0 + s) * 4 + h] = (float)P16[(tok0 + s) * NA + C_IW + h]; } }
    BSTAMP(19);
    { const int h = wave, fr = lane & 15, fq = lane >> 4; f16* __restrict__ QC = (f16*)(ws + WS_QC);
      const f16* Wk = (const f16*)(ws + WS_WUK) + ((size_t)(l * 8 + h) * 128) * 64;
      f16x8 af[4][2], wb0[8], wb1[8];
#pragma unroll
      for (int mt = 0; mt < 4; ++mt)
#pragma unroll
        for (int ks = 0; ks < 2; ++ks) af[mt][ks] = *(const f16x8*)(P16 + (tok0 + 16 * mt + fr) * NA + C_DQ + h * 64 + 16 + 32 * ks + 8 * fq);
#pragma unroll
      for (int rt = 0; rt < 8; ++rt) { wb0[rt] = *(const f16x8*)(Wk + (size_t)(16 * rt + fr) * 64 + 8 * fq); wb1[rt] = *(const f16x8*)(Wk + (size_t)(16 * rt + fr) * 64 + 32 + 8 * fq); }
      PIN8(&af[0][0]); PIN8(wb0); PIN8(wb1);
#pragma unroll
      for (int rt = 0; rt < 8; ++rt) {
        const f16x8 b0 = wb0[rt], b1 = wb1[rt];
#pragma unroll
        for (int mt = 0; mt < 4; ++mt) { f32x4 acc = (f32x4){0.f, 0.f, 0.f, 0.f};
            acc = __builtin_amdgcn_mfma_f32_16x16x32_f16(b0, af[mt][0], acc, 0, 0, 0); acc = __builtin_amdgcn_mfma_f32_16x16x32_f16(b1, af[mt][1], acc, 0, 0, 0);
            f16x4 o; o[0] = (f16)(acc[0] * 0.125f); o[1] = (f16)(acc[1] * 0.125f); o[2] = (f16)(acc[2] * 0.125f); o[3] = (f16)(acc[3] * 0.125f);
            *(f16x4*)(QC + ((tok0 + 16 * mt + fr) * 8 + h) * 160 + 16 * rt + 4 * fq) = o; }
      }
      { const size_t t = tok0 + lane; const f16* pr = P16 + t * NA + C_DQ + h * 64; f16* qo = QC + (t * 8 + h) * 160 + 128;
        const f16x8 x1 = *(const f16x8*)pr, x2 = *(const f16x8*)(pr + 8); f16x8 o1, o2, z;
#pragma unroll
        for (int j = 0; j < 8; ++j) { const float cs = rope[(s0 + lane) * 16 + j], sn = rope[(s0 + lane) * 16 + 8 + j];
            o1[j] = (f16)(((float)x1[j] * cs - (float)x2[j] * sn) * 0.125f); o2[j] = (f16)(((float)x2[j] * cs + (float)x1[j] * sn) * 0.125f); z[j] = (f16)0.f; }
        *(f16x8*)qo = o1; *(f16x8*)(qo + 8) = o2; *(f16x8*)(qo + 16) = z; *(f16x8*)(qo + 24) = z; } }

    BSTAMP(23);
    LAS float* wf = (LAS float*)(lds + 73728);
    if (wave < 4) { const int h = wave; const size_t t = tok0 + lane;
        const float iv = (float)P16[t * NA + C_MI + h] + a.i_bias[l * 4 + h];
        const float fv = (float)P16[t * NA + C_MF + h] + a.f_bias[l * 4 + h];
        float bcum = logsigmoidf_(fv);
#pragma unroll
        for (int o = 1; o < 64; o <<= 1) { const float u = shu(bcum, o, lane); if (lane >= o) bcum += u; }
        const float blast = shi(bcum, 63);
        const float lw = blast - bcum + iv; float ml = lw;
#pragma unroll
        for (int o = 32; o >= 1; o >>= 1) ml = fmaxf(ml, shx(ml, o, lane));
        f32x2 gg; gg[0] = bcum; gg[1] = iv - bcum; *(f32x2*)((float*)(ws + WS_GATE) + (t * 4 + h) * 2) = gg;
        wf[h * 64 + lane] = __expf(lw - ml);
        if (lane == 0) { f32x4 cs; cs[0] = blast; cs[1] = ml; cs[2] = 0.f; cs[3] = 0.f; *(f32x4*)((float*)(ws + WS_CHS) + ((size_t)(b * 4 + h) * 64 + ck) * 4) = cs; } }
    __syncthreads();
    constexpr int RST = 144;
    { const int cg = tid & 127, tg = tid >> 7;
      const float* cw = a.conv_w + (size_t)l * 4 * 1024 + 8 * cg;
      f32x4 w[4][2];
#pragma unroll
      for (int jj = 0; jj < 4; ++jj) { w[jj][0] = *(const f32x4*)(cw + jj * 1024); w[jj][1] = *(const f32x4*)(cw + jj * 1024 + 4); }
      const int sb = 16 * tg; f16x8 x[19];
#pragma unroll
      for (int i = 0; i < 19; ++i) { const int s = sb - 3 + i;
          if (s >= 0 || ck > 0) x[i] = *(const f16x8*)(P16 + (size_t)((long)tok0 + s) * NA + C_MQK + 8 * cg); else {
#pragma unroll
              for (int e = 0; e < 8; ++e) x[i][e] = (f16)0.f; } }
      f16* __restrict__ dstq = (cg < 64 ? (f16*)(ws + WS_MLQ) : (f16*)(ws + WS_MLK)) + 8 * (cg & 63);
      const float osc = cg < 64 ? 1.0f : 0.08838834764831845f; const int hrow = (cg & 63) >> 4;
      f16x8 kwa[8], kwb[8];
#pragma unroll
      for (int s = 0; s < 16; ++s) { f16x8 o; const float wfs = wf[hrow * 64 + sb + s];
#pragma unroll
          for (int e = 0; e < 8; ++e) { const float u = w[0][e >> 2][e & 3] * (float)x[s][e] + w[1][e >> 2][e & 3] * (float)x[s + 1][e] + w[2][e >> 2][e & 3] * (float)x[s + 2][e] + w[3][e >> 2][e & 3] * (float)x[s + 3][e];
              const float y = siluf_(u) * osc; o[e] = (f16)y; if (s < 8) kwa[e][s] = (f16)(y * wfs); else kwb[e][s - 8] = (f16)(y * wfs); }
          *(f16x8*)(dstq + (tok0 + sb + s) * 512) = o; }
      if (cg >= 64) {
#pragma unroll
          for (int e = 0; e < 8; ++e) { LAS unsigned char* rp = lds + (8 * (cg - 64) + e) * RST + sb * 2; *(LAS f16x8*)rp = kwa[e]; *(LAS f16x8*)(rp + 16) = kwb[e]; } } }
    __syncthreads();
    BSTAMP(25);
    { const int et = wave & 3, dt0 = (wave >> 2) * 2, ln = lane & 31, hh = lane >> 5;
      const f16* MVT = (const f16*)(ws + WS_MLVT); f16* DCT = (f16*)(ws + WS_DCT);
      f16x8 vfr[4][4];
#pragma unroll
      for (int h = 0; h < 4; ++h)
#pragma unroll
        for (int ks = 0; ks < 4; ++ks) vfr[h][ks] = *(const f16x8*)(MVT + ((size_t)(b * 512 + h * 128 + 32 * et + ln)) * SEQ + s0 + 8 * hh + 16 * ks);
      PIN8(&vfr[0][0]); PIN8(&vfr[2][0]);
#pragma unroll
      for (int h = 0; h < 4; ++h) {
        f32x16 acc0, acc1;
#pragma unroll
        for (int r = 0; r < 16; ++r) { acc0[r] = 0.f; acc1[r] = 0.f; }
#pragma unroll
        for (int ks = 0; ks < 4; ++ks) { const f16x8 af = vfr[h][ks];
            const f16x8 b0 = *(const LAS f16x8*)(lds + (h * 128 + 32 * dt0 + ln) * RST + (16 * ks + 8 * hh) * 2);
            const f16x8 b1 = *(const LAS f16x8*)(lds + (h * 128 + 32 * (dt0 + 1) + ln) * RST + (16 * ks + 8 * hh) * 2);
            acc0 = __builtin_amdgcn_mfma_f32_32x32x16_f16(b0, af, acc0, 0, 0, 0); acc1 = __builtin_amdgcn_mfma_f32_32x32x16_f16(b1, af, acc1, 0, 0, 0); }
        f16* dst = DCT + ((size_t)(b * 4 + h) * 64 + ck) * 16384 + (size_t)(32 * et + ln) * 128;
#pragma unroll
        for (int aa = 0; aa < 4; ++aa) { f16x4 o0, o1;
#pragma unroll
            for (int c = 0; c < 4; ++c) { o0[c] = (f16)acc0[4 * aa + c]; o1[c] = (f16)acc1[4 * aa + c]; }
            *(f16x4*)(dst + 32 * dt0 + 8 * aa + 4 * hh) = o0; *(f16x4*)(dst + 32 * (dt0 + 1) + 8 * aa + 4 * hh) = o1; }
      }
      { float sn = 0.f;
#pragma unroll
        for (int i = 0; i < 8; ++i) { const f16x8 v = *(const LAS f16x8*)(lds + tid * RST + i * 16);
#pragma unroll
            for (int j = 0; j < 8; ++j) sn += (float)v[j]; }
        ((float*)(ws + WS_DN))[((size_t)(b * 4 + (tid >> 7)) * 64 + ck) * 128 + (tid & 127)] = sn; } }
    __syncthreads();
}

__device__ __forceinline__ void mlstm_scan(const Args& a, LAS unsigned char* lds) {
    int tid = TIDX(a.wv); asm volatile("" : "+v"(tid));
    unsigned char* ws = a.ws; LAUNDER_S(ws);
    LAS float* tabA = (LAS float*)lds; LAS float* tabC = tabA + 64; LAS float* tabB = tabA + 128;
    for (int v = blockIdx.x; v < 256; v += gridDim.x) {
        const int bh = v >> 4, part = v & 15;
        float* chs = (float*)(ws + WS_CHS) + (size_t)bh * 64 * 4;
        f16x2* p = (f16x2*)((f16*)(ws + WS_DCT) + (size_t)bh * 64 * 16384 + part * 1024 + tid * 2);
        f16x2 d[64];
#pragma unroll
        for (int j = 0; j < 64; ++j) d[j] = p[(size_t)j * 8192];
        if (tid < 64) {
            const f32x4 c = *(const f32x4*)(chs + tid * 4); const float bl = c[0], ml = c[1];
            float B = bl, M = ml;
#pragma unroll
            for (int o = 1; o < 64; o <<= 1) { const float Bp = shu(B, o, tid), Mp = shu(M, o, tid); if (tid >= o) { M = fmaxf(B + Mp, M); B += Bp; } }
            const float mnext = fmaxf(B, M); float mprev = shu(mnext, 1, tid); if (tid == 0) mprev = 0.f;
            tabA[tid] = __expf(bl + mprev - mnext); tabC[tid] = __expf(ml - mnext); tabB[tid] = mprev; }
        __syncthreads();
        if (part == 0 && tid < 64) chs[tid * 4 + 2] = tabB[tid];
        float c0 = 0.f, c1 = 0.f;
#pragma unroll
        for (int j = 0; j < 64; ++j) { f16x2 o; o[0] = (f16)c0; o[1] = (f16)c1; p[(size_t)j * 8192] = o;
            const float aa = tabA[j], cc = tabC[j]; c0 = aa * c0 + cc * (float)d[j][0]; c1 = aa * c1 + cc * (float)d[j][1]; }
        if (part == 0 && tid < 128) { float* pn = (float*)(ws + WS_DN) + (size_t)bh * 64 * 128 + tid; float n = 0.f;
            for (int k0 = 0; k0 < 64; k0 += 32) { float d[32];
#pragma unroll
                for (int j = 0; j < 32; ++j) d[j] = pn[(k0 + j) * 128];
#pragma unroll
                for (int j = 0; j < 32; ++j) { pn[(k0 + j) * 128] = n; n = tabA[k0 + j] * n + tabC[k0 + j] * d[j]; } } }
        __syncthreads();
    }
}

__device__ __forceinline__ void mlstm_out_unit(const Args& a, LAS unsigned char* wlds  , int l, int b, int ck, int h, int th, int lane_in) {
    int lane = lane_in; asm volatile("" : "+v"(lane));
    unsigned char* ws = a.ws; LAUNDER_S(ws);
    const int ln = lane & 31, hh = lane >> 5, s0 = ck * 64; const size_t tok0 = (size_t)b * SEQ + s0;
    const int bh = b * 4 + h;
    const f16* __restrict__ MLQ = (const f16*)(ws + WS_MLQ); const f16* __restrict__ MLK = (const f16*)(ws + WS_MLK);
    const f16* __restrict__ MVT = (const f16*)(ws + WS_MLVT) + ((size_t)(b * 512 + h * 128)) * SEQ + s0;
    const f16* __restrict__ CT = (const f16*)(ws + WS_DCT) + ((size_t)bh * 64 + ck) * 16384;
    const float* __restrict__ NS = (const float*)(ws + WS_DN) + ((size_t)bh * 64 + ck) * 128;
    const float mk = ((const float*)(ws + WS_CHS))[((size_t)bh * 64 + ck) * 4 + 2];
    LAS float* gtab = (LAS float*)wlds;
    LAS float* ntab = gtab + 64;
    const f32x2 bg = *(const f32x2*)((const float*)(ws + WS_GATE) + ((tok0 + lane) * 4 + h) * 2);
    float pmx = bg[1];
#pragma unroll
    for (int o = 1; o < 64; o <<= 1) { const float u = shu(pmx, o, lane); if (lane >= o) pmx = fmaxf(pmx, u); }
    gtab[lane] = bg[1]; ntab[lane] = NS[lane]; ntab[64 + lane] = NS[64 + lane];
    const int tl = 32 * th + ln;
    const float bt = shi(bg[0], tl), Mt = fmaxf(shi(pmx, tl), mk);
    const float w_inter = __expf(mk - Mt), m_row = bt + Mt;
    f16x8 qf[8]; float qn = 0.f;
#pragma unroll
    for (int ks = 0; ks < 8; ++ks) qf[ks] = *(const f16x8*)(MLQ + (tok0 + tl) * 512 + h * 128 + 16 * ks + 8 * hh);
    PIN8(qf);
#pragma unroll
    for (int ks = 0; ks < 8; ++ks) {
#pragma unroll
        for (int j = 0; j < 8; ++j) qn += (float)qf[ks][j] * ntab[16 * ks + 8 * hh + j]; }
    qn += shx(qn, 32, lane);
    f32x16 acc[4];
#pragma unroll
    for (int et = 0; et < 4; ++et)
#pragma unroll
        for (int r = 0; r < 16; ++r) acc[et][r] = 0.f;
#pragma unroll
    for (int et = 0; et < 4; ++et) { f16x8 cfa[8];
#pragma unroll
        for (int ks = 0; ks < 8; ++ks) cfa[ks] = *(const f16x8*)(CT + (size_t)(32 * et + ln) * 128 + 16 * ks + 8 * hh);
        PIN8(cfa);
#pragma unroll
        for (int ks = 0; ks < 8; ++ks) acc[et] = __builtin_amdgcn_mfma_f32_32x32x16_f16(cfa[ks], qf[ks], acc[et], 0, 0, 0); }
#pragma unroll
    for (int et = 0; et < 4; ++et)
#pragma unroll
        for (int r = 0; r < 16; ++r) acc[et][r] *= w_inter;
    float den = 0.f;
    for (int st = 0; st <= th; ++st) {
        f32x16 z;
#pragma unroll
        for (int r = 0; r < 16; ++r) z[r] = 0.f;
        { f16x8 kfa[8];
#pragma unroll
          for (int ks = 0; ks < 8; ++ks) kfa[ks] = *(const f16x8*)(MLK + (tok0 + 32 * st + ln) * 512 + h * 128 + 16 * ks + 8 * hh);
          PIN8(kfa);
#pragma unroll
          for (int ks = 0; ks < 8; ++ks) z = __builtin_amdgcn_mfma_f32_32x32x16_f16(kfa[ks], qf[ks], z, 0, 0, 0); }
        f16x8 bf0, bf1;
#pragma unroll
        for (int aa = 0; aa < 4; ++aa) { const f32x4 gv = *(const LAS f32x4*)(gtab + 32 * st + 8 * aa + 4 * hh);
#pragma unroll
            for (int c = 0; c < 4; ++c) { const int s = 32 * st + 8 * aa + 4 * hh + c; const float w = s <= tl ? __expf(gv[c] - Mt) : 0.f; const float sw = z[4 * aa + c] * w; den += sw;
                if (aa < 2) bf0[4 * aa + c] = (f16)sw; else bf1[4 * (aa - 2) + c] = (f16)sw; } }
        { f16x8 va[8];
#pragma unroll
          for (int et = 0; et < 4; ++et) { const f16* vp = MVT + (size_t)(32 * et + ln) * SEQ + 32 * st + 4 * hh;
            { const f16x4 lo = *(const f16x4*)(vp), hi = *(const f16x4*)(vp + 8); va[2 * et] = __builtin_shufflevector(lo, hi, 0, 1, 2, 3, 4, 5, 6, 7); }
            { const f16x4 lo = *(const f16x4*)(vp + 16), hi = *(const f16x4*)(vp + 24); va[2 * et + 1] = __builtin_shufflevector(lo, hi, 0, 1, 2, 3, 4, 5, 6, 7); } }
          PIN8(va);
#pragma unroll
          for (int et = 0; et < 4; ++et) { acc[et] = __builtin_amdgcn_mfma_f32_32x32x16_f16(va[2 * et], bf0, acc[et], 0, 0, 0); acc[et] = __builtin_amdgcn_mfma_f32_32x32x16_f16(va[2 * et + 1], bf1, acc[et], 0, 0, 0); } }
    }
    den += shx(den, 32, lane);
    den += w_inter * qn;
    const float inv = 1.0f / fmaxf(fabsf(den), __expf(-m_row));
    float sm = 0.f;
#pragma unroll
    for (int et = 0; et < 4; ++et)
#pragma unroll
        for (int r = 0; r < 16; ++r) { acc[et][r] *= inv; sm += acc[et][r]; }
    sm += shx(sm, 32, lane);
    const float mu = sm * (1.0f / 128.0f); float vs = 0.f;
#pragma unroll
    for (int et = 0; et < 4; ++et)
#pragma unroll
        for (int r = 0; r < 16; ++r) { const float d = acc[et][r] - mu; vs += d * d; }
    vs += shx(vs, 32, lane);
    const float rstd = 1.0f / sqrtf(vs * (1.0f / 128.0f) + NORM_EPS);
    const f16* __restrict__ P16 = (const f16*)(ws + WS_P16); f16* Y3 = (f16*)(ws + WS_Y3);
    const size_t t = tok0 + tl;
    asm volatile("" ::: "memory");
#pragma unroll
    for (int eh = 0; eh < 4; ++eh) {
        f16x4 og[4], zg[4]; f32x4 nw[4];
#pragma unroll
        for (int i = 0; i < 4; ++i) { const int et = eh, aa = i, e = 32 * et + 8 * aa + 4 * hh;
            og[i] = *(const f16x4*)(P16 + t * NA + C_MO + h * 128 + e); zg[i] = *(const f16x4*)(P16 + t * NA + C_MZ + h * 128 + e);
            nw[i] = *(const f32x4*)(a.mln_w + l * 512 + h * 128 + e); }
#pragma unroll
        for (int i = 0; i < 4; ++i) { const int et = eh, aa = i, e = 32 * et + 8 * aa + 4 * hh;
            f16x4 y;
#pragma unroll
            for (int c = 0; c < 4; ++c) y[c] = (f16)((acc[et][4 * aa + c] - mu) * rstd * nw[i][c] * sigmoidf_((float)og[i][c]) * siluf_((float)zg[i][c]));
            *(f16x4*)(Y3 + t * 1536 + 1024 + h * 128 + e) = y; }
    }
}

constexpr int DL_HIST = 0;
constexpr int DL_RS = 304;
constexpr int DL_STAGE_W = 32 * DL_RS;
constexpr int DL_SELB = 8 * DL_STAGE_W;
constexpr int DL_EQB  = DL_SELB + 8192;
constexpr int DL_LIST = DL_EQB + 8192;
constexpr int DL_QST  = DL_LIST + 8192;
constexpr int DL_OL   = DL_QST + 1024;
constexpr int DL_END  = DL_OL + 32768;
static_assert(DL_END <= LDS_BYTES - 16, "DSA LDS map");


__device__ __forceinline__ unsigned okey(unsigned bits) { const unsigned m = (unsigned)((int)bits >> 31) | 0x80000000u; return bits == 0xFF800000u ? 0u : (bits ^ m); }
__device__ __forceinline__ unsigned fdig(unsigned bits) { const f16 hf = (f16)__uint_as_float(bits); const unsigned h = (unsigned)__builtin_bit_cast(unsigned short, hf);
    const unsigned m = (unsigned)((int)(h << 16) >> 31) | 0x8000u; return ((h ^ m) & 0xFFFFu) >> 5; }
#ifdef TIMING
#define DSTAMP(k) do { if (blockIdx.x == 0 && TIDX(a.wv) == 0) { LAS unsigned long long* ts_ = (LAS unsigned long long*)(lds + LDS_BYTES - 512); const unsigned long long t_ = wall_clock64(); ts_[k] += t_ - ts_[16]; ts_[16] = t_; } } while (0)
#else
#define DSTAMP(k) do {} while (0)
#endif
__device__ __forceinline__ void dsa_unit(const Args& a, LAS unsigned char* lds, int l, int b, int j) {
    int tid = TIDX(a.wv); asm volatile("" : "+v"(tid));
    const int wave = __builtin_amdgcn_readfirstlane(tid >> 6), lane = tid & 63, fr = lane & 15, fq = lane >> 4;
    unsigned char* ws = a.ws; LAUNDER_S(ws);
    const int t0 = 16 * j; const size_t tokb = (size_t)b * SEQ;
    const f16* __restrict__ IQ = (const f16*)(ws + WS_IQ); const f16* __restrict__ IK = (const f16*)(ws + WS_IK); const float* __restrict__ IW = (const float*)(ws + WS_IW);
    LAS unsigned* hist = (LAS unsigned*)(lds + DL_HIST); LAS unsigned* selb = (LAS unsigned*)(lds + DL_SELB); LAS unsigned* eqb = (LAS unsigned*)(lds + DL_EQB);
    LAS unsigned short* list = (LAS unsigned short*)(lds + DL_LIST); LAS unsigned* qst = (LAS unsigned*)(lds + DL_QST); LAS unsigned* nselp = qst + 64;

    if (tid < 16) { const int t = t0 + tid; const unsigned need = (unsigned)(t + 1 < 256 ? t + 1 : 256); qst[tid * 4 + 0] = 0u; qst[tid * 4 + 1] = 0u; qst[tid * 4 + 2] = need; qst[tid * 4 + 3] = 0u; nselp[tid] = need; }
    for (int i = tid; i < 4096; i += NTHREADS) selb[i] = 0u;

    u32x4 sk[32];
    {
        f16x8 iqf[4][2]; float iw[4];
#pragma unroll
        for (int h = 0; h < 4; ++h) { iw[h] = IW[(tokb + t0 + fr) * 4 + h];
#pragma unroll
            for (int ks = 0; ks < 2; ++ks) iqf[h][ks] = *(const f16x8*)(IQ + (tokb + t0 + fr) * 256 + h * 64 + 32 * ks + 8 * fq); }
        const int ntm0 = (j >= wave ? ((j - wave) >> 3) + 1 : 0) + (int)opaque0();
        const f16* kbase = IK + (tokb + 16 * wave + fr) * 64 + 8 * fq;
#pragma unroll
        for (int g8 = 0; g8 < 4; ++g8) {
            if (8 * g8 < ntm0) {
                f16x8 ka[8][2];
#pragma unroll
                for (int ii = 0; ii < 8; ++ii) { const f16* kp = kbase + (size_t)(8 * g8 + ii) * 128 * 64; ka[ii][0] = *(const f16x8*)kp; ka[ii][1] = *(const f16x8*)(kp + 32); }
#pragma unroll
                for (int ii = 0; ii < 8; ++ii) { const int i = 8 * g8 + ii, kt = wave + 8 * i;
                    f32x4 sc = (f32x4){0.f, 0.f, 0.f, 0.f};
#pragma unroll
                    for (int h = 0; h < 4; ++h) { f32x4 c = (f32x4){0.f, 0.f, 0.f, 0.f};
                        c = __builtin_amdgcn_mfma_f32_16x16x32_f16(ka[ii][0], iqf[h][0], c, 0, 0, 0); c = __builtin_amdgcn_mfma_f32_16x16x32_f16(ka[ii][1], iqf[h][1], c, 0, 0, 0);
#pragma unroll
                        for (int r = 0; r < 4; ++r) { const float cf = c[r]; const int cb = __float_as_int(cf); const float rl = __int_as_float(cb > 0 ? cb : 0); sc[r] += iw[h] * rl; } }
#pragma unroll
                    for (int r = 0; r < 4; ++r) { const int kidx = 16 * kt + 4 * fq + r; const float s = sc[r] + 0.0f;
                        sk[i][r] = kidx <= t0 + fr ? __float_as_uint(s) : 0xFF800000u; } }
            } else {
#pragma unroll
                for (int ii = 0; ii < 8; ++ii) sk[8 * g8 + ii] = (u32x4){0xFF800000u, 0xFF800000u, 0xFF800000u, 0xFF800000u};
            }
        }
    }
    DSTAMP(12);
    LAS unsigned* fst = qst + 96;
    LAS unsigned* cst = qst + 160;
    LAS u32x2* cand = (LAS u32x2*)(lds + DL_HIST);
    const int ntm = (j >= wave ? ((j - wave) >> 3) + 1 : 0);
#pragma unroll
    for (int i = 0; i < 8; ++i) *(LAS u32x4*)(lds + DL_HIST + (tid + NTHREADS * i) * 16) = (u32x4){0u, 0u, 0u, 0u};
    if (tid < 17) cst[tid] = 0u;
    __syncthreads();
    { unsigned oz = 0u; asm volatile("" : "+v"(oz)); const int ntm_ = ntm + (int)opaque0();
#pragma unroll
      for (int i = 0; i < 32; ++i) { if (i < ntm_) {
#pragma unroll
          for (int r = 0; r < 4; ++r) { const unsigned d = fdig(sk[i][r] ^ oz);
              __hip_atomic_fetch_add(hist + fr * 1024 + (d >> 1), (d & 1u) ? 65536u : 1u, __ATOMIC_RELAXED, __HIP_MEMORY_SCOPE_WORKGROUP); } } } }
    __syncthreads();
    DSTAMP(20);
    {
        const int base = 2048 - (lane + 1) * 32;
        unsigned need[2], cw[2][16], sum[2], incl[2];
#pragma unroll
        for (int qq = 0; qq < 2; ++qq) { const int q = 2 * wave + qq; need[qq] = qst[q * 4 + 2]; sum[qq] = 0u;
#pragma unroll
            for (int i = 0; i < 16; ++i) cw[qq][i] = hist[q * 1024 + (base >> 1) + i]; }
#pragma unroll
        for (int qq = 0; qq < 2; ++qq) {
#pragma unroll
            for (int i = 0; i < 16; ++i) sum[qq] += (cw[qq][i] & 0xFFFFu) + (cw[qq][i] >> 16);
            incl[qq] = sum[qq]; }
#pragma unroll
        for (int o = 1; o < 64; o <<= 1) { const unsigned u0 = shu(incl[0], o, lane), u1 = shu(incl[1], o, lane); if (lane >= o) { incl[0] += u0; incl[1] += u1; } }
        unsigned dstar[2], above[2], ceq[2]; bool found[2]; int Lc[2];
#pragma unroll
        for (int qq = 0; qq < 2; ++qq) { const unsigned long long bal = __ballot(incl[qq] >= need[qq]); Lc[qq] = bal ? (int)__builtin_ctzll(bal) : 63;
            dstar[qq] = 0u; above[qq] = incl[qq] - sum[qq]; ceq[qq] = 0u; found[qq] = false; }
#pragma unroll
        for (int i = 15; i >= 0; --i) {
#pragma unroll
            for (int hf = 1; hf >= 0; --hf) {
#pragma unroll
                for (int qq = 0; qq < 2; ++qq) { const unsigned c = hf ? (cw[qq][i] >> 16) : (cw[qq][i] & 0xFFFFu);
                    if (!found[qq]) { if (above[qq] + c >= need[qq]) { found[qq] = true; dstar[qq] = (unsigned)(base + 2 * i + hf); ceq[qq] = c; } else above[qq] += c; } } } }
#pragma unroll
        for (int qq = 0; qq < 2; ++qq) { const int q = 2 * wave + qq;
            const unsigned ds_ = shi(dstar[qq], Lc[qq]), ab_ = shi(above[qq], Lc[qq]), ce_ = shi(ceq[qq], Lc[qq]);
            if (lane == 0) { const unsigned nn = need[qq] - ab_; fst[q * 4 + 0] = ds_; fst[q * 4 + 1] = nn; fst[q * 4 + 2] = (ce_ == nn) ? 1u : 0u; } }
    }
    __syncthreads();
    DSTAMP(21);
    { const unsigned ds = fst[fr * 4 + 0], ta = fst[fr * 4 + 2];
      unsigned oz = 0u; asm volatile("" : "+v"(oz)); const int ntm_ = ntm + (int)opaque0();
#pragma unroll
      for (int i = 0; i < 32; ++i) { if (i < ntm_) {
          unsigned nsel = 0u, ncand = 0u;
#pragma unroll
          for (int r = 0; r < 4; ++r) { const unsigned d = fdig(sk[i][r] ^ oz); const bool gt = d > ds, eq = d == ds;
              nsel |= ((gt || (eq && ta)) ? 1u : 0u) << r; ncand |= ((eq && !ta) ? 1u : 0u) << r; }
          const unsigned kb = (unsigned)(16 * (wave + 8 * i) + 4 * fq);
          if (nsel) __hip_atomic_fetch_or(selb + fr * 128 + (kb >> 5), nsel << (kb & 31u), __ATOMIC_RELAXED, __HIP_MEMORY_SCOPE_WORKGROUP);
          if (ncand) {
#pragma unroll
              for (int r = 0; r < 4; ++r) { if ((ncand >> r) & 1u) { const unsigned slot = __hip_atomic_fetch_add(cst + fr, 1u, __ATOMIC_RELAXED, __HIP_MEMORY_SCOPE_WORKGROUP);
                  if (slot < 256u) { u32x2 e; e.x = okey(sk[i][r] ^ oz); e.y = kb + r; cand[fr * 256 + slot] = e; } else cst[16] = 1u; } } } } } }
    __syncthreads();
    DSTAMP(22);
    if (cst[16] == 0u) {
        for (int qq = 0; qq < 2; ++qq) { const int q = 2 * wave + qq; const unsigned n = cst[q], want = fst[q * 4 + 1];
            if (fst[q * 4 + 2] == 0u && n > 0u) {
                unsigned long long cmine[4]; unsigned rk[4];
#pragma unroll
                for (int c = 0; c < 4; ++c) { const unsigned ci = (unsigned)(lane + 64 * c); const u32x2 e = cand[q * 256 + (ci < n ? ci : 0u)];
                    cmine[c] = ci < n ? (((unsigned long long)e.x << 16) | (unsigned long long)(0xFFFFu - e.y)) : 0ull; rk[c] = 0u; }
#pragma unroll
                for (int cb = 0; cb < 4; ++cb) { const int nb_ = (int)n - 64 * cb < 64 ? (int)n - 64 * cb : 64;
                    for (int jx = 0; jx < nb_; ++jx) {
                        const unsigned lo = (unsigned)__builtin_amdgcn_readlane((int)(unsigned)cmine[cb], jx), hi = (unsigned)__builtin_amdgcn_readlane((int)(unsigned)(cmine[cb] >> 32), jx);
                        const unsigned long long cj = ((unsigned long long)hi << 32) | lo;
#pragma unroll
                        for (int c = 0; c < 4; ++c) rk[c] += cj > cmine[c] ? 1u : 0u; } }
#pragma unroll
                for (int c = 0; c < 4; ++c) { const unsigned ci = (unsigned)(lane + 64 * c);
                    if (ci < n && rk[c] < want) { const unsigned kidx = 0xFFFFu - (unsigned)(cmine[c] & 0xFFFFull);
                        __hip_atomic_fetch_or(selb + q * 128 + (kidx >> 5), 1u << (kidx & 31u), __ATOMIC_RELAXED, __HIP_MEMORY_SCOPE_WORKGROUP); } }
            }
            if (lane == 0) qst[q * 4 + 3] = 1u;
        }
    } else {
        for (int i = tid; i < 4096; i += NTHREADS) selb[i] = 0u;
        __syncthreads();
        for (int lvl = 0; lvl < 3; ++lvl) {
            const int shift = lvl == 0 ? 21 : (lvl == 1 ? 10 : 0); const unsigned dmask = lvl == 2 ? 0x3FFu : 0x7FFu; const int nbins = lvl == 2 ? 1024 : 2048;
            { u32x4* hz = (u32x4*)0; (void)hz;
#pragma unroll
              for (int i = 0; i < 8; ++i) *(LAS u32x4*)(lds + DL_HIST + (tid + NTHREADS * i) * 16) = (u32x4){0u, 0u, 0u, 0u}; }
            __syncthreads();
            { const unsigned mask = qst[fr * 4 + 0], val = qst[fr * 4 + 1], done = qst[fr * 4 + 3];
              unsigned oz = 0u; asm volatile("" : "+v"(oz));
              const int ntm = (j >= wave ? ((j - wave) >> 3) + 1 : 0) + (int)opaque0();
              if (!done) {
#pragma unroll
                for (int i = 0; i < 32; ++i) { if (i < ntm) {
#pragma unroll
                    for (int r = 0; r < 4; ++r) { const unsigned uk = okey(sk[i][r] ^ oz);
                        if (uk != 0u && (uk & mask) == val) { const unsigned d = (uk >> shift) & dmask;
                            __hip_atomic_fetch_add(hist + fr * 1024 + (d >> 1), (d & 1u) ? 65536u : 1u, __ATOMIC_RELAXED, __HIP_MEMORY_SCOPE_WORKGROUP); } } } }
              } }
            __syncthreads();
            for (int qq = 0; qq < 2; ++qq) { const int q = 2 * wave + qq;
                const unsigned mask = qst[q * 4 + 0], val = qst[q * 4 + 1], need = qst[q * 4 + 2], done = qst[q * 4 + 3];
                if (done) continue;
                const int nb = nbins >> 6, base = nbins - (lane + 1) * nb;
                unsigned cw[16]; unsigned s = 0;
#pragma unroll
                for (int i = 0; i < 16; ++i) { cw[i] = (i < (nb >> 1)) ? hist[q * 1024 + (base >> 1) + i] : 0u; s += (cw[i] & 0xFFFFu) + (cw[i] >> 16); }
                unsigned incl = s;
#pragma unroll
                for (int o = 1; o < 64; o <<= 1) { const unsigned u = shu(incl, o, lane); if (lane >= o) incl += u; }
                const unsigned long long bal = __ballot(incl >= need);
                const int Lc = bal ? (int)__builtin_ctzll(bal) : 63;
                unsigned dstar = 0, above = incl - s, ceq = 0; bool found = false;
#pragma unroll
                for (int i = 15; i >= 0; --i) {
#pragma unroll
                    for (int hf = 1; hf >= 0; --hf) { const unsigned c = hf ? (cw[i] >> 16) : (cw[i] & 0xFFFFu);
                        if (i < (nb >> 1) && !found) { if (above + c >= need) { found = true; dstar = (unsigned)(base + 2 * i + hf); ceq = c; } else above += c; } } }
                dstar = shi(dstar, Lc); above = shi(above, Lc); ceq = shi(ceq, Lc);
                if (lane == 0) { const unsigned nn = need - above;
                    qst[q * 4 + 0] = mask | (dmask << shift); qst[q * 4 + 1] = val | (dstar << shift); qst[q * 4 + 2] = nn; qst[q * 4 + 3] = (ceq == nn) ? 1u : 0u; }
            }
            __syncthreads();
        }
        { const unsigned mask = qst[fr * 4 + 0], val = qst[fr * 4 + 1], done = qst[fr * 4 + 3];
          unsigned oz = 0u; asm volatile("" : "+v"(oz));
          const int ntm = (j >= wave ? ((j - wave) >> 3) + 1 : 0) + (int)opaque0();
#pragma unroll
          for (int i = 0; i < 32; ++i) { if (i < ntm) {
#pragma unroll
              for (int r = 0; r < 4; ++r) { const unsigned uk = okey(sk[i][r] ^ oz); const unsigned kidx = (unsigned)(16 * (wave + 8 * i) + 4 * fq + r);
                  if (uk != 0u) { const unsigned hb = uk & mask;
                      if (hb > val || (hb == val && done)) __hip_atomic_fetch_or(selb + fr * 128 + (kidx >> 5), 1u << (kidx & 31u), __ATOMIC_RELAXED, __HIP_MEMORY_SCOPE_WORKGROUP);
                      else if (hb == val) __hip_atomic_fetch_or(eqb + fr * 128 + (kidx >> 5), 1u << (kidx & 31u), __ATOMIC_RELAXED, __HIP_MEMORY_SCOPE_WORKGROUP); } } } } }
        __syncthreads();
    }
    __syncthreads();
    DSTAMP(13);
    {
        unsigned long long w[2]; unsigned pc[2], incl[2], pos[2];
#pragma unroll
        for (int qq = 0; qq < 2; ++qq) { const int q = 2 * wave + qq;
            const unsigned need = qst[q * 4 + 2], done = qst[q * 4 + 3];
            w[qq] = (unsigned long long)selb[q * 128 + 2 * lane] | ((unsigned long long)selb[q * 128 + 2 * lane + 1] << 32);
            if (!done) { unsigned long long e = (unsigned long long)eqb[q * 128 + 2 * lane] | ((unsigned long long)eqb[q * 128 + 2 * lane + 1] << 32);
                const unsigned pce = (unsigned)__builtin_popcountll(e); unsigned ie = pce;
#pragma unroll
                for (int o = 1; o < 64; o <<= 1) { const unsigned u = shu(ie, o, lane); if (lane >= o) ie += u; }
                const unsigned before = ie - pce;
                if (before >= need) e = 0ull;
                else if (ie > need) { unsigned keep = need - before; while ((unsigned)__builtin_popcountll(e) > keep) e &= ~(1ull << (63 - __builtin_clzll(e))); }
                w[qq] |= e; }
            pc[qq] = (unsigned)__builtin_popcountll(w[qq]); incl[qq] = pc[qq]; }
#pragma unroll
        for (int o = 1; o < 64; o <<= 1) { const unsigned u0 = shu(incl[0], o, lane), u1 = shu(incl[1], o, lane); if (lane >= o) { incl[0] += u0; incl[1] += u1; } }
#pragma unroll
        for (int qq = 0; qq < 2; ++qq) { const int q = 2 * wave + qq; const unsigned nsel = nselp[q]; pos[qq] = incl[qq] - pc[qq];
#pragma unroll
            for (int i = 0; i < 4; ++i) { const unsigned p = (unsigned)(lane + 64 * i); if (p >= nsel) list[q * 256 + p] = 0; } }
        while (w[0] | w[1]) {
#pragma unroll
            for (int qq = 0; qq < 2; ++qq) { if (w[qq]) { const int bit = __builtin_ctzll(w[qq]); w[qq] &= w[qq] - 1ull;
                if (pos[qq] < 256u) list[(2 * wave + qq) * 256 + pos[qq]] = (unsigned short)(64 * lane + bit); ++pos[qq]; } } }
    }
    __syncthreads();

    DSTAMP(14);
    const f16* __restrict__ KV = (const f16*)(ws + WS_KV); const f16* __restrict__ QC = (const f16*)(ws + WS_QC);
    LAS unsigned char* stg = lds + DL_HIST + wave * DL_STAGE_W;
    const unsigned tr_addr = (unsigned)(uintptr_t)stg + (unsigned)((4 * fq + ((lane & 15) >> 2)) * DL_RS + (lane & 3) * 8);
    int growv[9], gc16[9];
#pragma unroll
    for (int i = 0; i < 9; ++i) { const int c = lane + 64 * i; growv[i] = (c * 3641) >> 16; gc16[i] = c - 18 * growv[i]; }
    for (int qq = 0; qq < 2; ++qq) { const int q = 2 * wave + qq; const size_t tok = tokb + t0 + q; const int nsel = (int)nselp[q];
        f16x8 qc[4]; f16x4 qr;
#pragma unroll
        for (int ks = 0; ks < 4; ++ks) { if (fr < 8) qc[ks] = *(const f16x8*)(QC + (tok * 8 + fr) * 160 + 32 * ks + 8 * fq); else {
#pragma unroll
            for (int e = 0; e < 8; ++e) qc[ks][e] = (f16)0.f; } }
        if (fr < 8) qr = *(const f16x4*)(QC + (tok * 8 + fr) * 160 + 128 + 4 * fq); else { qr[0] = (f16)0.f; qr[1] = (f16)0.f; qr[2] = (f16)0.f; qr[3] = (f16)0.f; }
        f32x4 acc[8];
#pragma unroll
        for (int c = 0; c < 8; ++c) acc[c] = (f32x4){0.f, 0.f, 0.f, 0.f};
        float m_run = -INFINITY, l_run = 0.f;
        u32x4 rw[9];
#define DG_LOAD(PIDX) do { const int pn_ = (PIDX) < 8 ? (PIDX) : 7; \
            _Pragma("unroll") for (int i = 0; i < 9; ++i) { const int idx_ = list[q * 256 + 32 * pn_ + growv[i]]; rw[i] = *(const u32x4*)(KV + (tokb + idx_) * 160 + gc16[i] * 8); } } while (0)
        DG_LOAD(0);
        const int npair = (nsel + 31) >> 5;
        for (int pp = 0; pp < npair; ++pp) {
#pragma unroll
            for (int i = 0; i < 9; ++i) *(LAS u32x4*)(stg + growv[i] * DL_RS + gc16[i] * 16) = rw[i];
            DG_LOAD(pp + 1);
            f16x8 fa[4], fb[4]; f16x4 fra, frb;
#pragma unroll
            for (int ks = 0; ks < 4; ++ks) { fa[ks] = *(const LAS f16x8*)(stg + fr * DL_RS + (32 * ks + 8 * fq) * 2); fb[ks] = *(const LAS f16x8*)(stg + (16 + fr) * DL_RS + (32 * ks + 8 * fq) * 2); }
            fra = *(const LAS f16x4*)(stg + fr * DL_RS + (128 + 4 * fq) * 2); frb = *(const LAS f16x4*)(stg + (16 + fr) * DL_RS + (128 + 4 * fq) * 2);
            f32x4 c0 = (f32x4){0.f, 0.f, 0.f, 0.f}, c1 = (f32x4){0.f, 0.f, 0.f, 0.f};
#pragma unroll
            for (int ks = 0; ks < 4; ++ks) { c0 = __builtin_amdgcn_mfma_f32_16x16x32_f16(fa[ks], qc[ks], c0, 0, 0, 0); c1 = __builtin_amdgcn_mfma_f32_16x16x32_f16(fb[ks], qc[ks], c1, 0, 0, 0); }
            c0 = __builtin_amdgcn_mfma_f32_16x16x16f16(fra, qr, c0, 0, 0, 0); c1 = __builtin_amdgcn_mfma_f32_16x16x16f16(frb, qr, c1, 0, 0, 0);
            float mx = -INFINITY;
#pragma unroll
            for (int r = 0; r < 4; ++r) { if (32 * pp + 4 * fq + r >= nsel) c0[r] = -INFINITY; if (32 * pp + 16 + 4 * fq + r >= nsel) c1[r] = -INFINITY; mx = fmaxf(mx, fmaxf(c0[r], c1[r])); }
            if (__any(mx > m_run + 4.0f)) {
                mx = fmaxf(mx, shx(mx, 16, lane)); mx = fmaxf(mx, shx(mx, 32, lane));
                const float mn = fmaxf(m_run, mx); const float scale = __expf(m_run - mn); l_run *= scale; m_run = mn;
#pragma unroll
                for (int c = 0; c < 8; ++c) acc[c] *= scale; }
            f16x8 pf;
#pragma unroll
            for (int r = 0; r < 4; ++r) { const float p0 = __expf(c0[r] - m_run), p1 = __expf(c1[r] - m_run); l_run += p0 + p1; pf[r] = (f16)p0; pf[4 + r] = (f16)p1; }
            u32x2 t0_[8], t1_[8];
            asm volatile("s_waitcnt lgkmcnt(0)\n\t"
                "ds_read_b64_tr_b16 %0, %16 offset:0\n\t"    "ds_read_b64_tr_b16 %1, %16 offset:32\n\t"   "ds_read_b64_tr_b16 %2, %16 offset:64\n\t"   "ds_read_b64_tr_b16 %3, %16 offset:96\n\t"
                "ds_read_b64_tr_b16 %4, %16 offset:128\n\t"  "ds_read_b64_tr_b16 %5, %16 offset:160\n\t"  "ds_read_b64_tr_b16 %6, %16 offset:192\n\t"  "ds_read_b64_tr_b16 %7, %16 offset:224\n\t"
                "ds_read_b64_tr_b16 %8, %16 offset:4864\n\t" "ds_read_b64_tr_b16 %9, %16 offset:4896\n\t" "ds_read_b64_tr_b16 %10, %16 offset:4928\n\t" "ds_read_b64_tr_b16 %11, %16 offset:4960\n\t"
                "ds_read_b64_tr_b16 %12, %16 offset:4992\n\t" "ds_read_b64_tr_b16 %13, %16 offset:5024\n\t" "ds_read_b64_tr_b16 %14, %16 offset:5056\n\t" "ds_read_b64_tr_b16 %15, %16 offset:5088\n\t"
                "s_waitcnt lgkmcnt(0)"
                : "=&v"(t0_[0]), "=&v"(t0_[1]), "=&v"(t0_[2]), "=&v"(t0_[3]), "=&v"(t0_[4]), "=&v"(t0_[5]), "=&v"(t0_[6]), "=&v"(t0_[7]),
                  "=&v"(t1_[0]), "=&v"(t1_[1]), "=&v"(t1_[2]), "=&v"(t1_[3]), "=&v"(t1_[4]), "=&v"(t1_[5]), "=&v"(t1_[6]), "=&v"(t1_[7])
                : "v"(tr_addr) : "memory");
#pragma unroll
            for (int c = 0; c < 8; ++c) { u32x4 av; av.x = t0_[c].x; av.y = t0_[c].y; av.z = t1_[c].x; av.w = t1_[c].y;
                acc[c] = __builtin_amdgcn_mfma_f32_16x16x32_f16(__builtin_bit_cast(f16x8, av), pf, acc[c], 0, 0, 0); }
            asm volatile("s_waitcnt lgkmcnt(0)" ::: "memory");
        }
#undef DG_LOAD
        l_run += shx(l_run, 16, lane); l_run += shx(l_run, 32, lane);
        const float inv = 1.0f / l_run;
        if (fr < 8) {
#pragma unroll
            for (int c = 0; c < 8; ++c) { f16x4 o; o[0] = (f16)(acc[c][0] * inv); o[1] = (f16)(acc[c][1] * inv); o[2] = (f16)(acc[c][2] * inv); o[3] = (f16)(acc[c][3] * inv);
                *(LAS f16x4*)(lds + DL_OL + ((q * 8 + fr) * 128 + 16 * c + 4 * fq) * 2) = o; } }
    }
    __syncthreads();
    DSTAMP(15);
    { const int h = wave; const f16* __restrict__ Wv = (const f16*)(ws + WS_WUV) + ((size_t)(l * 8 + h) * 64) * 128;
      const f16* __restrict__ P16 = (const f16*)(ws + WS_P16); f16* __restrict__ Y3 = (f16*)(ws + WS_Y3);
      f16x8 af[4], bf[4][4]; f16 zg[4][4];
#pragma unroll
      for (int n = 0; n < 4; ++n)
#pragma unroll
          for (int ks = 0; ks < 4; ++ks) bf[n][ks] = *(const f16x8*)(Wv + (size_t)(16 * n + fr) * 128 + 32 * ks + 8 * fq);
#pragma unroll
      for (int n = 0; n < 4; ++n)
#pragma unroll
          for (int r = 0; r < 4; ++r) zg[n][r] = P16[(tokb + t0 + 4 * fq + r) * NA + C_DZ + h * 64 + 16 * n + fr];
#pragma unroll
      for (int ks = 0; ks < 4; ++ks) af[ks] = *(const LAS f16x8*)(lds + DL_OL + ((fr * 8 + h) * 128 + 32 * ks + 8 * fq) * 2);
#pragma unroll
      for (int n = 0; n < 4; ++n) { f32x4 c = (f32x4){0.f, 0.f, 0.f, 0.f};
#pragma unroll
          for (int ks = 0; ks < 4; ++ks) c = __builtin_amdgcn_mfma_f32_16x16x32_f16(af[ks], bf[n][ks], c, 0, 0, 0);
#pragma unroll
          for (int r = 0; r < 4; ++r) Y3[(tokb + t0 + 4 * fq + r) * 1536 + h * 64 + 16 * n + fr] = (f16)(c[r] * siluf_((float)zg[n][r])); } }
    __syncthreads();
}

__device__ __forceinline__ void transpose_slab(LAS unsigned char* lds, const f16* __restrict__ P16, int coff, int b, int s0, f16* __restrict__ dstT, int wv) {
    constexpr int RS = 1040;
    int tid = TIDX(wv); asm volatile("" : "+v"(tid));
#pragma unroll
    for (int i = 0; i < 8; ++i) { const int id = tid + 512 * i, row = id >> 6, cc = id & 63;
        *(LAS u32x4*)(lds + row * RS + cc * 16) = *(const u32x4*)(P16 + (size_t)(b * SEQ + s0 + row) * NA + coff + cc * 8); }
    __syncthreads();
    f16* d = dstT + ((size_t)(b * 512 + tid)) * SEQ + s0;
#pragma unroll
    for (int i = 0; i < 8; ++i) { f16x8 v;
#pragma unroll
        for (int j = 0; j < 8; ++j) v[j] = *(const LAS f16*)(lds + (i * 8 + j) * RS + tid * 2);
        *(f16x8*)(d + i * 8) = v; }
    __syncthreads();
}

__device__ __forceinline__ void final_norm(const Args& a) {
    const int G = gridDim.x, bid = blockIdx.x; int tid = TIDX(a.wv); asm volatile("" : "+v"(tid)); const int wave = tid >> 6, lane = tid & 63;
    unsigned char* ws = a.ws; LAUNDER_S(ws);
    const f16* X = (const f16*)(ws + WS_X16); const float* ss = (const float*)(ws + WS_SS);
    for (int row = bid * 8 + wave; row < MTOK; row += G * 8) {
        const float rs = pg8::row_rstd(ss, row);
#pragma unroll
        for (int i = 0; i < 2; ++i) { const int c = i * 512 + lane * 8; const f16x8 v = *(const f16x8*)(X + (size_t)row * DM + c); const f32x4 w0 = *(const f32x4*)(a.fnorm_w + c), w1 = *(const f32x4*)(a.fnorm_w + c + 4);
            f32x4 o0, o1;
#pragma unroll
            for (int j = 0; j < 4; ++j) { o0[j] = (float)v[j] * rs * w0[j]; o1[j] = (float)v[4 + j] * rs * w1[j]; }
            *(f32x4*)(a.out + (size_t)row * DM + c) = o0; *(f32x4*)(a.out + (size_t)row * DM + c + 4) = o1; }
    }
}

__device__ __forceinline__ void zero_y3(const Args& a) {
    unsigned char* ws = a.ws; LAUNDER_S(ws);
    u32x4* p = (u32x4*)(ws + WS_Y3); const size_t n = (size_t)MTOK * 1536 * 2 / 16;
    for (size_t i = (size_t)blockIdx.x * NTHREADS + threadIdx.x; i < n; i += (size_t)gridDim.x * NTHREADS) p[i] = (u32x4){0u, 0u, 0u, 0u};
}

#ifndef PH_P0
#define PH_P0 1
#endif
#ifndef PH_A
#define PH_A 1
#endif
#ifndef PH_B
#define PH_B 1
#endif
#ifndef PH_C
#define PH_C 1
#endif
#ifndef PH_A2
#define PH_A2 1
#endif
#ifndef PH_D
#define PH_D 1
#endif
#ifndef PH_E
#define PH_E 1
#endif
__global__ void __launch_bounds__(NTHREADS, 2) fwd(Args a_in) {
    Args a = a_in; a.wv = __builtin_amdgcn_readfirstlane((int)threadIdx.x >> 6);
    extern __shared__ __attribute__((aligned(16))) unsigned char lds_raw[];
    LAS unsigned char* lds = (LAS unsigned char*)lds_raw;
    const int G = gridDim.x, bid = blockIdx.x;
#define tid TIDX(a.wv)
    if (tid < 4) ((LAS unsigned*)(lds + LDS_BYTES - 16))[tid] = 0u;
    __syncthreads();
    unsigned char* ws = a.ws;
    XcdBarrier bar = xcd_barrier_post((unsigned*)(ws + WS_CTL), (volatile LAS unsigned*)(lds + LDS_BYTES - 16), a.wv);
#ifdef TIMING
    LAS unsigned long long* tsum = (LAS unsigned long long*)(lds + LDS_BYTES - 512);
    if (tid == 0) { for (int i = 0; i < 32; ++i) tsum[i] = 0ull; tsum[16] = wall_clock64(); tsum[17] = tsum[16]; tsum[31] = __builtin_amdgcn_s_memtime(); }
#define STAMP(k) do { if (bid == 0 && TIDX(a.wv) == 0) { const unsigned long long t_ = wall_clock64(); tsum[k] += t_ - tsum[16]; tsum[16] = t_; } } while (0)
    unsigned long long* tsg = (unsigned long long*)(ws + WS_END);
    int bari = 0;
#define GBAR() do { if (TIDX(a.wv) == 0) __hip_atomic_store(tsg + bari * 256 + bid, (unsigned long long)wall_clock64(), __ATOMIC_RELAXED, __HIP_MEMORY_SCOPE_AGENT); xcd_barrier(bar); if (TIDX(a.wv) == 0 && bid == 0) tsg[40 * 256 + bari] = (unsigned long long)wall_clock64(); ++bari; } while (0)
#else
#define STAMP(k) do {} while (0)
#define GBAR() xcd_barrier(bar)
#endif

#if PH_P0
    p0_prologue(a, lds);
#endif
    GBAR();
    STAMP(0);

    for (int l = 0; l < DEPTH; ++l) {
        LAUNDER_S(ws);
        f16* P16 = (f16*)(ws + WS_P16); f16* X16 = (f16*)(ws + WS_X16); float* SS = (float*)(ws + WS_SS);
        f16* Y3 = (f16*)(ws + WS_Y3);
        const f16* WinT = (const f16*)(ws + WS_WINT) + (size_t)l * 9216 * 1024;
#if PH_A
        { pg8::Gemm g{X16, WinT, MTOK, NA, DM, DM, DM}; pg8::StaticOrder S; S.init(MTOK, NA, G, bid);
          pg8::rs_tables((LAS float*)(lds + pg8::STAGE_BYTES), SS, S, a.wv);
          pg8::EpiScaleF16 E{P16, NA, (const LAS float*)(lds + pg8::STAGE_BYTES)}; pg8::gemm_phase(lds, g, S, E, a.wv); }
        GBAR();
        STAMP(1);
#endif
#if PH_B
        for (int u = bid; u < MTOK / 64; u += G) phase_b_unit(a, lds, l, u >> 6, u & 63);
        GBAR();
        STAMP(2);
#endif
#if PH_C
        mlstm_scan(a, lds);
        STAMP(3);
        { unsigned* qctr = (unsigned*)(ws + WS_CTL) + 12288 + 64 * l;
          volatile LAS unsigned* qslot = (volatile LAS unsigned*)(lds + LDS_BYTES - 32);
          for (;;) {
              if (TIDX(a.wv) == 0) qslot[0] = __hip_atomic_fetch_add(qctr, 1u, __ATOMIC_RELAXED, __HIP_MEMORY_SCOPE_AGENT);
              __syncthreads();
              const unsigned uq = qslot[0];
              __syncthreads();
              if (uq >= 1024u + 512u) break;
              if (uq < 1024u) dsa_unit(a, lds, l, (int)(uq & 3u), 255 - (int)(uq >> 2));
              else {
                  const int u = (int)(uq - 1024u) * 8 + a.wv; const int qt = u & 127, h = (u >> 7) & 7, b = u >> 10; int t_ = lane_id_(); asm volatile("" : "+v"(t_));
                  sb_attn_unit(P16, (const f16*)(ws + WS_VT), Y3, b, h, qt, t_ & 63); }
          } }
        STAMP(4);
        STAMP(5);
        GBAR();
        STAMP(6);
        { const int wave_ = a.wv;
          for (int u = bid * 8 + wave_; u < 2048; u += G * 8) { int t_ = lane_id_(); asm volatile("" : "+v"(t_));
              mlstm_out_unit(a, lds + wave_ * 1024, l, u >> 9, (u >> 3) & 63, (u >> 1) & 3, u & 1, t_ & 63); } }
        GBAR();
        STAMP(7);
#endif
#if PH_A2
        { pg8::Gemm g{X16, WinT + (size_t)NA * DM, MTOK, NG, DM, DM, DM}; pg8::StaticOrder S; S.init(MTOK, NG, G, bid);
          pg8::rs_tables((LAS float*)(lds + pg8::STAGE_BYTES), SS, S, a.wv);
          pg8::EpiScaleF16T<true> E{(f16*)(ws + WS_G16), NG, (const LAS float*)(lds + pg8::STAGE_BYTES)}; pg8::gemm_phase(lds, g, S, E, a.wv); }
        GBAR();
        STAMP(8);
#endif
#if PH_D
        { pg8::Gemm g{Y3, (const f16*)(ws + WS_WBRT) + (size_t)l * 1024 * 1536, MTOK, DM, 1536, 1536, 1536}; pg8::StaticOrder S; S.init(MTOK, DM, G, bid);
          pg8::EpiMerge E{(const f16*)(ws + WS_G16), (f16*)(ws + WS_MIX16)}; pg8::gemm_phase<pg8::EpiMerge, true>(lds, g, S, E, a.wv); }
        GBAR();
        STAMP(9);
#endif
#if PH_E
        { pg8::Gemm g{(const f16*)(ws + WS_MIX16), (const f16*)(ws + WS_WOUTT) + (size_t)l * DM * DM, MTOK, DM, DM, DM, DM}; pg8::StaticOrder S; S.init(MTOK, DM, G, bid);
          pg8::EpiResid E{X16, SS}; pg8::gemm_phase(lds, g, S, E, a.wv); }
        GBAR();
        STAMP(10);
#endif
    }
    final_norm(a);
#undef tid
#ifdef TIMING
    const int tid = TIDX(a.wv);
    STAMP(11);
    if (bid == 0) {
        LAS unsigned long long* mxx = (LAS unsigned long long*)lds;
        LAS unsigned long long* arr = mxx + 512;
        __syncthreads();
        for (int p = 0; p < bari; ++p) {
            if (tid < 256) arr[tid] = __hip_atomic_load(tsg + p * 256 + tid, __ATOMIC_RELAXED, __HIP_MEMORY_SCOPE_AGENT);
            __syncthreads();
            if (tid < 8) { unsigned long long m = 0ull; for (int k = tid; k < 256; k += 8) m = arr[k] > m ? arr[k] : m; mxx[p * 8 + tid] = m; }
            __syncthreads();
        }
        LAS unsigned long long* mean = arr + 300;
        for (int p = 0; p < bari; ++p) {
            if (tid < 256) arr[tid] = __hip_atomic_load(tsg + p * 256 + tid, __ATOMIC_RELAXED, __HIP_MEMORY_SCOPE_AGENT);
            __syncthreads();
            if (tid == 0) { long long sm = 0; for (int k = 0; k < 256; ++k) sm += (long long)(arr[k] - arr[0]); mean[p] = (unsigned long long)((long long)arr[0] + sm / 256); }
            __syncthreads();
        }
        if (tid == 0) {
            long long n1 = 0, n2 = 0;
            for (int p = 1; p < bari; ++p) { const int ph = (p - 1) % 7;
                if (!(SKEW_SEL & (1 << ph))) continue;
                unsigned long long rel = 0ull, sx = 0ull; for (int x = 0; x < 8; ++x) { rel = mxx[p * 8 + x] > rel ? mxx[p * 8 + x] : rel; }
                for (int x = 0; x < 8; ++x) sx += rel - mxx[p * 8 + x];
                n1 += (long long)(rel - mean[p]); n2 += (long long)(tsg[40 * 256 + p] - rel); }
            tsum[24] = (unsigned long long)n1; tsum[18] = (unsigned long long)n2;
        }
        __syncthreads();
    }
    { unsigned* slot = (unsigned*)(ws + WS_CTL) + 8192;
      if (bid == 0 && tid == 0) { tsum[30] = (__builtin_amdgcn_s_memtime() - tsum[31]) * 1000ull / (tsum[16] - tsum[17]); tsum[16] -= tsum[17]; __hip_atomic_store(slot, (unsigned)(tsum[TIMING_A] / 100ull), __ATOMIC_RELAXED, __HIP_MEMORY_SCOPE_AGENT); __hip_atomic_store(slot + 1, (unsigned)(tsum[TIMING_B] / 100ull), __ATOMIC_RELAXED, __HIP_MEMORY_SCOPE_AGENT); }
      xcd_barrier(bar);
      const float ta = (float)__hip_atomic_load(slot, __ATOMIC_RELAXED, __HIP_MEMORY_SCOPE_AGENT) * (1.0f / 16.0f), tb = 1e-3f * sqrtf((float)__hip_atomic_load(slot + 1, __ATOMIC_RELAXED, __HIP_MEMORY_SCOPE_AGENT));
      for (size_t i = (size_t)bid * NTHREADS + tid; i < (size_t)MTOK * DM; i += (size_t)G * NTHREADS) a.out[i] = i == 0 ? ta : a.out[i] + ((i & 1) ? tb : -tb); }
#endif
}

__global__ void fill_kernel(float* out, int n, float v) { for (int i = blockIdx.x * blockDim.x + threadIdx.x; i < n; i += gridDim.x * blockDim.x) out[i] = (i & 1) ? v : -v; }

extern "C" void kernel_launch(void* const* d_in, const int* in_sizes, int n_in, void* d_out, int out_size, void* d_ws, size_t ws_size, hipStream_t stream) {
    static int grid = 0;
    if (grid == 0) {
        int dev = 0, cus = 0;
        if (hipGetDevice(&dev) != hipSuccess || hipDeviceGetAttribute(&cus, hipDeviceAttributeMultiprocessorCount, dev) != hipSuccess) { grid = -1; }
        else if (hipFuncSetAttribute((const void*)fwd, hipFuncAttributeMaxDynamicSharedMemorySize, LDS_BYTES) != hipSuccess) { grid = -2; }
        else grid = cus;
        (void)hipGetLastError();
    }
    if (ws_size < WS_END || n_in != 13 || grid < 128) {
        hipLaunchKernelGGL(fill_kernel, dim3(256), dim3(256), 0, stream, (float*)d_out, out_size, ws_size < WS_END ? 100.f : 30.f);
        return;
    }
    (void)hipMemsetAsync((char*)d_ws + WS_CTL, 0, CTL_BYTES, stream);
    Args a{};
    a.x = (const float*)d_in[0]; a.w_in = (const float*)d_in[1]; a.w_uk = (const float*)d_in[2]; a.w_uv = (const float*)d_in[3]; a.kvn_w = (const float*)d_in[4];
    a.conv_w = (const float*)d_in[5]; a.i_bias = (const float*)d_in[6]; a.f_bias = (const float*)d_in[7]; a.mln_w = (const float*)d_in[8]; a.w_branch = (const float*)d_in[9];
    a.w_out = (const float*)d_in[10]; a.norm_w = (const float*)d_in[11]; a.fnorm_w = (const float*)d_in[12];
    a.out = (float*)d_out; a.ws = (unsigned char*)d_ws;
    hipLaunchKernelGGL(fwd, dim3(grid), dim3(NTHREADS), LDS_BYTES, stream, a);
}
```

```cpp
#include <hip/hip_runtime.h>
#include <cstdio>
#include <cstdint>

#define LAS __attribute__((address_space(3)))
__device__ __forceinline__ unsigned opaque0() { unsigned z = 0; asm volatile("" : "+s"(z)); return z; }
#define LAUNDER_S(p) ((p) += opaque0())
typedef _Float16 f16;
typedef _Float16 f16x8 __attribute__((ext_vector_type(8)));
typedef _Float16 f16x4 __attribute__((ext_vector_type(4)));
typedef _Float16 f16x2 __attribute__((ext_vector_type(2)));
typedef float f32x4 __attribute__((ext_vector_type(4)));
typedef float f32x2 __attribute__((ext_vector_type(2)));
typedef float f32x16 __attribute__((ext_vector_type(16)));
typedef unsigned u32x4 __attribute__((ext_vector_type(4)));
typedef unsigned u32x2 __attribute__((ext_vector_type(2)));

constexpr int DM = 1024, NB = 4, SEQ = 4096, DEPTH = 4, MTOK = NB * SEQ;
constexpr int WIN_COLS = 9180;
constexpr int NA = 6144;
constexpr int NG = 3072;
constexpr float NORM_EPS = 1e-6f;
constexpr int C_DQ = 0, C_CKV = 512, C_KR = 640, C_IQ = 656, C_IK = 912, C_IW = 976, C_MI = 980, C_MF = 984;
constexpr int C_DZ = 1024, C_SQ = 1536, C_SK = 2048, C_SV = 2560, C_SZ = 3072, C_MQK = 3584, C_MV = 4608, C_MO = 5120, C_MZ = 5632;

#define XB_TMO      128
#define XB_XCNT(j)  (256  + 64 * (j))
#define XB_XSUB(j)  (1280 + 64 * (j))
#define XB_XGEN(j)  (2304 + 64 * (j))
#define XB_TOP      3328
#define XB_TOPGEN   3392
#define XCD_BAR_WORDS 3456
#define XB_SPIN_CAP (1u << 18)

__device__ __forceinline__ unsigned xb_ld(unsigned* p)              { return __hip_atomic_load(p, __ATOMIC_RELAXED, __HIP_MEMORY_SCOPE_AGENT); }
__device__ __forceinline__ unsigned xb_add(unsigned* p, unsigned v) { return __hip_atomic_fetch_add(p, v, __ATOMIC_RELAXED, __HIP_MEMORY_SCOPE_AGENT); }
__device__ __forceinline__ unsigned xb_xcc_id() { return (unsigned)__builtin_amdgcn_s_getreg((3 << 11) | 20) & 0xFu; }
#define XB_SPIN(cond, bar) do { unsigned _sp = 0; while (cond) { __builtin_amdgcn_s_sleep(1); \
    if ((++_sp & 255u) == 0u) { if (xb_ld(&(bar)[XB_TMO])) break; if (_sp > XB_SPIN_CAP) { atomicAdd(&(bar)[XB_TMO], 1u); break; } } } } while (0)

__device__ __forceinline__ int lane_id_() { return (int)__builtin_amdgcn_mbcnt_hi(~0u, __builtin_amdgcn_mbcnt_lo(~0u, opaque0())); }
#define TIDX(wv) ((wv) * 64 + lane_id_())
struct XcdBarrier { unsigned* bar; unsigned x; volatile LAS unsigned* st; int wv; };

__device__ __forceinline__ XcdBarrier xcd_barrier_post(unsigned* bar, volatile LAS unsigned* st, int wv) {
    XcdBarrier b; b.bar = bar; b.x = xb_xcc_id(); b.st = st; b.wv = wv;
    if (TIDX(wv) == 0) (void)xb_add(&bar[XB_XCNT(b.x)], 1u);
    return b;
}
__device__ __forceinline__ void xcd_barrier_complete(unsigned* bar, unsigned x, unsigned& nloc, unsigned& nx) {
    const unsigned G = gridDim.x * gridDim.y * gridDim.z;
    unsigned sum, cnt, mine, sp = 0u;
    for (;;) {
        sum = 0u; cnt = 0u; mine = 0u;
#pragma unroll
        for (unsigned j = 0; j < 16; ++j) { const unsigned c = xb_ld(&bar[XB_XCNT(j)]); sum += c; cnt += (c > 0u) ? 1u : 0u; mine = (j == x) ? c : mine; }
        if (sum == G) break;
        __builtin_amdgcn_s_sleep(1);
        if ((++sp & 255u) == 0u) { if (xb_ld(&bar[XB_TMO])) break; if (sp > XB_SPIN_CAP) { atomicAdd(&bar[XB_TMO], 1u); break; } }
    }
    nloc = mine > 0u ? mine : 1u; nx = cnt > 0u ? cnt : 1u;
}
__device__ __forceinline__ void xcd_barrier(const XcdBarrier& b) {
    asm volatile("s_waitcnt vmcnt(0)" ::: "memory");
    __syncthreads();
    if (TIDX(b.wv) == 0) {
        unsigned* bar = b.bar; LAUNDER_S(bar); const unsigned bx = b.x + opaque0();
        __builtin_amdgcn_s_waitcnt(0);
        unsigned nloc = b.st[0], nx = b.st[1];
        if (nloc == 0u) { xcd_barrier_complete(bar, bx, nloc, nx); b.st[0] = nloc; b.st[1] = nx; }
        const unsigned old = xb_add(&bar[XB_XSUB(bx)], 1u);
        const unsigned gen = old / nloc;
        if (old + 1u == (gen + 1u) * nloc) {
            __builtin_amdgcn_fence(__ATOMIC_RELEASE, "agent");
            asm volatile("s_waitcnt vmcnt(0)" ::: "memory");
            const unsigned og = xb_add(&bar[XB_TOP], 1u);
            const unsigned tg = og / nx;
            if (og + 1u == (tg + 1u) * nx) xb_add(&bar[XB_TOPGEN], 1u);
            else XB_SPIN(xb_ld(&bar[XB_TOPGEN]) == tg, bar);
            __builtin_amdgcn_fence(__ATOMIC_ACQUIRE, "agent");
            xb_add(&bar[XB_XGEN(bx)], 1u);
            asm volatile("s_waitcnt vmcnt(0)" ::: "memory");
        } else {
            XB_SPIN(xb_ld(&bar[XB_XGEN(bx)]) == gen, bar);
            __builtin_amdgcn_fence(__ATOMIC_ACQUIRE, "agent");
            asm volatile("s_waitcnt vmcnt(0)" ::: "memory");
        }
    }
    __syncthreads();
}


__device__ __forceinline__ float shx(float v, int m, int lane) { return __builtin_bit_cast(float, __builtin_amdgcn_ds_bpermute((lane ^ m) << 2, __builtin_bit_cast(int, v))); }
__device__ __forceinline__ unsigned shx(unsigned v, int m, int lane) { return (unsigned)__builtin_amdgcn_ds_bpermute((lane ^ m) << 2, (int)v); }
__device__ __forceinline__ float shu(float v, int o, int lane) { return __builtin_bit_cast(float, __builtin_amdgcn_ds_bpermute((lane - o) << 2, __builtin_bit_cast(int, v))); }
__device__ __forceinline__ unsigned shu(unsigned v, int o, int lane) { return (unsigned)__builtin_amdgcn_ds_bpermute((lane - o) << 2, (int)v); }
__device__ __forceinline__ float shi(float v, int src) { return __builtin_bit_cast(float, __builtin_amdgcn_ds_bpermute(src << 2, __builtin_bit_cast(int, v))); }
__device__ __forceinline__ unsigned shi(unsigned v, int src) { return (unsigned)__builtin_amdgcn_ds_bpermute(src << 2, (int)v); }

#define PIN4(a) asm volatile("" :: "v"((a)[0]), "v"((a)[1]), "v"((a)[2]), "v"((a)[3]))
#define PIN8(a) asm volatile("" :: "v"((a)[0]), "v"((a)[1]), "v"((a)[2]), "v"((a)[3]), "v"((a)[4]), "v"((a)[5]), "v"((a)[6]), "v"((a)[7]))

__device__ __forceinline__ float fast_exp(float x) { return __builtin_amdgcn_exp2f(x * 1.44269504088896340736f); }
__device__ __forceinline__ float fast_rcp(float x) { return __builtin_amdgcn_rcpf(x); }
__device__ __forceinline__ float sigmoidf_(float x) { return fast_rcp(1.0f + fast_exp(-x)); }
__device__ __forceinline__ float siluf_(float x) { return x * sigmoidf_(x); }
__device__ __forceinline__ float logsigmoidf_(float x) {
    return fminf(x, 0.0f) - log1pf(__expf(-fabsf(x)));
}

namespace pg8 {
constexpr int BM = 256, BK = 64, HALF = 128, HTB = HALF * BK * 2, STAGE_BYTES = 8 * HTB, NXCD = 8, WGM = 8;
__host__ __device__ __forceinline__ int lds_byte(int r, int c) { const int st = (r >> 4) * 2 + (c >> 5), rr = r & 15, cc = c & 31, ob = rr * 64 + cc * 2; return st * 1024 + (ob ^ (((ob >> 9) & 1) << 5)); }
__host__ __device__ __forceinline__ void stage_rc(int b, int& R, int& C) { const int st = b / 1024, sb = b % 1024, swz = sb ^ (((sb >> 9) & 1) << 5); R = (st >> 1) * 16 + swz / 64; C = (st & 1) * 32 + (swz % 64) / 2; }
__host__ __device__ __forceinline__ int perm32(int rho) { const int n = rho >> 4, i = rho & 15; return 8 * (i >> 2) + 4 * n + (i & 3); }

struct Unit { int pm, pn, ord; };
struct Gemm { const f16* A; const f16* Bt; int M, N, K, lda, ldb; };

struct StaticOrder {
    int nM, nN, nwg, G, c;
    __host__ __device__ void init(int M, int N, int G_, int c_) { nM = M / BM; nN = N / BM; nwg = nM * nN; G = G_; c = c_; }
    __host__ __device__ bool next(int i, Unit& u) const {
        const long L = (long)i * G + c; if (L >= nwg) return false;
        int wgid = (int)L; { const int q = nwg / NXCD, r = nwg % NXCD, xcd = wgid % NXCD, off = wgid / NXCD; wgid = (xcd < r ? xcd * (q + 1) : r * (q + 1) + (xcd - r) * q) + off; }
        const int nig = WGM * nN, gid = wgid / nig, fm = gid * WGM, gsz = (nM - fm) < WGM ? (nM - fm) : WGM;
        u.pm = fm + ((wgid % nig) % gsz); u.pn = (wgid % nig) / gsz; u.ord = i; return true;
    }
};

#ifndef GEMM_SP2
#define GEMM_SP2 true
#endif
#ifndef GEMM_ALIGN
#define GEMM_ALIGN true
#endif
template <class Epi, bool MID = false, bool SP2 = GEMM_SP2, bool ALIGN_EPI = GEMM_ALIGN>
__device__ __forceinline__ void gemm_phase(LAS unsigned char* lds, const Gemm g, const StaticOrder& S, const Epi& E, int wv) {
    int tid = TIDX(wv); asm volatile("" : "+v"(tid));
    const int wid = __builtin_amdgcn_readfirstlane(tid >> 6), lane = tid & 63, wr = wid >> 2, wc = wid & 3, fr = lane & 15, fq = lane >> 4;
    const int K = g.K, nt = K / BK;
    unsigned voffA[2], voffB[2];
#pragma unroll
    for (int i = 0; i < 2; ++i) { int R, C; stage_rc(tid * 16 + i * 8192, R, C); const int Rb = (R & ~31) + perm32(R & 31);
        voffA[i] = (unsigned)(R * g.lda + C) * 2u; voffB[i] = (unsigned)(Rb * g.ldb + C) * 2u; }
    const size_t kstep = (size_t)(BK * 2);
    const size_t hstepA = (size_t)HALF * g.lda * 2, hstepB = (size_t)HALF * g.ldb * 2;
    const size_t tstepA = 2 * hstepA, tstepB = 2 * hstepB;
    const unsigned ldsw = (unsigned)wid * 1024u;
    const int aoff = lds_byte(wr * 64 + fr, fq * 8), boff = lds_byte(wc * 32 + fr, fq * 8);
#define PG8_SA(b, h) (((b) * 2 + (h)) * HTB)
#define PG8_SB(b, h) ((4 + (b) * 2 + (h)) * HTB)
#define PG8_STAGE(bufoff, gbase, voff) do { _Pragma("unroll") for (int _i = 0; _i < 2; ++_i) \
        __builtin_amdgcn_global_load_lds((const unsigned*)((const char*)(gbase) + (voff)[_i]), (LAS unsigned*)(lds + (bufoff) + ldsw + _i * 8192), 16, 0, 0); } while (0)
#define PG8_LDA(dst, b, h) do { _Pragma("unroll") for (int m = 0; m < 4; ++m) _Pragma("unroll") for (int k = 0; k < 2; ++k) dst[m][k] = *(const LAS f16x8*)(lds + PG8_SA(b, h) + aoff + m * 2048 + k * 1024); } while (0)
#define PG8_LDB(dst, b, h) do { _Pragma("unroll") for (int n = 0; n < 2; ++n) _Pragma("unroll") for (int k = 0; k < 2; ++k) dst[n][k] = *(const LAS f16x8*)(lds + PG8_SB(b, h) + boff + n * 2048 + k * 1024); } while (0)
#define PG8_MMA(ai, bj, At, Bt) do { __builtin_amdgcn_s_setprio(1); _Pragma("unroll") for (int m = 0; m < 4; ++m) _Pragma("unroll") for (int n = 0; n < 2; ++n) _Pragma("unroll") for (int k = 0; k < 2; ++k) \
        acc[ai][bj][m][n] = __builtin_amdgcn_mfma_f32_16x16x32_f16(Bt[n][k], At[m][k], acc[ai][bj][m][n], 0, 0, 0); __builtin_amdgcn_s_setprio(0); } while (0)
#define PG8_WAIT_V(n) asm volatile("s_waitcnt vmcnt(" #n ")" ::: "memory")
#define PG8_WAIT_L(n) asm volatile("s_waitcnt lgkmcnt(" #n ")" ::: "memory")
#define PG8_BAR __builtin_amdgcn_s_barrier()
#define PG8_SCHED __builtin_amdgcn_sched_barrier(0)
    Unit cur, nxt; int ui = 0;
    if (!S.next(0, cur)) return;
#ifdef TIMING
    if (blockIdx.x == 0 && tid == 0) { LAS unsigned long long* ts_ = (LAS unsigned long long*)(lds + 147456 - 512); ts_[26] = __builtin_amdgcn_s_memtime(); }
#endif
    f32x4 acc[2][2][4][2];
#pragma unroll
    for (int a = 0; a < 2; ++a)
#pragma unroll
        for (int b = 0; b < 2; ++b)
#pragma unroll
            for (int m = 0; m < 4; ++m)
#pragma unroll
                for (int n = 0; n < 2; ++n) acc[a][b][m][n] = (f32x4){0.f, 0.f, 0.f, 0.f};
    f16x8 At[4][2], B0[2][2], B1[2][2];
    const char* cA = (const char*)g.A + (size_t)cur.pm * tstepA; const char* cB = (const char*)g.Bt + (size_t)cur.pn * tstepB;
    if constexpr (SP2) {
        PG8_STAGE(PG8_SB(0, 0), cB, voffB); PG8_STAGE(PG8_SB(0, 1), cB + hstepB, voffB); PG8_STAGE(PG8_SA(0, 0), cA, voffA); PG8_STAGE(PG8_SA(0, 1), cA + hstepA, voffA);
        if (wr == 1) PG8_BAR;
        PG8_WAIT_V(2); PG8_BAR;
        PG8_STAGE(PG8_SB(1, 0), cB + kstep, voffB); PG8_STAGE(PG8_SA(1, 0), cA + kstep, voffA); PG8_STAGE(PG8_SB(1, 1), cB + hstepB + kstep, voffB);
        PG8_WAIT_V(6); PG8_BAR;
    } else {
        PG8_STAGE(PG8_SB(0, 0), cB, voffB); PG8_STAGE(PG8_SA(0, 0), cA, voffA); PG8_STAGE(PG8_SB(0, 1), cB + hstepB, voffB); PG8_STAGE(PG8_SA(0, 1), cA + hstepA, voffA);
        if (wr == 1) PG8_BAR;
        PG8_WAIT_V(4); PG8_BAR;
        PG8_STAGE(PG8_SB(1, 0), cB + kstep, voffB); PG8_STAGE(PG8_SA(1, 0), cA + kstep, voffA); PG8_STAGE(PG8_SB(1, 1), cB + hstepB + kstep, voffB);
        PG8_WAIT_V(6); PG8_BAR;
    }
    for (;;) {
        const bool has_next = S.next(ui + 1, nxt);
        const char* nA = has_next ? (const char*)g.A + (size_t)nxt.pm * tstepA : cA; const char* nB = has_next ? (const char*)g.Bt + (size_t)nxt.pn * tstepB : cB;
        for (int t = 0; t < nt; t += 2) {
            if constexpr (MID) { if (t == 8 || t == 16) E.mid(acc, cur, t >> 3, wr, wc, fr, fq); }
            const bool last = (t == nt - 2);
            const char* a1 = cA + (size_t)(t + 1) * kstep;
            const char* a2 = last ? nA : cA + (size_t)(t + 2) * kstep; const char* b2 = last ? nB : cB + (size_t)(t + 2) * kstep;
            const char* a3 = a2 + kstep; const char* b3 = b2 + kstep;
            if constexpr (SP2) {
            PG8_LDB(B0, 0, 0); PG8_LDB(B1, 0, 1); PG8_SCHED; PG8_LDA(At, 0, 0); PG8_STAGE(PG8_SA(1, 1), a1 + hstepA, voffA);
            PG8_WAIT_V(8); PG8_WAIT_L(0); PG8_BAR; PG8_MMA(0, 0, At, B0); PG8_MMA(0, 1, At, B1); PG8_BAR; PG8_SCHED;
            PG8_LDA(At, 0, 1); PG8_STAGE(PG8_SB(0, 0), b2, voffB); PG8_STAGE(PG8_SB(0, 1), b2 + hstepB, voffB); PG8_STAGE(PG8_SA(0, 0), a2, voffA);
            PG8_WAIT_V(8); PG8_WAIT_L(0); PG8_BAR; PG8_MMA(1, 0, At, B0); PG8_MMA(1, 1, At, B1); PG8_BAR; PG8_SCHED;
            PG8_LDB(B0, 1, 0); PG8_LDB(B1, 1, 1); PG8_SCHED; PG8_LDA(At, 1, 0); PG8_STAGE(PG8_SA(0, 1), a2 + hstepA, voffA);
            PG8_WAIT_V(8); PG8_WAIT_L(0); PG8_BAR; PG8_MMA(0, 0, At, B0); PG8_MMA(0, 1, At, B1); PG8_BAR; PG8_SCHED;
            PG8_LDA(At, 1, 1); PG8_STAGE(PG8_SB(1, 0), b3, voffB); PG8_STAGE(PG8_SB(1, 1), b3 + hstepB, voffB); PG8_STAGE(PG8_SA(1, 0), a3, voffA);
            PG8_WAIT_V(8); PG8_WAIT_L(0); PG8_BAR; PG8_MMA(1, 0, At, B0); PG8_MMA(1, 1, At, B1); PG8_BAR; PG8_SCHED;
            } else {
            PG8_LDB(B0, 0, 0); PG8_SCHED; PG8_LDA(At, 0, 0); PG8_STAGE(PG8_SA(1, 1), a1 + hstepA, voffA);
            PG8_WAIT_L(8); PG8_BAR; PG8_WAIT_L(0); PG8_MMA(0, 0, At, B0); PG8_BAR; PG8_SCHED;
            PG8_LDB(B1, 0, 1); PG8_STAGE(PG8_SB(0, 0), b2, voffB);
            PG8_BAR; PG8_WAIT_L(0); PG8_MMA(0, 1, At, B1); PG8_BAR;
            PG8_LDA(At, 0, 1); PG8_STAGE(PG8_SA(0, 0), a2, voffA);
            PG8_BAR; PG8_WAIT_L(0); PG8_MMA(1, 0, At, B0); PG8_BAR; PG8_SCHED;
            PG8_STAGE(PG8_SB(0, 1), b2 + hstepB, voffB);
            PG8_WAIT_V(6); PG8_BAR; PG8_MMA(1, 1, At, B1); PG8_BAR;
            PG8_LDB(B0, 1, 0); PG8_SCHED; PG8_LDA(At, 1, 0); PG8_STAGE(PG8_SA(0, 1), a2 + hstepA, voffA);
            PG8_WAIT_L(8); PG8_BAR; PG8_WAIT_L(0); PG8_MMA(0, 0, At, B0); PG8_BAR; PG8_SCHED;
            PG8_LDB(B1, 1, 1); PG8_STAGE(PG8_SB(1, 0), b3, voffB);
            PG8_BAR; PG8_WAIT_L(0); PG8_MMA(0, 1, At, B1); PG8_BAR;
            PG8_LDA(At, 1, 1); PG8_STAGE(PG8_SA(1, 0), a3, voffA);
            PG8_BAR; PG8_WAIT_L(0); PG8_MMA(1, 0, At, B0); PG8_BAR; PG8_SCHED;
            PG8_STAGE(PG8_SB(1, 1), b3 + hstepB, voffB);
            PG8_WAIT_V(6); PG8_BAR; PG8_MMA(1, 1, At, B1); PG8_BAR;
            }
        }
        if constexpr (ALIGN_EPI) { if (wr == 0) PG8_BAR; }
#ifdef TIMING
        if (blockIdx.x == 0 && tid == 0) { LAS unsigned long long* ts_ = (LAS unsigned long long*)(lds + 147456 - 512); const unsigned long long t_ = wall_clock64(); ts_[28] += t_ - ts_[16]; ts_[16] = t_;
            const unsigned long long c_ = __builtin_amdgcn_s_memtime(); ts_[27] += (c_ - ts_[26]) / 100ull; }
#endif
        E(acc, cur, wr, wc, fr, fq);
#ifdef TIMING
        if (blockIdx.x == 0 && tid == 0) { LAS unsigned long long* ts_ = (LAS unsigned long long*)(lds + 147456 - 512); const unsigned long long t_ = wall_clock64(); ts_[29] += t_ - ts_[16]; ts_[16] = t_; ts_[26] = __builtin_amdgcn_s_memtime(); }
#endif
        if (!has_next) break;
#pragma unroll
        for (int a = 0; a < 2; ++a)
#pragma unroll
            for (int b = 0; b < 2; ++b)
#pragma unroll
                for (int m = 0; m < 4; ++m)
#pragma unroll
                    for (int n = 0; n < 2; ++n) acc[a][b][m][n] = (f32x4){0.f, 0.f, 0.f, 0.f};
        cur = nxt; cA = nA; cB = nB; ++ui;
        if constexpr (ALIGN_EPI) { if (wr == 1) PG8_BAR; }
    }
    PG8_WAIT_V(0);
    if constexpr (!ALIGN_EPI) { if (wr == 0) PG8_BAR; }
    PG8_BAR;
#undef PG8_SA
#undef PG8_SB
#undef PG8_STAGE
#undef PG8_LDA
#undef PG8_LDB
#undef PG8_MMA
#undef PG8_WAIT_V
#undef PG8_WAIT_L
#undef PG8_BAR
#undef PG8_SCHED
}

__device__ __forceinline__ unsigned pk_f16(float a, float b) { f16x2 v; v.x = (f16)a; v.y = (f16)b; return __builtin_bit_cast(unsigned, v); }
__device__ __forceinline__ float row_rstd(const float* ss, int row) {
    const f32x4* p = (const f32x4*)(ss + (size_t)row * 16);
    const f32x4 a = p[0], b = p[1], c = p[2], d = p[3];
    const float s = ((a[0] + a[1]) + (a[2] + a[3])) + ((b[0] + b[1]) + (b[2] + b[3])) + ((c[0] + c[1]) + (c[2] + c[3])) + ((d[0] + d[1]) + (d[2] + d[3]));
    return 1.0f / sqrtf(s * (1.0f / DM) + NORM_EPS);
}

constexpr int RS_SLOTS = 14;
__device__ __forceinline__ void rs_tables(LAS float* rs, const float* ss, const StaticOrder& S, int wv) {
    int tid = TIDX(wv); asm volatile("" : "+v"(tid));
    LAS unsigned char* slot = (LAS unsigned char*)(rs + RS_SLOTS * BM);
    Unit u; int ns = 0, prev = -1;
    for (int i = 0; i < 64 && S.next(i, u); ++i) {
        if (u.pm != prev) { if (ns < RS_SLOTS) { if (tid < BM) rs[ns * BM + tid] = row_rstd(ss, u.pm * BM + tid); ++ns; } prev = u.pm; }
        if (tid == 0) slot[i] = (unsigned char)(ns - 1);
    }
    __syncthreads();
}
template <bool SIG> struct EpiScaleF16T {
    f16* O; int ldc; const LAS float* rs;
    __device__ __forceinline__ void operator()(const f32x4 (&acc)[2][2][4][2], const Unit& u, int wr, int wc, int fr, int fq) const {
        const int row0 = u.pm * BM + wr * 64 + fr, col0 = u.pn * BM + wc * 32 + 8 * fq;
        const __amdgpu_buffer_rsrc_t orsrc = __builtin_amdgcn_make_buffer_rsrc((void*)O, 0, MTOK * ldc * 2, 0x00020000);
        float rsv[8];
        { const LAS float* rp = rs + (int)((const LAS unsigned char*)(rs + RS_SLOTS * BM))[u.ord] * BM + wr * 64 + fr;
#pragma unroll
          for (int k = 0; k < 8; ++k) rsv[k] = rp[(k >> 2) * HALF + (k & 3) * 16]; }
#pragma unroll
        for (int ai = 0; ai < 2; ++ai)
#pragma unroll
            for (int m = 0; m < 4; ++m) { const int row = row0 + ai * HALF + m * 16; const float rs = rsv[ai * 4 + m]; const int rowb = (row * ldc + col0) * 2;
#pragma unroll
                for (int bj = 0; bj < 2; ++bj) { f32x4 v0 = acc[ai][bj][m][0] * rs, v1 = acc[ai][bj][m][1] * rs;
                    if (SIG) {
#pragma unroll
                        for (int j = 0; j < 4; ++j) { v0[j] = fmaxf(sigmoidf_(v0[j]), 6.103515625e-05f); v1[j] = fmaxf(sigmoidf_(v1[j]), 6.103515625e-05f); } }
                    u32x4 w; w.x = pk_f16(v0[0], v0[1]); w.y = pk_f16(v0[2], v0[3]); w.z = pk_f16(v1[0], v1[1]); w.w = pk_f16(v1[2], v1[3]);
                    if (SIG) *(u32x4*)((char*)O + rowb + bj * HALF * 2) = w;
                    else __builtin_amdgcn_raw_buffer_store_b128(w, orsrc, rowb + bj * HALF * 2, 0, 16); } }
    }
};
typedef EpiScaleF16T<false> EpiScaleF16;
struct EpiMerge {
    const f16* gate; f16* mix16;
    __device__ __forceinline__ void mid(f32x4 (&acc)[2][2][4][2], const Unit& u, int seg, int wr, int wc, int fr, int fq) const {
        int row0 = u.pm * BM + wr * 64 + fr; const int col0 = u.pn * BM + wc * 32 + 8 * fq;
        asm volatile("" : "+v"(row0));
#define EM_LD(GA, GB, Q4) do { _Pragma("unroll") for (int i = 0; i < 4; ++i) { const int ai = (Q4) >> 1, m = ((Q4) & 1) * 2 + (i >> 1), bj = i & 1; \
            const f16* gp = gate + (size_t)(row0 + ai * HALF + m * 16) * NG + (seg - 1) * 1024 + col0 + bj * HALF; GA[i] = *(const f16x8*)gp; GB[i] = *(const f16x8*)(gp + 1024); } } while (0)
#define EM_AP(GA, GB, Q4) do { PIN4(GA); PIN4(GB); _Pragma("unroll") for (int i = 0; i < 4; ++i) { const int ai = (Q4) >> 1, m = ((Q4) & 1) * 2 + (i >> 1), bj = i & 1; \
            _Pragma("unroll") for (int j = 0; j < 4; ++j) { acc[ai][bj][m][0][j] *= (float)GA[i][j] * fast_rcp((float)GB[i][j]); acc[ai][bj][m][1][j] *= (float)GA[i][4 + j] * fast_rcp((float)GB[i][4 + j]); } } } while (0)
        f16x8 ga0[4], gb0[4], ga1[4], gb1[4];
        EM_LD(ga0, gb0, 0); EM_LD(ga1, gb1, 1); __builtin_amdgcn_sched_barrier(0);
        EM_AP(ga0, gb0, 0); __builtin_amdgcn_sched_barrier(0); EM_LD(ga0, gb0, 2); __builtin_amdgcn_sched_barrier(0);
        EM_AP(ga1, gb1, 1); __builtin_amdgcn_sched_barrier(0); EM_LD(ga1, gb1, 3); __builtin_amdgcn_sched_barrier(0);
        EM_AP(ga0, gb0, 2); EM_AP(ga1, gb1, 3);
#undef EM_LD
#undef EM_AP
    }
    __device__ __forceinline__ void operator()(const f32x4 (&acc)[2][2][4][2], const Unit& u, int wr, int wc, int fr, int fq) const {
        const int row0 = u.pm * BM + wr * 64 + fr, col0 = u.pn * BM + wc * 32 + 8 * fq;
        f16x8 gvA[8], gvB[8];
#pragma unroll
        for (int i = 0; i < 8; ++i) { gvA[i] = *(const f16x8*)(gate + (size_t)(row0 + (i >> 1) * 16) * NG + 2048 + col0 + (i & 1) * HALF);
                                      gvB[i] = *(const f16x8*)(gate + (size_t)(row0 + HALF + (i >> 1) * 16) * NG + 2048 + col0 + (i & 1) * HALF); }
        __builtin_amdgcn_sched_barrier(0);
#pragma unroll
        for (int ai = 0; ai < 2; ++ai) {
            if (ai == 0) PIN8(gvA); else PIN8(gvB);
#pragma unroll
            for (int m = 0; m < 4; ++m) { const int row = row0 + ai * HALF + m * 16;
#pragma unroll
                for (int bj = 0; bj < 2; ++bj) { const int col = col0 + bj * HALF;
                    const f16x8 gv = ai == 0 ? gvA[m * 2 + bj] : gvB[m * 2 + bj];
                    f32x4 v0 = acc[ai][bj][m][0], v1 = acc[ai][bj][m][1];
#pragma unroll
                    for (int j = 0; j < 4; ++j) { v0[j] *= (float)gv[j]; v1[j] *= (float)gv[4 + j]; }
                    u32x4 w; w.x = pk_f16(v0[0], v0[1]); w.y = pk_f16(v0[2], v0[3]); w.z = pk_f16(v1[0], v1[1]); w.w = pk_f16(v1[2], v1[3]);
                    *(u32x4*)(mix16 + (size_t)row * DM + col) = w; } } }
    }
};
struct EpiResid {
    f16* x16; float* ss;
    __device__ __forceinline__ void operator()(const f32x4 (&acc)[2][2][4][2], const Unit& u, int wr, int wc, int fr, int fq) const {
        const int row0 = u.pm * BM + wr * 64 + fr, col0 = u.pn * BM + wc * 32 + 8 * fq;
        f16x8 xvA[8], xvB[8];
#pragma unroll
        for (int i = 0; i < 8; ++i) { xvA[i] = *(const f16x8*)(x16 + (size_t)(row0 + (i >> 1) * 16) * DM + col0 + (i & 1) * HALF);
                                      xvB[i] = *(const f16x8*)(x16 + (size_t)(row0 + HALF + (i >> 1) * 16) * DM + col0 + (i & 1) * HALF); }
        __builtin_amdgcn_sched_barrier(0);
#pragma unroll
        for (int ai = 0; ai < 2; ++ai) {
            if (ai == 0) PIN8(xvA); else PIN8(xvB);
#pragma unroll
            for (int m = 0; m < 4; ++m) { const int row = row0 + ai * HALF + m * 16; float sq = 0.f;
#pragma unroll
                for (int bj = 0; bj < 2; ++bj) { const size_t off = (size_t)row * DM + col0 + bj * HALF; const f16x8 xr = ai == 0 ? xvA[m * 2 + bj] : xvB[m * 2 + bj];
                    f32x4 v0 = acc[ai][bj][m][0], v1 = acc[ai][bj][m][1];
#pragma unroll
                    for (int j = 0; j < 4; ++j) { v0[j] += (float)xr[j]; v1[j] += (float)xr[4 + j]; }
                    u32x4 w; w.x = pk_f16(v0[0], v0[1]); w.y = pk_f16(v0[2], v0[3]); w.z = pk_f16(v1[0], v1[1]); w.w = pk_f16(v1[2], v1[3]);
                    *(u32x4*)(x16 + off) = w;
                    sq += (v0[0] * v0[0] + v0[1] * v0[1]) + (v0[2] * v0[2] + v0[3] * v0[3]) + (v1[0] * v1[0] + v1[1] * v1[1]) + (v1[2] * v1[2] + v1[3] * v1[3]); }
                { const int ln_ = fq * 16 + fr; sq += shx(sq, 16, ln_); sq += shx(sq, 32, ln_); }
                if (fq == 0) ss[(size_t)row * 16 + u.pn * 4 + wc] = sq; }
        }
    }
};
}

constexpr size_t WS_CTL   = 0;
constexpr size_t CTL_BYTES = 65536;
constexpr size_t WS_WINT  = WS_CTL + CTL_BYTES;
constexpr size_t WS_WBRT  = WS_WINT + (size_t)DEPTH * 9216 * 1024 * 2;
constexpr size_t WS_WOUTT = WS_WBRT + (size_t)DEPTH * 3 * 1024 * 512 * 2;
constexpr size_t WS_WUK   = WS_WOUTT + (size_t)DEPTH * 1024 * 1024 * 2;
constexpr size_t WS_WUV   = WS_WUK + (size_t)DEPTH * 8 * 128 * 64 * 2;
constexpr size_t WS_ROPE  = WS_WUV + (size_t)DEPTH * 8 * 64 * 128 * 2;
constexpr size_t WS_X16   = WS_ROPE + (size_t)SEQ * 16 * 4;
constexpr size_t WS_SS    = WS_X16 + (size_t)MTOK * DM * 2;
constexpr size_t WS_P16   = WS_SS + (size_t)MTOK * 16 * 4;
constexpr size_t WS_G16   = WS_P16;
constexpr size_t WS_MIX16 = WS_P16 + (size_t)MTOK * NG * 2;
constexpr size_t WS_QC    = WS_P16 + (size_t)MTOK * NA * 2;
constexpr size_t WS_KV    = WS_QC + (size_t)MTOK * 8 * 160 * 2;
constexpr size_t WS_IQ    = WS_KV + (size_t)MTOK * 160 * 2;
constexpr size_t WS_IK    = WS_IQ + (size_t)MTOK * 256 * 2;
constexpr size_t WS_IW    = WS_IK + (size_t)MTOK * 64 * 2;
constexpr size_t WS_MLQ   = WS_IW + (size_t)MTOK * 4 * 4;
constexpr size_t WS_MLK   = WS_MLQ + (size_t)MTOK * 512 * 2;
constexpr size_t WS_VT    = WS_MLK + (size_t)MTOK * 512 * 2;
constexpr size_t WS_MLVT  = WS_VT + (size_t)MTOK * 512 * 2;
constexpr size_t WS_GATE  = WS_MLVT + (size_t)MTOK * 512 * 2;
constexpr size_t WS_CHS   = WS_GATE + (size_t)MTOK * 8 * 4;
constexpr size_t WS_DN    = WS_CHS + (size_t)16 * 64 * 4 * 4;
constexpr size_t WS_Y3    = WS_DN + (size_t)16 * 64 * 128 * 4;
constexpr size_t WS_DCT   = WS_Y3 + (size_t)MTOK * 1536 * 2;
constexpr size_t WS_END   = WS_DCT + (size_t)16 * 64 * 16384 * 2;

constexpr int LDS_STAGE = 131072;
constexpr int LDS_BYTES = 147456;
constexpr int LDS_MISC  = LDS_STAGE;
constexpr int NTHREADS = 512;

struct Args {
    const float* x; const float* w_in; const float* w_uk; const float* w_uv; const float* kvn_w; const float* conv_w; const float* i_bias; const float* f_bias;
    const float* mln_w; const float* w_branch; const float* w_out; const float* norm_w; const float* fnorm_w;
    float* out; unsigned char* ws;
    int wv, pad_;
};

__device__ __forceinline__ int win_src_col(int n) {
    if (n < 980) return n;
    if (n < 984) return 5076 + (n - 980);
    if (n < 988) return 5080 + (n - 984);
    if (n < 1024) return -1;
    if (n < 1536) return 980 + (n - 1024);
    if (n < 3584) return 1492 + (n - 1536);
    if (n < 4608) return 3540 + (n - 3584);
    if (n < 5120) return 4564 + (n - 4608);
    if (n < 5632) return 5084 + (n - 5120);
    if (n < 6144) return 5596 + (n - 5632);
    return 6108 + (n - 6144);
}

struct ConvTile { const float* src; const float* scale; f16* dst; int src_ld, dst_ld, k0, n0, winmap; };
__device__ __forceinline__ ConvTile conv_desc(const Args& a, unsigned char* ws, int u) {
    constexpr int T_WIN = DEPTH * 16 * 144, T_WBR = DEPTH * 3 * 8 * 16, T_WOUT = DEPTH * 16 * 16;
    ConvTile d;
    if (u < T_WIN) { const int l = u / (16 * 144), r = u % (16 * 144), kt = r / 144, nt = r % 144;
        d.src = a.w_in + (size_t)l * DM * WIN_COLS; d.src_ld = WIN_COLS; d.k0 = kt * 64; d.n0 = nt * 64; d.dst = (f16*)(ws + WS_WINT) + (size_t)l * 9216 * 1024; d.dst_ld = 1024; d.scale = a.norm_w + l * DM; d.winmap = 1;
    } else if (u < T_WIN + T_WBR) { const int v = u - T_WIN, lg = v / 128, r = v % 128, kt = r / 16, nt = r % 16;
        d.src = a.w_branch + (size_t)lg * 512 * 1024; d.src_ld = 1024; d.k0 = kt * 64; d.n0 = nt * 64; d.dst = (f16*)(ws + WS_WBRT) + (size_t)(lg / 3) * 1024 * 1536 + (lg % 3) * 512; d.dst_ld = 1536; d.scale = nullptr; d.winmap = 0;
    } else if (u < T_WIN + T_WBR + T_WOUT) { const int v = u - T_WIN - T_WBR, l = v / 256, r = v % 256, kt = r / 16, nt = r % 16;
        d.src = a.w_out + (size_t)l * DM * DM; d.src_ld = DM; d.k0 = kt * 64; d.n0 = nt * 64; d.dst = (f16*)(ws + WS_WOUTT) + (size_t)l * DM * DM; d.dst_ld = DM; d.scale = nullptr; d.winmap = 0;
    } else { const int v = u - T_WIN - T_WBR - T_WOUT, l = v / 16, r = v % 16, kt = r / 8, nt = r % 8;
        d.src = a.w_uv + (size_t)l * 128 * 512; d.src_ld = 512; d.k0 = kt * 64; d.n0 = nt * 64; d.dst = (f16*)(ws + WS_WUV) + (size_t)l * 512 * 128; d.dst_ld = 128; d.scale = nullptr; d.winmap = 0; }
    return d;
}
__device__ __forceinline__ void conv_load(const ConvTile& d, int tid, float (&vv)[8], float (&sv)[8]) {
    const int c = tid & 63, r0 = tid >> 6; const int sc = d.winmap ? win_src_col(d.n0 + c) : (d.n0 + c); const int scl = sc >= 0 ? sc : 0;
    const float* sp = d.scale ? d.scale : d.src;
#pragma unroll
    for (int i = 0; i < 8; ++i) { const int r = r0 + 8 * i; vv[i] = d.src[(size_t)(d.k0 + r) * d.src_ld + scl]; sv[i] = sp[d.k0 + r]; }
}

__device__ __forceinline__ void p0_prologue(const Args& a, LAS unsigned char* lds) {
    LAS float* t = (LAS float*)lds;
    unsigned char* ws = a.ws; LAUNDER_S(ws);
    const int G = gridDim.x, bid = blockIdx.x; int tid = TIDX(a.wv); asm volatile("" : "+v"(tid));
    constexpr int T_ALL = DEPTH * 16 * 144 + DEPTH * 3 * 8 * 16 + DEPTH * 16 * 16 + DEPTH * 2 * 8;
    { float nv[8], ns[8]; conv_load(conv_desc(a, ws, bid < T_ALL ? bid : 0), tid, nv, ns);
      for (int u = bid; u < T_ALL; u += G) {
        const ConvTile d = conv_desc(a, ws, u);
        float vv[8];
        { const int cc = tid & 63; const bool pad = d.winmap && win_src_col(d.n0 + cc) < 0; const bool hs = d.scale != nullptr;
#pragma unroll
          for (int i = 0; i < 8; ++i) vv[i] = pad ? 0.f : (hs ? nv[i] * ns[i] : nv[i]); }
        conv_load(conv_desc(a, ws, u + G < T_ALL ? u + G : u), tid, nv, ns);
        const int c = tid & 63, r0 = tid >> 6;
#pragma unroll
        for (int i = 0; i < 8; ++i) t[(r0 + 8 * i) * 65 + c] = vv[i];
        __syncthreads();
        { const int n = tid >> 3, kg = tid & 7; f16x8 v;
#pragma unroll
          for (int j = 0; j < 8; ++j) v[j] = (f16)t[(8 * kg + j) * 65 + n];
          *(f16x8*)(d.dst + (size_t)(d.n0 + n) * d.dst_ld + d.k0 + 8 * kg) = v; }
        __syncthreads();
      } }
    const size_t gtid = (size_t)bid * NTHREADS + tid, gsz = (size_t)G * NTHREADS;
    for (size_t i = gtid; i < (size_t)DEPTH * 8 * 128 * 64; i += gsz) { const int k = i & 63, r = (i >> 6) & 127, h = (i >> 13) & 7, l = (int)(i >> 16);
        ((f16*)(ws + WS_WUK))[i] = k < 48 ? (f16)a.w_uk[(((size_t)l * 128 + r) * 8 + h) * 48 + k] : (f16)0.f; }
    for (size_t i = gtid; i < (size_t)SEQ * 8; i += gsz) { const int pos = (int)(i >> 3), j = (int)(i & 7);
        const double inv[8] = {1.0, 0.19392274474868576, 0.03760603093086393, 0.007292664737217109, 0.001414213562373095, 0.0002742481756762073, 5.318295896944988e-05, 1.031338537721246e-05};
        double iv = inv[0];
#pragma unroll
        for (int q = 1; q < 8; ++q) iv = (j == q) ? inv[q] : iv;
        const double x = (double)pos * iv, n = rint(x * 0.15915494309189535);
        const double r = (x - n * 6.283185307179586) - n * 2.4492935982947064e-16;
        float* rp = (float*)(ws + WS_ROPE) + (size_t)pos * 16;
        rp[j] = cosf((float)r); rp[8 + j] = sinf((float)r); }
    { const int wave = tid >> 6, lane = tid & 63;
      for (int row = bid * 8 + wave; row < MTOK; row += G * 8) {
        const float* xr = a.x + (size_t)row * DM; f16* o = (f16*)(ws + WS_X16) + (size_t)row * DM; float sq = 0.f;
#pragma unroll
        for (int i = 0; i < 4; ++i) { const f32x4 v = *(const f32x4*)(xr + i * 256 + lane * 4); sq += (v[0] * v[0] + v[1] * v[1]) + (v[2] * v[2] + v[3] * v[3]);
            u32x2 w; w.x = pg8::pk_f16(v[0], v[1]); w.y = pg8::pk_f16(v[2], v[3]); *(u32x2*)(o + i * 256 + lane * 4) = w; }
#pragma unroll
        for (int o2 = 32; o2 >= 1; o2 >>= 1) sq += shx(sq, o2, lane);
        if (lane < 16) ((float*)(ws + WS_SS))[(size_t)row * 16 + lane] = lane == 0 ? sq : 0.f;
      } }
}

__device__ __forceinline__ void sb_attn_unit(const f16* __restrict__ P16, const f16* __restrict__ VT, f16* __restrict__ Y3, int b, int h, int qt, int lane_in) {
    int lane = lane_in; asm volatile("" : "+v"(lane));
    const int q0 = qt * 32, hh = lane >> 5, ln = lane & 31;
    const size_t rowq = (size_t)(b * SEQ + q0 + ln) * NA;
    f16x8 qf[4];
#pragma unroll
    for (int s = 0; s < 4; ++s) qf[s] = *(const f16x8*)(P16 + rowq + C_SQ + h * 64 + 16 * s + 8 * hh);
    f32x16 o0, o1;
#pragma unroll
    for (int r = 0; r < 16; ++r) { o0[r] = 0.f; o1[r] = 0.f; }
    float carry = 1.0f;
    const f16* vt = VT + ((size_t)(b * 8 + h) * 64) * SEQ;
    const int query = q0 + ln;
    for (int kt = qt; kt >= 0; --kt) {
        const int k0 = kt * 32;
        const f16* kp = P16 + (size_t)(b * SEQ + k0 + ln) * NA + C_SK + h * 64 + 8 * hh;
        f32x16 z;
#pragma unroll
        for (int r = 0; r < 16; ++r) z[r] = 0.f;
        { f16x8 kfa[4];
#pragma unroll
          for (int s = 0; s < 4; ++s) kfa[s] = *(const f16x8*)(kp + 16 * s);
          PIN4(kfa);
#pragma unroll
          for (int s = 0; s < 4; ++s) z = __builtin_amdgcn_mfma_f32_32x32x16_f16(kfa[s], qf[s], z, 0, 0, 0); }
        float av[16], p[4], pp[4];
#pragma unroll
        for (int a = 0; a < 4; ++a) {
            float st[4], be[4];
#pragma unroll
            for (int c = 0; c < 4; ++c) { const int key = k0 + c + 8 * a + 4 * hh; const bool valid = key < query;
                const float zz = fminf(z[4 * a + c] * 0.125f, 80.f); const float u = fast_exp(zz); const float s_ = fast_rcp(1.0f + u);
                st[c] = valid ? s_ : 1.0f; be[c] = valid ? u * s_ : 0.0f; }
            const float s2 = st[3], s1 = s2 * st[2], s0 = s1 * st[1];
            p[a] = s0 * st[0];
            av[4 * a + 3] = be[3]; av[4 * a + 2] = be[2] * s2; av[4 * a + 1] = be[1] * s1; av[4 * a + 0] = be[0] * s0;
        }
#pragma unroll
        for (int a = 0; a < 4; ++a) pp[a] = shx(p[a], 32, lane);
        const float T0 = p[0] * pp[0], T1 = p[1] * pp[1], T2 = p[2] * pp[2], T3 = p[3] * pp[3];
        float grp[4];
        grp[3] = carry; grp[2] = carry * T3; grp[1] = grp[2] * T2; grp[0] = grp[1] * T1;
        const float ncarry = grp[0] * T0;
        if (hh == 0) {
#pragma unroll
            for (int a = 0; a < 4; ++a) grp[a] *= pp[a];
        }
        f16x8 bf0, bf1;
#pragma unroll
        for (int j = 0; j < 8; ++j) { bf0[j] = (f16)(av[j] * grp[j >> 2]); bf1[j] = (f16)(av[8 + j] * grp[2 + (j >> 2)]); }
        { f16x8 va[4];
#pragma unroll
          for (int dt = 0; dt < 2; ++dt) { const f16* vp = vt + (size_t)(32 * dt + ln) * SEQ + k0 + 4 * hh;
            { const f16x4 lo = *(const f16x4*)(vp), hi = *(const f16x4*)(vp + 8); va[2 * dt] = __builtin_shufflevector(lo, hi, 0, 1, 2, 3, 4, 5, 6, 7); }
            { const f16x4 lo = *(const f16x4*)(vp + 16), hi = *(const f16x4*)(vp + 24); va[2 * dt + 1] = __builtin_shufflevector(lo, hi, 0, 1, 2, 3, 4, 5, 6, 7); } }
          PIN4(va);
          o0 = __builtin_amdgcn_mfma_f32_32x32x16_f16(va[0], bf0, o0, 0, 0, 0); o0 = __builtin_amdgcn_mfma_f32_32x32x16_f16(va[1], bf1, o0, 0, 0, 0);
          o1 = __builtin_amdgcn_mfma_f32_32x32x16_f16(va[2], bf0, o1, 0, 0, 0); o1 = __builtin_amdgcn_mfma_f32_32x32x16_f16(va[3], bf1, o1, 0, 0, 0); }
        carry = ncarry;
        if (__all(carry < 1e-30f)) break;
    }
    const size_t rowt = (size_t)(b * SEQ + query);
    f16x4 zgv[8];
#pragma unroll
    for (int i = 0; i < 8; ++i) zgv[i] = *(const f16x4*)(P16 + rowt * NA + C_SZ + h * 64 + 32 * (i >> 2) + 8 * (i & 3) + 4 * hh);
#pragma unroll
    for (int dt = 0; dt < 2; ++dt)
#pragma unroll
        for (int a = 0; a < 4; ++a) { const int dim = 32 * dt + 8 * a + 4 * hh;
            f16x4 y;
#pragma unroll
            for (int c = 0; c < 4; ++c) { const float ov = dt == 0 ? o0[4 * a + c] : o1[4 * a + c]; y[c] = (f16)(ov * siluf_((float)zgv[4 * dt + a][c])); }
            *(f16x4*)(Y3 + rowt * 1536 + 512 + h * 64 + dim) = y; }
}

__device__ __forceinline__ void transpose_slab(LAS unsigned char* lds, const f16* __restrict__ P16, int coff, int b, int s0, f16* __restrict__ dstT, int wv);

#ifdef TIMING
#define BSTAMP(k) do { if (blockIdx.x == 0 && TIDX(a.wv) == 0) { LAS unsigned long long* ts_ = (LAS unsigned long long*)(lds + LDS_BYTES - 512); const unsigned long long t_ = wall_clock64(); ts_[k] += t_ - ts_[16]; ts_[16] = t_; } } while (0)
#else
#define BSTAMP(k) do {} while (0)
#endif
__device__ __forceinline__ void phase_b_unit(const Args& a, LAS unsigned char* lds, int l, int b, int ck) {
    int tid = TIDX(a.wv); asm volatile("" : "+v"(tid));
    const int wave = __builtin_amdgcn_readfirstlane(tid >> 6), lane = tid & 63;
    unsigned char* ws = a.ws; LAUNDER_S(ws);
    const f16* __restrict__ P16 = (const f16*)(ws + WS_P16);
    const int s0 = ck * 64; const size_t tok0 = (size_t)b * SEQ + s0;
    const float* __restrict__ rope = (const float*)(ws + WS_ROPE);

    transpose_slab(lds, P16, C_SV, b, s0, (f16*)(ws + WS_VT), a.wv);
    transpose_slab(lds, P16, C_MV, b, s0, (f16*)(ws + WS_MLVT), a.wv);

    BSTAMP(18);
    { f16* __restrict__ KV = (f16*)(ws + WS_KV);
      const float w0 = a.kvn_w[l * 128 + 2 * lane], w1 = a.kvn_w[l * 128 + 2 * lane + 1];
      f16x2 xv[8]; float k1[8], k2[8], rc[8], rsn[8];
#pragma unroll
      for (int i = 0; i < 8; ++i) { const int s = wave * 8 + i; const f16* pr = P16 + (tok0 + s) * NA;
        xv[i] = *(const f16x2*)(pr + C_CKV + 2 * lane); k1[i] = (float)pr[C_KR + (lane & 7)]; k2[i] = (float)pr[C_KR + 8 + (lane & 7)];
        rc[i] = rope[(s0 + s) * 16 + (lane & 7)]; rsn[i] = rope[(s0 + s) * 16 + 8 + (lane & 7)]; }
      PIN8(xv); PIN8(k1); PIN8(k2); PIN8(rc); PIN8(rsn);
#pragma unroll
      for (int i = 0; i < 8; ++i) { const int s = wave * 8 + i; const size_t t = tok0 + s;
        const float x0 = (float)xv[i][0], x1 = (float)xv[i][1];
        float sq = x0 * x0 + x1 * x1;
#pragma unroll
        for (int o = 32; o >= 1; o >>= 1) sq += shx(sq, o, lane);
        const float rs = 1.0f / sqrtf(sq * (1.0f / 128.0f) + NORM_EPS);
        f16x2 o2; o2[0] = (f16)(x0 * rs * w0); o2[1] = (f16)(x1 * rs * w1);
        *(f16x2*)(KV + t * 160 + 2 * lane) = o2;
        if (lane < 8) { KV[t * 160 + 128 + lane] = (f16)(k1[i] * rc[i] - k2[i] * rsn[i]); KV[t * 160 + 136 + lane] = (f16)(k2[i] * rc[i] + k1[i] * rsn[i]); }
        else if (lane < 16) { f16x2 z; z[0] = (f16)0.f; z[1] = (f16)0.f; *(f16x2*)(KV + t * 160 + 144 + 2 * (lane - 8)) = z; }
      } }
    { f16* __restrict__ IQ = (f16*)(ws + WS_IQ); f16* __restrict__ IK = (f16*)(ws + WS_IK); float* __restrict__ IW = (float*)(ws + WS_IW);
      f16x8 vv[5], ov[5]; f32x4 rca[5], rcb[5], rsa[5], rsb[5];
#pragma unroll
      for (int i = 0; i < 5; ++i) { const int e = tid + 512 * i, s = e / 40, c0 = (e % 40) * 8; const f16* pr = P16 + (tok0 + s) * NA + C_IQ;
        vv[i] = *(const f16x8*)(pr + c0); ov[i] = *(const f16x8*)(pr + (c0 ^ 8));
        const float* rp = rope + (s0 + s) * 16; rca[i] = *(const f32x4*)rp; rcb[i] = *(const f32x4*)(rp + 4); rsa[i] = *(const f32x4*)(rp + 8); rsb[i] = *(const f32x4*)(rp + 12); }
      asm volatile("" :: "v"(vv[0]), "v"(vv[1]), "v"(vv[2]), "v"(vv[3]), "v"(vv[4]), "v"(ov[0]), "v"(ov[1]), "v"(ov[2]), "v"(ov[3]), "v"(ov[4]));
      asm volatile("" :: "v"(rca[0]), "v"(rca[1]), "v"(rca[2]), "v"(rca[3]), "v"(rca[4]), "v"(rcb[0]), "v"(rcb[1]), "v"(rcb[2]), "v"(rcb[3]), "v"(rcb[4]));
      asm volatile("" :: "v"(rsa[0]), "v"(rsa[1]), "v"(rsa[2]), "v"(rsa[3]), "v"(rsa[4]), "v"(rsb[0]), "v"(rsb[1]), "v"(rsb[2]), "v"(rsb[3]), "v"(rsb[4]));
#pragma unroll
      for (int i = 0; i < 5; ++i) { const int e = tid + 512 * i, s = e / 40, c0 = (e % 40) * 8; const size_t t = tok0 + s; const int d0 = c0 & 63;
        f16x8 v = vv[i];
        if (d0 < 16) {
#pragma unroll
            for (int jj = 0; jj < 8; ++jj) { const float cs = jj < 4 ? rca[i][jj & 3] : rcb[i][jj & 3], sn = jj < 4 ? rsa[i][jj & 3] : rsb[i][jj & 3];
                v[jj] = (f16)(d0 == 0 ? (float)vv[i][jj] * cs - (float)ov[i][jj] * sn : (float)vv[i][jj] * cs + (float)ov[i][jj] * sn); } }
        if (c0 < 256) *(f16x8*)(IQ + t * 256 + c0) = v; else *(f16x8*)(IK + t * 64 + (c0 - 256)) = v; }
      if (tid < 256) { const int s = tid >> 2, h = tid & 3; IW[(tok0 + s) * 4 + h] = (float)P16[(tok0 + s) * NA + C_IW + h]; } }
    BSTAMP(19);
    { const int h = wave, fr = lane & 15, fq = lane >> 4; f16* __restrict__ QC = (f16*)(ws + WS_QC);
      const f16* Wk = (const f16*)(ws + WS_WUK) + ((size_t)(l * 8 + h) * 128) * 64;
      f16x8 af[4][2], wb0[8], wb1[8];
#pragma unroll
      for (int mt = 0; mt < 4; ++mt)
#pragma unroll
        for (int ks = 0; ks < 2; ++ks) af[mt][ks] = *(const f16x8*)(P16 + (tok0 + 16 * mt + fr) * NA + C_DQ + h * 64 + 16 + 32 * ks + 8 * fq);
#pragma unroll
      for (int rt = 0; rt < 8; ++rt) { wb0[rt] = *(const f16x8*)(Wk + (size_t)(16 * rt + fr) * 64 + 8 * fq); wb1[rt] = *(const f16x8*)(Wk + (size_t)(16 * rt + fr) * 64 + 32 + 8 * fq); }
      PIN8(&af[0][0]); PIN8(wb0); PIN8(wb1);
#pragma unroll
      for (int rt = 0; rt < 8; ++rt) {
        const f16x8 b0 = wb0[rt], b1 = wb1[rt];
#pragma unroll
        for (int mt = 0; mt < 4; ++mt) { f32x4 acc = (f32x4){0.f, 0.f, 0.f, 0.f};
            acc = __builtin_amdgcn_mfma_f32_16x16x32_f16(b0, af[mt][0], acc, 0, 0, 0); acc = __builtin_amdgcn_mfma_f32_16x16x32_f16(b1, af[mt][1], acc, 0, 0, 0);
            f16x4 o; o[0] = (f16)(acc[0] * 0.125f); o[1] = (f16)(acc[1] * 0.125f); o[2] = (f16)(acc[2] * 0.125f); o[3] = (f16)(acc[3] * 0.125f);
            *(f16x4*)(QC + ((tok0 + 16 * mt + fr) * 8 + h) * 160 + 16 * rt + 4 * fq) = o; }
      }
      { const size_t t = tok0 + lane; const f16* pr = P16 + t * NA + C_DQ + h * 64; f16* qo = QC + (t * 8 + h) * 160 + 128;
        const f16x8 x1 = *(const f16x8*)pr, x2 = *(const f16x8*)(pr + 8); f16x8 o1, o2, z;
#pragma unroll
        for (int j = 0; j < 8; ++j) { const float cs = rope[(s0 + lane) * 16 + j], sn = rope[(s0 + lane) * 16 + 8 + j];
            o1[j] = (f16)(((float)x1[j] * cs - (float)x2[j] * sn) * 0.125f); o2[j] = (f16)(((float)x2[j] * cs + (float)x1[j] * sn) * 0.125f); z[j] = (f16)0.f; }
        *(f16x8*)qo = o1; *(f16x8*)(qo + 8) = o2; *(f16x8*)(qo + 16) = z; *(f16x8*)(qo + 24) = z; } }

    BSTAMP(23);
    LAS float* wf = (LAS float*)(lds + 73728);
    if (wave < 4) { const int h = wave; const size_t t = tok0 + lane;
        const float iv = (float)P16[t * NA + C_MI + h] + a.i_bias[l * 4 + h];
        const float fv = (float)P16[t * NA + C_MF + h] + a.f_bias[l * 4 + h];
        float bcum = logsigmoidf_(fv);
#pragma unroll
        for (int o = 1; o < 64; o <<= 1) { const float u = shu(bcum, o, lane); if (lane >= o) bcum += u; }
        const float blast = shi(bcum, 63);
        const float lw = blast - bcum + iv; float ml = lw;
#pragma unroll
        for (int o = 32; o >= 1; o >>= 1) ml = fmaxf(ml, shx(ml, o, lane));
        f32x2 gg; gg[0] = bcum; gg[1] = iv - bcum; *(f32x2*)((float*)(ws + WS_GATE) + (t * 4 + h) * 2) = gg;
        wf[h * 64 + lane] = __expf(lw - ml);
        if (lane == 0) { f32x4 cs; cs[0] = blast; cs[1] = ml; cs[2] = 0.f; cs[3] = 0.f; *(f32x4*)((float*)(ws + WS_CHS) + ((size_t)(b * 4 + h) * 64 + ck) * 4) = cs; } }
    __syncthreads();
    constexpr int RST = 144;
    { const int cg = tid & 127, tg = tid >> 7;
      const float* cw = a.conv_w + (size_t)l * 4 * 1024 + 8 * cg;
      f32x4 w[4][2];
#pragma unroll
      for (int jj = 0; jj < 4; ++jj) { w[jj][0] = *(const f32x4*)(cw + jj * 1024); w[jj][1] = *(const f32x4*)(cw + jj * 1024 + 4); }
      const int sb = 16 * tg; f16x8 x[19];
#pragma unroll
      for (int i = 0; i < 19; ++i) { const int s = sb - 3 + i;
          if (s >= 0 || ck > 0) x[i] = *(const f16x8*)(P16 + (size_t)((long)tok0 + s) * NA + C_MQK + 8 * cg); else {
#pragma unroll
              for (int e = 0; e < 8; ++e) x[i][e] = (f16)0.f; } }
      f16* __restrict__ dstq = (cg < 64 ? (f16*)(ws + WS_MLQ) : (f16*)(ws + WS_MLK)) + 8 * (cg & 63);
      const float osc = cg < 64 ? 1.0f : 0.08838834764831845f; const int hrow = (cg & 63) >> 4;
      f16x8 kwa[8], kwb[8];
#pragma unroll
      for (int s = 0; s < 16; ++s) { f16x8 o; const float wfs = wf[hrow * 64 + sb + s];
#pragma unroll
          for (int e = 0; e < 8; ++e) { const float u = w[0][e >> 2][e & 3] * (float)x[s][e] + w[1][e >> 2][e & 3] * (float)x[s + 1][e] + w[2][e >> 2][e & 3] * (float)x[s + 2][e] + w[3][e >> 2][e & 3] * (float)x[s + 3][e];
              const float y = siluf_(u) * osc; o[e] = (f16)y; if (s < 8) kwa[e][s] = (f16)(y * wfs); else kwb[e][s - 8] = (f16)(y * wfs); }
          *(f16x8*)(dstq + (tok0 + sb + s) * 512) = o; }
      if (cg >= 64) {
#pragma unroll
          for (int e = 0; e < 8; ++e) { LAS unsigned char* rp = lds + (8 * (cg - 64) + e) * RST + sb * 2; *(LAS f16x8*)rp = kwa[e]; *(LAS f16x8*)(rp + 16) = kwb[e]; } } }
    __syncthreads();
    BSTAMP(25);
    { const int et = wave & 3, dt0 = (wave >> 2) * 2, ln = lane & 31, hh = lane >> 5;
      const f16* MVT = (const f16*)(ws + WS_MLVT); f16* DCT = (f16*)(ws + WS_DCT);
      f16x8 vfr[4][4];
#pragma unroll
      for (int h = 0; h < 4; ++h)
#pragma unroll
        for (int ks = 0; ks < 4; ++ks) vfr[h][ks] = *(const f16x8*)(MVT + ((size_t)(b * 512 + h * 128 + 32 * et + ln)) * SEQ + s0 + 8 * hh + 16 * ks);
      PIN8(&vfr[0][0]); PIN8(&vfr[2][0]);
#pragma unroll
      for (int h = 0; h < 4; ++h) {
        f32x16 acc0, acc1;
#pragma unroll
        for (int r = 0; r < 16; ++r) { acc0[r] = 0.f; acc1[r] = 0.f; }
#pragma unroll
        for (int ks = 0; ks < 4; ++ks) { const f16x8 af = vfr[h][ks];
            const f16x8 b0 = *(const LAS f16x8*)(lds + (h * 128 + 32 * dt0 + ln) * RST + (16 * ks + 8 * hh) * 2);
            const f16x8 b1 = *(const LAS f16x8*)(lds + (h * 128 + 32 * (dt0 + 1) + ln) * RST + (16 * ks + 8 * hh) * 2);
            acc0 = __builtin_amdgcn_mfma_f32_32x32x16_f16(b0, af, acc0, 0, 0, 0); acc1 = __builtin_amdgcn_mfma_f32_32x32x16_f16(b1, af, acc1, 0, 0, 0); }
        f16* dst = DCT + ((size_t)(b * 4 + h) * 64 + ck) * 16384 + (size_t)(et * 8 * 64 + ln) * 8 + 4 * hh; asm volatile("" : "+v"(dst));
#pragma unroll
        for (int aa = 0; aa < 4; ++aa) { f16x4 o0, o1;
#pragma unroll
            for (int c = 0; c < 4; ++c) { o0[c] = (f16)acc0[4 * aa + c]; o1[c] = (f16)acc1[4 * aa + c]; }
            *(f16x4*)(dst + ((2 * dt0 + (aa >> 1)) * 64 + (aa & 1) * 32) * 8) = o0; *(f16x4*)(dst + ((2 * (dt0 + 1) + (aa >> 1)) * 64 + (aa & 1) * 32) * 8) = o1; }
      }
      { float sn = 0.f;
#pragma unroll
        for (int i = 0; i < 8; ++i) { const f16x8 v = *(const LAS f16x8*)(lds + tid * RST + i * 16);
#pragma unroll
            for (int j = 0; j < 8; ++j) sn += (float)v[j]; }
        ((float*)(ws + WS_DN))[((size_t)(b * 4 + (tid >> 7)) * 64 + ck) * 128 + (tid & 127)] = sn; } }
    __syncthreads();
}

__device__ __forceinline__ void mlstm_scan(const Args& a, LAS unsigned char* lds) {
    int tid = TIDX(a.wv); asm volatile("" : "+v"(tid));
    unsigned char* ws = a.ws; LAUNDER_S(ws);
    LAS float* tabA = (LAS float*)lds; LAS float* tabC = tabA + 64; LAS float* tabB = tabA + 128; LAS float* tabM = tabA + 192;
    for (int v = blockIdx.x; v < 256; v += gridDim.x) {
        const int bh = v >> 4, part = v & 15;
        float* chs = (float*)(ws + WS_CHS) + (size_t)bh * 64 * 4;
        if (tid < 64) { const f32x4 c = *(const f32x4*)(chs + tid * 4); tabB[tid] = c[0]; tabM[tid] = c[1]; }
        __syncthreads();
        if (tid == 0) { float m = 0.f;
            for (int k = 0; k < 64; ++k) { const float bl = tabB[k], ml = tabM[k]; const float mn = fmaxf(bl + m, ml);
                tabA[k] = __expf(bl + m - mn); tabC[k] = __expf(ml - mn); tabB[k] = m; m = mn; } }
        __syncthreads();
        if (part == 0 && tid < 64) chs[tid * 4 + 2] = tabB[tid];
        f16x2* p = (f16x2*)((f16*)(ws + WS_DCT) + (size_t)bh * 64 * 16384 + part * 1024 + tid * 2);
        float c0 = 0.f, c1 = 0.f;
        for (int k0 = 0; k0 < 64; k0 += 32) { f16x2 d[32];
#pragma unroll
            for (int j = 0; j < 32; ++j) d[j] = p[(size_t)(k0 + j) * 8192];
#pragma unroll
            for (int j = 0; j < 32; ++j) { f16x2 o; o[0] = (f16)c0; o[1] = (f16)c1; p[(size_t)(k0 + j) * 8192] = o;
                const float aa = tabA[k0 + j], cc = tabC[k0 + j]; c0 = aa * c0 + cc * (float)d[j][0]; c1 = aa * c1 + cc * (float)d[j][1]; } }
        if (part == 0 && tid < 128) { float* pn = (float*)(ws + WS_DN) + (size_t)bh * 64 * 128 + tid; float n = 0.f;
            for (int k0 = 0; k0 < 64; k0 += 32) { float d[32];
#pragma unroll
                for (int j = 0; j < 32; ++j) d[j] = pn[(k0 + j) * 128];
#pragma unroll
                for (int j = 0; j < 32; ++j) { pn[(k0 + j) * 128] = n; n = tabA[k0 + j] * n + tabC[k0 + j] * d[j]; } } }
        __syncthreads();
    }
}

__device__ __forceinline__ void mlstm_out_unit(const Args& a, LAS unsigned char* wlds  , LAS unsigned char* tb  , int l, int b, int ck, int h, int th, int lane_in) {
    int lane = lane_in; asm volatile("" : "+v"(lane));
    unsigned char* ws = a.ws; LAUNDER_S(ws);
    const int ln = lane & 31, hh = lane >> 5, s0 = ck * 64; const size_t tok0 = (size_t)b * SEQ + s0;
    const int bh = b * 4 + h;
    const f16* __restrict__ MLQ = (const f16*)(ws + WS_MLQ); const f16* __restrict__ MLK = (const f16*)(ws + WS_MLK);
    const f16* __restrict__ MVT = (const f16*)(ws + WS_MLVT) + ((size_t)(b * 512 + h * 128)) * SEQ + s0;
    const f16* __restrict__ CT = (const f16*)(ws + WS_DCT) + ((size_t)bh * 64 + ck) * 16384;
    const float* __restrict__ NS = (const float*)(ws + WS_DN) + ((size_t)bh * 64 + ck) * 128;
    const float mk = ((const float*)(ws + WS_CHS))[((size_t)bh * 64 + ck) * 4 + 2];
    LAS float* gtab = (LAS float*)wlds;
    LAS float* ntab = gtab + 64;
    const f32x2 bg = *(const f32x2*)((const float*)(ws + WS_GATE) + ((tok0 + lane) * 4 + h) * 2);
    const float ns0 = NS[lane], ns1 = NS[64 + lane];
    const int tl = 32 * th + ln;
#define ML5_LDC(dst, et) do { _Pragma("unroll") for (int ks = 0; ks < 8; ++ks) dst[ks] = *(const f16x8*)(CT + (size_t)((((et) * 8 + ks) * 64 + lane) * 8)); } while (0)
#define ML5_SB __builtin_amdgcn_sched_barrier(0)
    f16x8 qf[8];
#pragma unroll
    for (int ks = 0; ks < 8; ++ks) qf[ks] = *(const f16x8*)(MLQ + (tok0 + tl) * 512 + h * 128 + 16 * ks + 8 * hh);
    ML5_SB;
    float pmx = bg[1];
#pragma unroll
    for (int o = 1; o < 64; o <<= 1) { const float u = shu(pmx, o, lane); if (lane >= o) pmx = fmaxf(pmx, u); }
    gtab[lane] = bg[1]; ntab[lane] = ns0; ntab[64 + lane] = ns1;
    const float bt = shi(bg[0], tl), Mt = fmaxf(shi(pmx, tl), mk);
    const float w_inter = __expf(mk - Mt), m_row = bt + Mt;
    float qn = 0.f;
    PIN8(qf);
#pragma unroll
    for (int ks = 0; ks < 8; ++ks) {
#pragma unroll
        for (int j = 0; j < 8; ++j) qn += (float)qf[ks][j] * ntab[16 * ks + 8 * hh + j]; }
    qn += shx(qn, 32, lane);
    f32x16 acc[4];
#pragma unroll
    for (int et = 0; et < 4; ++et)
#pragma unroll
        for (int r = 0; r < 16; ++r) acc[et][r] = 0.f;
#pragma unroll
    for (int et = 0; et < 4; ++et) { f16x8 cfa[8];
        ML5_LDC(cfa, et);
        PIN8(cfa);
#pragma unroll
        for (int ks = 0; ks < 8; ++ks) acc[et] = __builtin_amdgcn_mfma_f32_32x32x16_f16(cfa[ks], qf[ks], acc[et], 0, 0, 0); }
#pragma unroll
    for (int et = 0; et < 4; ++et)
#pragma unroll
        for (int r = 0; r < 16; ++r) acc[et][r] *= w_inter;
    float den = 0.f;
    for (int st = 0; st <= th; ++st) {
        f32x16 z;
#pragma unroll
        for (int r = 0; r < 16; ++r) z[r] = 0.f;
        { f16x8 kfa[8];
#pragma unroll
          for (int ks = 0; ks < 8; ++ks) kfa[ks] = *(const f16x8*)(MLK + (tok0 + 32 * st + ln) * 512 + h * 128 + 16 * ks + 8 * hh);
          PIN8(kfa);
#pragma unroll
          for (int ks = 0; ks < 8; ++ks) z = __builtin_amdgcn_mfma_f32_32x32x16_f16(kfa[ks], qf[ks], z, 0, 0, 0); }
        f16x8 bf0, bf1;
#pragma unroll
        for (int aa = 0; aa < 4; ++aa) { const f32x4 gv = *(const LAS f32x4*)(gtab + 32 * st + 8 * aa + 4 * hh);
#pragma unroll
            for (int c = 0; c < 4; ++c) { const int s = 32 * st + 8 * aa + 4 * hh + c; const float w = s <= tl ? __expf(gv[c] - Mt) : 0.f; const float sw = z[4 * aa + c] * w; den += sw;
                if (aa < 2) bf0[4 * aa + c] = (f16)sw; else bf1[4 * (aa - 2) + c] = (f16)sw; } }
        { f16x8 va[8];
#pragma unroll
          for (int et = 0; et < 4; ++et) { const f16* vp = MVT + (size_t)(32 * et + ln) * SEQ + 32 * st + 4 * hh;
            { const f16x4 lo = *(const f16x4*)(vp), hi = *(const f16x4*)(vp + 8); va[2 * et] = __builtin_shufflevector(lo, hi, 0, 1, 2, 3, 4, 5, 6, 7); }
            { const f16x4 lo = *(const f16x4*)(vp + 16), hi = *(const f16x4*)(vp + 24); va[2 * et + 1] = __builtin_shufflevector(lo, hi, 0, 1, 2, 3, 4, 5, 6, 7); } }
          PIN8(va);
#pragma unroll
          for (int et = 0; et < 4; ++et) { acc[et] = __builtin_amdgcn_mfma_f32_32x32x16_f16(va[2 * et], bf0, acc[et], 0, 0, 0); acc[et] = __builtin_amdgcn_mfma_f32_32x32x16_f16(va[2 * et + 1], bf1, acc[et], 0, 0, 0); } }
    }
    const f16* __restrict__ P16 = (const f16*)(ws + WS_P16); f16* Y3 = (f16*)(ws + WS_Y3);
    constexpr int TBS = 272;
    const int er = lane >> 4, ec = lane & 15;
    const f16* orow = P16 + (tok0 + 32 * th + er) * NA + h * 128 + 8 * ec;
    f16x8 ogv[8], zgv[8];
    ML5_SB;
#pragma unroll
    for (int i = 0; i < 8; ++i) { ogv[i] = *(const f16x8*)(orow + (size_t)(4 * i) * NA + C_MO); zgv[i] = *(const f16x8*)(orow + (size_t)(4 * i) * NA + C_MZ); }
    ML5_SB;
    den += shx(den, 32, lane);
    den += w_inter * qn;
    const float inv = 1.0f / fmaxf(fabsf(den), __expf(-m_row));
    float sm = 0.f;
#pragma unroll
    for (int et = 0; et < 4; ++et)
#pragma unroll
        for (int r = 0; r < 16; ++r) { acc[et][r] *= inv; sm += acc[et][r]; }
    sm += shx(sm, 32, lane);
    const float mu = sm * (1.0f / 128.0f); float vs = 0.f;
#pragma unroll
    for (int et = 0; et < 4; ++et)
#pragma unroll
        for (int r = 0; r < 16; ++r) { const float d = acc[et][r] - mu; vs += d * d; }
    vs += shx(vs, 32, lane);
    const float rstd = 1.0f / sqrtf(vs * (1.0f / 128.0f) + NORM_EPS);
    PIN8(ogv); PIN8(zgv);
#pragma unroll
    for (int i = 0; i < 8; ++i) { f16x8 g;
#pragma unroll
        for (int j = 0; j < 8; ++j) g[j] = (f16)(sigmoidf_((float)ogv[i][j]) * siluf_((float)zgv[i][j]));
        *(LAS f16x8*)(tb + (4 * i + er) * TBS + ec * 16) = g; }
    const float* __restrict__ nwp = a.mln_w + l * 512 + h * 128 + 4 * hh;
#pragma unroll
    for (int et = 0; et < 4; ++et)
#pragma unroll
        for (int aa = 0; aa < 4; ++aa) { LAS f16x4* gp = (LAS f16x4*)(tb + ln * TBS + (32 * et + 8 * aa + 4 * hh) * 2); const f16x4 gq = *gp; const f32x4 nw = *(const f32x4*)(nwp + 32 * et + 8 * aa);
            f16x4 y;
#pragma unroll
            for (int c = 0; c < 4; ++c) y[c] = (f16)((acc[et][4 * aa + c] - mu) * rstd * nw[c] * (float)gq[c]);
            *gp = y; }
    f16* yrow = Y3 + (tok0 + 32 * th + er) * 1536 + 1024 + h * 128 + 8 * ec;
#pragma unroll
    for (int i = 0; i < 8; ++i) { const f16x8 v = *(const LAS f16x8*)(tb + (4 * i + er) * TBS + ec * 16); *(f16x8*)(yrow + (size_t)(4 * i) * 1536) = v; }
#undef ML5_LDC
#undef ML5_SB
}

constexpr int DL_HIST = 0;
constexpr int DL_RS = 304;
constexpr int DL_STAGE_W = 32 * DL_RS;
constexpr int DL_SELB = 8 * DL_STAGE_W;
constexpr int DL_EQB  = DL_SELB + 8192;
constexpr int DL_LIST = DL_EQB + 8192;
constexpr int DL_QST  = DL_LIST + 8192;
constexpr int DL_OL   = DL_QST + 1024;
constexpr int DL_END  = DL_OL + 32768;
static_assert(DL_END <= LDS_BYTES - 16, "DSA LDS map");


__device__ __forceinline__ unsigned okey(unsigned bits) { const unsigned m = (unsigned)((int)bits >> 31) | 0x80000000u; return bits == 0xFF800000u ? 0u : (bits ^ m); }
__device__ __forceinline__ unsigned fdig(unsigned bits) { const f16 hf = (f16)__uint_as_float(bits); const unsigned h = (unsigned)__builtin_bit_cast(unsigned short, hf);
    const unsigned m = (unsigned)((int)(h << 16) >> 31) | 0x8000u; return ((h ^ m) & 0xFFFFu) >> 5; }
#ifdef TIMING
#define DSTAMP(k) do { if (blockIdx.x == 0 && TIDX(a.wv) == 0) { LAS unsigned long long* ts_ = (LAS unsigned long long*)(lds + LDS_BYTES - 512); const unsigned long long t_ = wall_clock64(); ts_[k] += t_ - ts_[16]; ts_[16] = t_; } } while (0)
#else
#define DSTAMP(k) do {} while (0)
#endif
__device__ __forceinline__ void dsa_unit(const Args& a, LAS unsigned char* lds, int l, int b, int j) {
    int tid = TIDX(a.wv); asm volatile("" : "+v"(tid));
    const int wave = __builtin_amdgcn_readfirstlane(tid >> 6), lane = tid & 63, fr = lane & 15, fq = lane >> 4;
    unsigned char* ws = a.ws; LAUNDER_S(ws);
    const int t0 = 16 * j; const size_t tokb = (size_t)b * SEQ;
    const f16* __restrict__ IQ = (const f16*)(ws + WS_IQ); const f16* __restrict__ IK = (const f16*)(ws + WS_IK); const float* __restrict__ IW = (const float*)(ws + WS_IW);
    LAS unsigned* hist = (LAS unsigned*)(lds + DL_HIST); LAS unsigned* selb = (LAS unsigned*)(lds + DL_SELB); LAS unsigned* eqb = (LAS unsigned*)(lds + DL_EQB);
    LAS unsigned short* list = (LAS unsigned short*)(lds + DL_LIST); LAS unsigned* qst = (LAS unsigned*)(lds + DL_QST); LAS unsigned* nselp = qst + 64;

    if (tid < 16) { const int t = t0 + tid; const unsigned need = (unsigned)(t + 1 < 256 ? t + 1 : 256); qst[tid * 4 + 0] = 0u; qst[tid * 4 + 1] = 0u; qst[tid * 4 + 2] = need; qst[tid * 4 + 3] = 0u; nselp[tid] = need; }
    for (int i = tid; i < 4096; i += NTHREADS) selb[i] = 0u;

    u32x4 sk[32];
    {
        f16x8 iqf[4][2]; float iw[4];
#pragma unroll
        for (int h = 0; h < 4; ++h) { iw[h] = IW[(tokb + t0 + fr) * 4 + h];
#pragma unroll
            for (int ks = 0; ks < 2; ++ks) iqf[h][ks] = *(const f16x8*)(IQ + (tokb + t0 + fr) * 256 + h * 64 + 32 * ks + 8 * fq); }
        const int ntm0 = (j >= wave ? ((j - wave) >> 3) + 1 : 0) + (int)opaque0();
        const f16* kbase = IK + (tokb + 16 * wave + fr) * 64 + 8 * fq;
#pragma unroll
        for (int g8 = 0; g8 < 4; ++g8) {
            if (8 * g8 < ntm0) {
                f16x8 ka[8][2];
#pragma unroll
                for (int ii = 0; ii < 8; ++ii) { const f16* kp = kbase + (size_t)(8 * g8 + ii) * 128 * 64; ka[ii][0] = *(const f16x8*)kp; ka[ii][1] = *(const f16x8*)(kp + 32); }
#pragma unroll
                for (int ii = 0; ii < 8; ++ii) { const int i = 8 * g8 + ii, kt = wave + 8 * i;
                    f32x4 sc = (f32x4){0.f, 0.f, 0.f, 0.f};
#pragma unroll
                    for (int h = 0; h < 4; ++h) { f32x4 c = (f32x4){0.f, 0.f, 0.f, 0.f};
                        c = __builtin_amdgcn_mfma_f32_16x16x32_f16(ka[ii][0], iqf[h][0], c, 0, 0, 0); c = __builtin_amdgcn_mfma_f32_16x16x32_f16(ka[ii][1], iqf[h][1], c, 0, 0, 0);
#pragma unroll
                        for (int r = 0; r < 4; ++r) { const float cf = c[r]; const int cb = __float_as_int(cf); const float rl = __int_as_float(cb > 0 ? cb : 0); sc[r] += iw[h] * rl; } }
#pragma unroll
                    for (int r = 0; r < 4; ++r) { const int kidx = 16 * kt + 4 * fq + r; const float s = sc[r] + 0.0f;
                        sk[i][r] = kidx <= t0 + fr ? __float_as_uint(s) : 0xFF800000u; } }
            } else {
#pragma unroll
                for (int ii = 0; ii < 8; ++ii) sk[8 * g8 + ii] = (u32x4){0xFF800000u, 0xFF800000u, 0xFF800000u, 0xFF800000u};
            }
        }
    }
    DSTAMP(12);
    LAS unsigned* fst = qst + 96;
    LAS unsigned* cst = qst + 160;
    LAS u32x2* cand = (LAS u32x2*)(lds + DL_HIST);
    const int ntm = (j >= wave ? ((j - wave) >> 3) + 1 : 0);
    { unsigned zz = 0u; asm volatile("" : "+v"(zz));
#pragma unroll
      for (int i = 0; i < 8; ++i) *(LAS u32x4*)(lds + DL_HIST + (tid + NTHREADS * i) * 16) = (u32x4){zz, zz, zz, zz}; }
    if (tid < 17) cst[tid] = 0u;
    __syncthreads();
    { unsigned oz = 0u; asm volatile("" : "+v"(oz)); const int ntm_ = ntm + (int)opaque0();
#pragma unroll
      for (int i = 0; i < 32; ++i) { if (i < ntm_) {
#pragma unroll
          for (int r = 0; r < 4; ++r) { const unsigned d = fdig(sk[i][r] ^ oz);
              __hip_atomic_fetch_add(hist + fr * 1024 + (d >> 1), (d & 1u) ? 65536u : 1u, __ATOMIC_RELAXED, __HIP_MEMORY_SCOPE_WORKGROUP); } } } }
    __syncthreads();
    DSTAMP(20);
    {
        const int base = 2048 - (lane + 1) * 32;
        unsigned need[2], cw[2][16], sum[2], incl[2];
#pragma unroll
        for (int qq = 0; qq < 2; ++qq) { const int q = 2 * wave + qq; need[qq] = qst[q * 4 + 2]; sum[qq] = 0u;
#pragma unroll
            for (int i = 0; i < 16; ++i) cw[qq][i] = hist[q * 1024 + (base >> 1) + i]; }
#pragma unroll
        for (int qq = 0; qq < 2; ++qq) {
#pragma unroll
            for (int i = 0; i < 16; ++i) sum[qq] += (cw[qq][i] & 0xFFFFu) + (cw[qq][i] >> 16);
            incl[qq] = sum[qq]; }
#pragma unroll
        for (int o = 1; o < 64; o <<= 1) { const unsigned u0 = shu(incl[0], o, lane), u1 = shu(incl[1], o, lane); if (lane >= o) { incl[0] += u0; incl[1] += u1; } }
        unsigned dstar[2], above[2], ceq[2]; bool found[2]; int Lc[2];
#pragma unroll
        for (int qq = 0; qq < 2; ++qq) { const unsigned long long bal = __ballot(incl[qq] >= need[qq]); Lc[qq] = bal ? (int)__builtin_ctzll(bal) : 63;
            dstar[qq] = 0u; above[qq] = incl[qq] - sum[qq]; ceq[qq] = 0u; found[qq] = false; }
#pragma unroll
        for (int i = 15; i >= 0; --i) {
#pragma unroll
            for (int hf = 1; hf >= 0; --hf) {
#pragma unroll
                for (int qq = 0; qq < 2; ++qq) { const unsigned c = hf ? (cw[qq][i] >> 16) : (cw[qq][i] & 0xFFFFu);
                    if (!found[qq]) { if (above[qq] + c >= need[qq]) { found[qq] = true; dstar[qq] = (unsigned)(base + 2 * i + hf); ceq[qq] = c; } else above[qq] += c; } } } }
#pragma unroll
        for (int qq = 0; qq < 2; ++qq) { const int q = 2 * wave + qq;
            const unsigned ds_ = shi(dstar[qq], Lc[qq]), ab_ = shi(above[qq], Lc[qq]), ce_ = shi(ceq[qq], Lc[qq]);
            if (lane == 0) { const unsigned nn = need[qq] - ab_; fst[q * 4 + 0] = ds_; fst[q * 4 + 1] = nn; fst[q * 4 + 2] = (ce_ == nn) ? 1u : 0u; } }
    }
    __syncthreads();
    DSTAMP(21);
    { const unsigned ds = fst[fr * 4 + 0], ta = fst[fr * 4 + 2];
      unsigned oz = 0u; asm volatile("" : "+v"(oz)); const int ntm_ = ntm + (int)opaque0();
#pragma unroll
      for (int i = 0; i < 32; ++i) { if (i < ntm_) {
          unsigned nsel = 0u, ncand = 0u;
#pragma unroll
          for (int r = 0; r < 4; ++r) { const unsigned d = fdig(sk[i][r] ^ oz); const bool gt = d > ds, eq = d == ds;
              nsel |= ((gt || (eq && ta)) ? 1u : 0u) << r; ncand |= ((eq && !ta) ? 1u : 0u) << r; }
          const unsigned kb = (unsigned)(16 * (wave + 8 * i) + 4 * fq);
          if (nsel) __hip_atomic_fetch_or(selb + fr * 128 + (kb >> 5), nsel << (kb & 31u), __ATOMIC_RELAXED, __HIP_MEMORY_SCOPE_WORKGROUP);
          if (ncand) {
#pragma unroll
              for (int r = 0; r < 4; ++r) { if ((ncand >> r) & 1u) { const unsigned slot = __hip_atomic_fetch_add(cst + fr, 1u, __ATOMIC_RELAXED, __HIP_MEMORY_SCOPE_WORKGROUP);
                  if (slot < 256u) { u32x2 e; e.x = okey(sk[i][r] ^ oz); e.y = kb + r; cand[fr * 256 + slot] = e; } else cst[16] = 1u; } } } } } }
    __syncthreads();
    DSTAMP(22);
    if (cst[16] == 0u) {
        for (int qq = 0; qq < 2; ++qq) { const int q = 2 * wave + qq; const unsigned n = cst[q], want = fst[q * 4 + 1];
            if (fst[q * 4 + 2] == 0u && n > 0u) {
                unsigned long long cmine[4]; unsigned rk[4];
#pragma unroll
                for (int c = 0; c < 4; ++c) { const unsigned ci = (unsigned)(lane + 64 * c); const u32x2 e = cand[q * 256 + (ci < n ? ci : 0u)];
                    cmine[c] = ci < n ? (((unsigned long long)e.x << 16) | (unsigned long long)(0xFFFFu - e.y)) : 0ull; rk[c] = 0u; }
#pragma unroll
                for (int cb = 0; cb < 4; ++cb) { const int nb_ = (int)n - 64 * cb < 64 ? (int)n - 64 * cb : 64;
                    for (int jx = 0; jx < nb_; ++jx) {
                        const unsigned lo = (unsigned)__builtin_amdgcn_readlane((int)(unsigned)cmine[cb], jx), hi = (unsigned)__builtin_amdgcn_readlane((int)(unsigned)(cmine[cb] >> 32), jx);
                        const unsigned long long cj = ((unsigned long long)hi << 32) | lo;
#pragma unroll
                        for (int c = 0; c < 4; ++c) rk[c] += cj > cmine[c] ? 1u : 0u; } }
#pragma unroll
                for (int c = 0; c < 4; ++c) { const unsigned ci = (unsigned)(lane + 64 * c);
                    if (ci < n && rk[c] < want) { const unsigned kidx = 0xFFFFu - (unsigned)(cmine[c] & 0xFFFFull);
                        __hip_atomic_fetch_or(selb + q * 128 + (kidx >> 5), 1u << (kidx & 31u), __ATOMIC_RELAXED, __HIP_MEMORY_SCOPE_WORKGROUP); } }
            }
            if (lane == 0) qst[q * 4 + 3] = 1u;
        }
    } else {
        for (int i = tid; i < 4096; i += NTHREADS) selb[i] = 0u;
        __syncthreads();
        for (int lvl = 0; lvl < 3; ++lvl) {
            const int shift = lvl == 0 ? 21 : (lvl == 1 ? 10 : 0); const unsigned dmask = lvl == 2 ? 0x3FFu : 0x7FFu; const int nbins = lvl == 2 ? 1024 : 2048;
            { u32x4* hz = (u32x4*)0; (void)hz;
#pragma unroll
              for (int i = 0; i < 8; ++i) { unsigned zz = 0u; asm volatile("" : "+v"(zz)); *(LAS u32x4*)(lds + DL_HIST + (tid + NTHREADS * i) * 16) = (u32x4){zz, zz, zz, zz}; } }
            __syncthreads();
            { const unsigned mask = qst[fr * 4 + 0], val = qst[fr * 4 + 1], done = qst[fr * 4 + 3];
              unsigned oz = 0u; asm volatile("" : "+v"(oz));
              const int ntm = (j >= wave ? ((j - wave) >> 3) + 1 : 0) + (int)opaque0();
              if (!done) {
#pragma unroll
                for (int i = 0; i < 32; ++i) { if (i < ntm) {
#pragma unroll
                    for (int r = 0; r < 4; ++r) { const unsigned uk = okey(sk[i][r] ^ oz);
                        if (uk != 0u && (uk & mask) == val) { const unsigned d = (uk >> shift) & dmask;
                            __hip_atomic_fetch_add(hist + fr * 1024 + (d >> 1), (d & 1u) ? 65536u : 1u, __ATOMIC_RELAXED, __HIP_MEMORY_SCOPE_WORKGROUP); } } } }
              } }
            __syncthreads();
            for (int qq = 0; qq < 2; ++qq) { const int q = 2 * wave + qq;
                const unsigned mask = qst[q * 4 + 0], val = qst[q * 4 + 1], need = qst[q * 4 + 2], done = qst[q * 4 + 3];
                if (done) continue;
                const int nb = nbins >> 6, base = nbins - (lane + 1) * nb;
                unsigned cw[16]; unsigned s = 0;
#pragma unroll
                for (int i = 0; i < 16; ++i) { cw[i] = (i < (nb >> 1)) ? hist[q * 1024 + (base >> 1) + i] : 0u; s += (cw[i] & 0xFFFFu) + (cw[i] >> 16); }
                unsigned incl = s;
#pragma unroll
                for (int o = 1; o < 64; o <<= 1) { const unsigned u = shu(incl, o, lane); if (lane >= o) incl += u; }
                const unsigned long long bal = __ballot(incl >= need);
                const int Lc = bal ? (int)__builtin_ctzll(bal) : 63;
                unsigned dstar = 0, above = incl - s, ceq = 0; bool found = false;
#pragma unroll
                for (int i = 15; i >= 0; --i) {
#pragma unroll
                    for (int hf = 1; hf >= 0; --hf) { const unsigned c = hf ? (cw[i] >> 16) : (cw[i] & 0xFFFFu);
                        if (i < (nb >> 1) && !found) { if (above + c >= need) { found = true; dstar = (unsigned)(base + 2 * i + hf); ceq = c; } else above += c; } } }
                dstar = shi(dstar, Lc); above = shi(above, Lc); ceq = shi(ceq, Lc);
                if (lane == 0) { const unsigned nn = need - above;
                    qst[q * 4 + 0] = mask | (dmask << shift); qst[q * 4 + 1] = val | (dstar << shift); qst[q * 4 + 2] = nn; qst[q * 4 + 3] = (ceq == nn) ? 1u : 0u; }
            }
            __syncthreads();
        }
        { const unsigned mask = qst[fr * 4 + 0], val = qst[fr * 4 + 1], done = qst[fr * 4 + 3];
          unsigned oz = 0u; asm volatile("" : "+v"(oz));
          const int ntm = (j >= wave ? ((j - wave) >> 3) + 1 : 0) + (int)opaque0();
#pragma unroll
          for (int i = 0; i < 32; ++i) { if (i < ntm) {
#pragma unroll
              for (int r = 0; r < 4; ++r) { const unsigned uk = okey(sk[i][r] ^ oz); const unsigned kidx = (unsigned)(16 * (wave + 8 * i) + 4 * fq + r);
                  if (uk != 0u) { const unsigned hb = uk & mask;
                      if (hb > val || (hb == val && done)) __hip_atomic_fetch_or(selb + fr * 128 + (kidx >> 5), 1u << (kidx & 31u), __ATOMIC_RELAXED, __HIP_MEMORY_SCOPE_WORKGROUP);
                      else if (hb == val) __hip_atomic_fetch_or(eqb + fr * 128 + (kidx >> 5), 1u << (kidx & 31u), __ATOMIC_RELAXED, __HIP_MEMORY_SCOPE_WORKGROUP); } } } } }
        __syncthreads();
    }
    __syncthreads();
    DSTAMP(13);
    {
        unsigned long long w[2]; unsigned pc[2], incl[2], pos[2];
#pragma unroll
        for (int qq = 0; qq < 2; ++qq) { const int q = 2 * wave + qq;
            const unsigned need = qst[q * 4 + 2], done = qst[q * 4 + 3];
            w[qq] = (unsigned long long)selb[q * 128 + 2 * lane] | ((unsigned long long)selb[q * 128 + 2 * lane + 1] << 32);
            if (!done) { unsigned long long e = (unsigned long long)eqb[q * 128 + 2 * lane] | ((unsigned long long)eqb[q * 128 + 2 * lane + 1] << 32);
                const unsigned pce = (unsigned)__builtin_popcountll(e); unsigned ie = pce;
#pragma unroll
                for (int o = 1; o < 64; o <<= 1) { const unsigned u = shu(ie, o, lane); if (lane >= o) ie += u; }
                const unsigned before = ie - pce;
                if (before >= need) e = 0ull;
                else if (ie > need) { unsigned keep = need - before; while ((unsigned)__builtin_popcountll(e) > keep) e &= ~(1ull << (63 - __builtin_clzll(e))); }
                w[qq] |= e; }
            pc[qq] = (unsigned)__builtin_popcountll(w[qq]); incl[qq] = pc[qq]; }
#pragma unroll
        for (int o = 1; o < 64; o <<= 1) { const unsigned u0 = shu(incl[0], o, lane), u1 = shu(incl[1], o, lane); if (lane >= o) { incl[0] += u0; incl[1] += u1; } }
#pragma unroll
        for (int qq = 0; qq < 2; ++qq) { const int q = 2 * wave + qq; const unsigned nsel = nselp[q]; pos[qq] = incl[qq] - pc[qq];
#pragma unroll
            for (int i = 0; i < 4; ++i) { const unsigned p = (unsigned)(lane + 64 * i); if (p >= nsel) list[q * 256 + p] = 0; } }
        while (w[0] | w[1]) {
#pragma unroll
            for (int qq = 0; qq < 2; ++qq) { if (w[qq]) { const int bit = __builtin_ctzll(w[qq]); w[qq] &= w[qq] - 1ull;
                if (pos[qq] < 256u) list[(2 * wave + qq) * 256 + pos[qq]] = (unsigned short)(64 * lane + bit); ++pos[qq]; } } }
    }
    __syncthreads();

    DSTAMP(14);
    const f16* __restrict__ KV = (const f16*)(ws + WS_KV); const f16* __restrict__ QC = (const f16*)(ws + WS_QC);
    LAS unsigned char* stg = lds + DL_HIST + wave * DL_STAGE_W;
    const unsigned tr_addr = (unsigned)(uintptr_t)stg + (unsigned)((4 * fq + ((lane & 15) >> 2)) * DL_RS + (lane & 3) * 8);
    int growv[9], gc16[9];
#pragma unroll
    for (int i = 0; i < 9; ++i) { const int c = lane + 64 * i; growv[i] = (c * 3641) >> 16; gc16[i] = c - 18 * growv[i]; }
    for (int qq = 0; qq < 2; ++qq) { const int q = 2 * wave + qq; const size_t tok = tokb + t0 + q; const int nsel = (int)nselp[q];
        f16x8 qc[4]; f16x4 qr;
#pragma unroll
        for (int ks = 0; ks < 4; ++ks) { if (fr < 8) qc[ks] = *(const f16x8*)(QC + (tok * 8 + fr) * 160 + 32 * ks + 8 * fq); else {
#pragma unroll
            for (int e = 0; e < 8; ++e) qc[ks][e] = (f16)0.f; } }
        if (fr < 8) qr = *(const f16x4*)(QC + (tok * 8 + fr) * 160 + 128 + 4 * fq); else { qr[0] = (f16)0.f; qr[1] = (f16)0.f; qr[2] = (f16)0.f; qr[3] = (f16)0.f; }
        f32x4 acc[8];
#pragma unroll
        for (int c = 0; c < 8; ++c) acc[c] = (f32x4){0.f, 0.f, 0.f, 0.f};
        float m_run = -INFINITY, l_run = 0.f;
        u32x4 rw[9];
#define DG_LOAD(PIDX) do { const int pn_ = (PIDX) < 8 ? (PIDX) : 7; \
            _Pragma("unroll") for (int i = 0; i < 9; ++i) { const int idx_ = list[q * 256 + 32 * pn_ + growv[i]]; rw[i] = *(const u32x4*)(KV + (tokb + idx_) * 160 + gc16[i] * 8); } } while (0)
        DG_LOAD(0);
        const int npair = (nsel + 31) >> 5;
        for (int pp = 0; pp < npair; ++pp) {
#pragma unroll
            for (int i = 0; i < 9; ++i) *(LAS u32x4*)(stg + growv[i] * DL_RS + gc16[i] * 16) = rw[i];
            DG_LOAD(pp + 1);
            f16x8 fa[4], fb[4]; f16x4 fra, frb;
#pragma unroll
            for (int ks = 0; ks < 4; ++ks) { fa[ks] = *(const LAS f16x8*)(stg + fr * DL_RS + (32 * ks + 8 * fq) * 2); fb[ks] = *(const LAS f16x8*)(stg + (16 + fr) * DL_RS + (32 * ks + 8 * fq) * 2); }
            fra = *(const LAS f16x4*)(stg + fr * DL_RS + (128 + 4 * fq) * 2); frb = *(const LAS f16x4*)(stg + (16 + fr) * DL_RS + (128 + 4 * fq) * 2);
            f32x4 c0 = (f32x4){0.f, 0.f, 0.f, 0.f}, c1 = (f32x4){0.f, 0.f, 0.f, 0.f};
#pragma unroll
            for (int ks = 0; ks < 4; ++ks) { c0 = __builtin_amdgcn_mfma_f32_16x16x32_f16(fa[ks], qc[ks], c0, 0, 0, 0); c1 = __builtin_amdgcn_mfma_f32_16x16x32_f16(fb[ks], qc[ks], c1, 0, 0, 0); }
            c0 = __builtin_amdgcn_mfma_f32_16x16x16f16(fra, qr, c0, 0, 0, 0); c1 = __builtin_amdgcn_mfma_f32_16x16x16f16(frb, qr, c1, 0, 0, 0);
            float mx = -INFINITY;
#pragma unroll
            for (int r = 0; r < 4; ++r) { if (32 * pp + 4 * fq + r >= nsel) c0[r] = -INFINITY; if (32 * pp + 16 + 4 * fq + r >= nsel) c1[r] = -INFINITY; mx = fmaxf(mx, fmaxf(c0[r], c1[r])); }
            if (__any(mx > m_run + 4.0f)) {
                mx = fmaxf(mx, shx(mx, 16, lane)); mx = fmaxf(mx, shx(mx, 32, lane));
                const float mn = fmaxf(m_run, mx); const float scale = __expf(m_run - mn); l_run *= scale; m_run = mn;
#pragma unroll
                for (int c = 0; c < 8; ++c) acc[c] *= scale; }
            f16x8 pf;
#pragma unroll
            for (int r = 0; r < 4; ++r) { const float p0 = __expf(c0[r] - m_run), p1 = __expf(c1[r] - m_run); l_run += p0 + p1; pf[r] = (f16)p0; pf[4 + r] = (f16)p1; }
            u32x2 t0_[8], t1_[8];
            asm volatile("s_waitcnt lgkmcnt(0)\n\t"
                "ds_read_b64_tr_b16 %0, %16 offset:0\n\t"    "ds_read_b64_tr_b16 %1, %16 offset:32\n\t"   "ds_read_b64_tr_b16 %2, %16 offset:64\n\t"   "ds_read_b64_tr_b16 %3, %16 offset:96\n\t"
                "ds_read_b64_tr_b16 %4, %16 offset:128\n\t"  "ds_read_b64_tr_b16 %5, %16 offset:160\n\t"  "ds_read_b64_tr_b16 %6, %16 offset:192\n\t"  "ds_read_b64_tr_b16 %7, %16 offset:224\n\t"
                "ds_read_b64_tr_b16 %8, %16 offset:4864\n\t" "ds_read_b64_tr_b16 %9, %16 offset:4896\n\t" "ds_read_b64_tr_b16 %10, %16 offset:4928\n\t" "ds_read_b64_tr_b16 %11, %16 offset:4960\n\t"
                "ds_read_b64_tr_b16 %12, %16 offset:4992\n\t" "ds_read_b64_tr_b16 %13, %16 offset:5024\n\t" "ds_read_b64_tr_b16 %14, %16 offset:5056\n\t" "ds_read_b64_tr_b16 %15, %16 offset:5088\n\t"
                "s_waitcnt lgkmcnt(0)"
                : "=&v"(t0_[0]), "=&v"(t0_[1]), "=&v"(t0_[2]), "=&v"(t0_[3]), "=&v"(t0_[4]), "=&v"(t0_[5]), "=&v"(t0_[6]), "=&v"(t0_[7]),
                  "=&v"(t1_[0]), "=&v"(t1_[1]), "=&v"(t1_[2]), "=&v"(t1_[3]), "=&v"(t1_[4]), "=&v"(t1_[5]), "=&v"(t1_[6]), "=&v"(t1_[7])
                : "v"(tr_addr) : "memory");
#pragma unroll
            for (int c = 0; c < 8; ++c) { u32x4 av; av.x = t0_[c].x; av.y = t0_[c].y; av.z = t1_[c].x; av.w = t1_[c].y;
                acc[c] = __builtin_amdgcn_mfma_f32_16x16x32_f16(__builtin_bit_cast(f16x8, av), pf, acc[c], 0, 0, 0); }
            asm volatile("s_waitcnt lgkmcnt(0)" ::: "memory");
        }
#undef DG_LOAD
        l_run += shx(l_run, 16, lane); l_run += shx(l_run, 32, lane);
        const float inv = 1.0f / l_run;
        if (fr < 8) {
#pragma unroll
            for (int c = 0; c < 8; ++c) { f16x4 o; o[0] = (f16)(acc[c][0] * inv); o[1] = (f16)(acc[c][1] * inv); o[2] = (f16)(acc[c][2] * inv); o[3] = (f16)(acc[c][3] * inv);
                *(LAS f16x4*)(lds + DL_OL + ((q * 8 + fr) * 128 + 16 * c + 4 * fq) * 2) = o; } }
    }
    __syncthreads();
    DSTAMP(15);
    { const int h = wave; const f16* __restrict__ Wv = (const f16*)(ws + WS_WUV) + ((size_t)(l * 8 + h) * 64) * 128;
      const f16* __restrict__ P16 = (const f16*)(ws + WS_P16); f16* __restrict__ Y3 = (f16*)(ws + WS_Y3);
      f16x8 af[4], bf[4][4]; f16 zg[4][4];
#pragma unroll
      for (int n = 0; n < 4; ++n)
#pragma unroll
          for (int ks = 0; ks < 4; ++ks) bf[n][ks] = *(const f16x8*)(Wv + (size_t)(16 * n + fr) * 128 + 32 * ks + 8 * fq);
#pragma unroll
      for (int n = 0; n < 4; ++n)
#pragma unroll
          for (int r = 0; r < 4; ++r) zg[n][r] = P16[(tokb + t0 + 4 * fq + r) * NA + C_DZ + h * 64 + 16 * n + fr];
#pragma unroll
      for (int ks = 0; ks < 4; ++ks) af[ks] = *(const LAS f16x8*)(lds + DL_OL + ((fr * 8 + h) * 128 + 32 * ks + 8 * fq) * 2);
#pragma unroll
      for (int n = 0; n < 4; ++n) { f32x4 c = (f32x4){0.f, 0.f, 0.f, 0.f};
#pragma unroll
          for (int ks = 0; ks < 4; ++ks) c = __builtin_amdgcn_mfma_f32_16x16x32_f16(af[ks], bf[n][ks], c, 0, 0, 0);
#pragma unroll
          for (int r = 0; r < 4; ++r) Y3[(tokb + t0 + 4 * fq + r) * 1536 + h * 64 + 16 * n + fr] = (f16)(c[r] * siluf_((float)zg[n][r])); } }
    __syncthreads();
}

__device__ __forceinline__ void transpose_slab(LAS unsigned char* lds, const f16* __restrict__ P16, int coff, int b, int s0, f16* __restrict__ dstT, int wv) {
    constexpr int RS = 1040;
    int tid = TIDX(wv); asm volatile("" : "+v"(tid));
#pragma unroll
    for (int i = 0; i < 8; ++i) { const int id = tid + 512 * i, row = id >> 6, cc = id & 63;
        *(LAS u32x4*)(lds + row * RS + cc * 16) = *(const u32x4*)(P16 + (size_t)(b * SEQ + s0 + row) * NA + coff + cc * 8); }
    __syncthreads();
    f16* d = dstT + ((size_t)(b * 512 + tid)) * SEQ + s0;
#pragma unroll
    for (int i = 0; i < 8; ++i) { f16x8 v;
#pragma unroll
        for (int j = 0; j < 8; ++j) v[j] = *(const LAS f16*)(lds + (i * 8 + j) * RS + tid * 2);
        *(f16x8*)(d + i * 8) = v; }
    __syncthreads();
}

__device__ __forceinline__ void final_norm(const Args& a) {
    const int G = gridDim.x, bid = blockIdx.x; int tid = TIDX(a.wv); asm volatile("" : "+v"(tid)); const int wave = tid >> 6, lane = tid & 63;
    unsigned char* ws = a.ws; LAUNDER_S(ws);
    const f16* X = (const f16*)(ws + WS_X16); const float* ss = (const float*)(ws + WS_SS);
    for (int row = bid * 8 + wave; row < MTOK; row += G * 8) {
        const float rs = pg8::row_rstd(ss, row);
#pragma unroll
        for (int i = 0; i < 2; ++i) { const int c = i * 512 + lane * 8; const f16x8 v = *(const f16x8*)(X + (size_t)row * DM + c); const f32x4 w0 = *(const f32x4*)(a.fnorm_w + c), w1 = *(const f32x4*)(a.fnorm_w + c + 4);
            f32x4 o0, o1;
#pragma unroll
            for (int j = 0; j < 4; ++j) { o0[j] = (float)v[j] * rs * w0[j]; o1[j] = (float)v[4 + j] * rs * w1[j]; }
            *(f32x4*)(a.out + (size_t)row * DM + c) = o0; *(f32x4*)(a.out + (size_t)row * DM + c + 4) = o1; }
    }
}

__device__ __forceinline__ void zero_y3(const Args& a) {
    unsigned char* ws = a.ws; LAUNDER_S(ws);
    u32x4* p = (u32x4*)(ws + WS_Y3); const size_t n = (size_t)MTOK * 1536 * 2 / 16;
    for (size_t i = (size_t)blockIdx.x * NTHREADS + threadIdx.x; i < n; i += (size_t)gridDim.x * NTHREADS) p[i] = (u32x4){0u, 0u, 0u, 0u};
}

#ifndef PH_P0
#define PH_P0 1
#endif
#ifndef PH_A
#define PH_A 1
#endif
#ifndef PH_B
#define PH_B 1
#endif
#ifndef PH_C
#define PH_C 1
#endif
#ifndef PH_A2
#define PH_A2 1
#endif
#ifndef PH_D
#define PH_D 1
#endif
#ifndef PH_E
#define PH_E 1
#endif
__global__ void __launch_bounds__(NTHREADS, 2) fwd(Args a_in) {
    Args a = a_in; a.wv = __builtin_amdgcn_readfirstlane((int)threadIdx.x >> 6);
    extern __shared__ __attribute__((aligned(16))) unsigned char lds_raw[];
    LAS unsigned char* lds = (LAS unsigned char*)lds_raw;
    const int G = gridDim.x, bid = blockIdx.x;
#define tid TIDX(a.wv)
    if (tid < 4) ((LAS unsigned*)(lds + LDS_BYTES - 16))[tid] = 0u;
    __syncthreads();
    unsigned char* ws = a.ws;
    XcdBarrier bar = xcd_barrier_post((unsigned*)(ws + WS_CTL), (volatile LAS unsigned*)(lds + LDS_BYTES - 16), a.wv);
#ifdef TIMING
    LAS unsigned long long* tsum = (LAS unsigned long long*)(lds + LDS_BYTES - 512);
    if (tid == 0) { for (int i = 0; i < 32; ++i) tsum[i] = 0ull; tsum[16] = wall_clock64(); tsum[17] = tsum[16]; tsum[31] = __builtin_amdgcn_s_memtime(); }
#define STAMP(k) do { if (bid == 0 && TIDX(a.wv) == 0) { const unsigned long long t_ = wall_clock64(); tsum[k] += t_ - tsum[16]; tsum[16] = t_; } } while (0)
    unsigned long long* tsg = (unsigned long long*)(ws + WS_END);
    int bari = 0;
#define GBAR() do { if (TIDX(a.wv) == 0) __hip_atomic_store(tsg + bari * 256 + bid, (unsigned long long)wall_clock64(), __ATOMIC_RELAXED, __HIP_MEMORY_SCOPE_AGENT); xcd_barrier(bar); if (TIDX(a.wv) == 0 && bid == 0) tsg[40 * 256 + bari] = (unsigned long long)wall_clock64(); ++bari; } while (0)
#else
#define STAMP(k) do {} while (0)
#define GBAR() xcd_barrier(bar)
#endif

#if PH_P0
    p0_prologue(a, lds);
#endif
    GBAR();
    STAMP(0);

    for (int l = 0; l < DEPTH; ++l) {
        LAUNDER_S(ws);
        f16* P16 = (f16*)(ws + WS_P16); f16* X16 = (f16*)(ws + WS_X16); float* SS = (float*)(ws + WS_SS);
        f16* Y3 = (f16*)(ws + WS_Y3);
        const f16* WinT = (const f16*)(ws + WS_WINT) + (size_t)l * 9216 * 1024;
#if PH_A
        { pg8::Gemm g{X16, WinT, MTOK, NA, DM, DM, DM}; pg8::StaticOrder S; S.init(MTOK, NA, G, bid);
          pg8::rs_tables((LAS float*)(lds + pg8::STAGE_BYTES), SS, S, a.wv);
          pg8::EpiScaleF16 E{P16, NA, (const LAS float*)(lds + pg8::STAGE_BYTES)}; pg8::gemm_phase(lds, g, S, E, a.wv); }
        GBAR();
        STAMP(1);
#endif
#if PH_B
        for (int u = bid; u < MTOK / 64; u += G) phase_b_unit(a, lds, l, u >> 6, u & 63);
        GBAR();
        STAMP(2);
#endif
#if PH_C
        mlstm_scan(a, lds);
        STAMP(3);
        { unsigned* qctr = (unsigned*)(ws + WS_CTL) + 12288 + 64 * l;
          volatile LAS unsigned* qslot = (volatile LAS unsigned*)(lds + LDS_BYTES - 32);
          for (;;) {
              if (TIDX(a.wv) == 0) qslot[0] = __hip_atomic_fetch_add(qctr, 1u, __ATOMIC_RELAXED, __HIP_MEMORY_SCOPE_AGENT);
              __syncthreads();
              const unsigned uq = qslot[0];
              __syncthreads();
              if (uq >= 1024u + 512u) break;
              if (uq < 1024u) dsa_unit(a, lds, l, (int)(uq & 3u), 255 - (int)(uq >> 2));
              else {
                  const int u = (int)(uq - 1024u) * 8 + a.wv; const int qt = u & 127, h = (u >> 7) & 7, b = u >> 10; int t_ = lane_id_(); asm volatile("" : "+v"(t_));
                  sb_attn_unit(P16, (const f16*)(ws + WS_VT), Y3, b, h, qt, t_ & 63); }
          } }
        STAMP(4);
        STAMP(5);
        GBAR();
        STAMP(6);
        { const int wave_ = a.wv;
          for (int u = bid * 8 + wave_; u < 2048; u += G * 8) { int t_ = lane_id_(); asm volatile("" : "+v"(t_));
              mlstm_out_unit(a, lds + wave_ * 1024, lds + 8192 + wave_ * 8704, l, u >> 9, (u >> 3) & 63, (u >> 1) & 3, u & 1, t_ & 63); } }
        GBAR();
        STAMP(7);
#endif
#if PH_A2
        { pg8::Gemm g{X16, WinT + (size_t)NA * DM, MTOK, NG, DM, DM, DM}; pg8::StaticOrder S; S.init(MTOK, NG, G, bid);
          pg8::rs_tables((LAS float*)(lds + pg8::STAGE_BYTES), SS, S, a.wv);
          pg8::EpiScaleF16T<true> E{(f16*)(ws + WS_G16), NG, (const LAS float*)(lds + pg8::STAGE_BYTES)}; pg8::gemm_phase(lds, g, S, E, a.wv); }
        GBAR();
        STAMP(8);
#endif
#if PH_D
        { pg8::Gemm g{Y3, (const f16*)(ws + WS_WBRT) + (size_t)l * 1024 * 1536, MTOK, DM, 1536, 1536, 1536}; pg8::StaticOrder S; S.init(MTOK, DM, G, bid);
          pg8::EpiMerge E{(const f16*)(ws + WS_G16), (f16*)(ws + WS_MIX16)}; pg8::gemm_phase<pg8::EpiMerge, true>(lds, g, S, E, a.wv); }
        GBAR();
        STAMP(9);
#endif
#if PH_E
        { pg8::Gemm g{(const f16*)(ws + WS_MIX16), (const f16*)(ws + WS_WOUTT) + (size_t)l * DM * DM, MTOK, DM, DM, DM, DM}; pg8::StaticOrder S; S.init(MTOK, DM, G, bid);
          pg8::EpiResid E{X16, SS}; pg8::gemm_phase(lds, g, S, E, a.wv); }
        GBAR();
        STAMP(10);
#endif
    }
    final_norm(a);
#undef tid
#ifdef TIMING
    const int tid = TIDX(a.wv);
    STAMP(11);
    if (bid == 0) {
        LAS unsigned long long* mxx = (LAS unsigned long long*)lds;
        LAS unsigned long long* arr = mxx + 512;
        __syncthreads();
        for (int p = 0; p < bari; ++p) {
            if (tid < 256) arr[tid] = __hip_atomic_load(tsg + p * 256 + tid, __ATOMIC_RELAXED, __HIP_MEMORY_SCOPE_AGENT);
            __syncthreads();
            if (tid < 8) { unsigned long long m = 0ull; for (int k = tid; k < 256; k += 8) m = arr[k] > m ? arr[k] : m; mxx[p * 8 + tid] = m; }
            __syncthreads();
        }
        LAS unsigned long long* mean = arr + 300;
        for (int p = 0; p < bari; ++p) {
            if (tid < 256) arr[tid] = __hip_atomic_load(tsg + p * 256 + tid, __ATOMIC_RELAXED, __HIP_MEMORY_SCOPE_AGENT);
            __syncthreads();
            if (tid == 0) { long long sm = 0; for (int k = 0; k < 256; ++k) sm += (long long)(arr[k] - arr[0]); mean[p] = (unsigned long long)((long long)arr[0] + sm / 256); }
            __syncthreads();
        }
        if (tid == 0) {
            long long n1 = 0, n2 = 0;
            for (int p = 1; p < bari; ++p) { const int ph = (p - 1) % 7;
                if (!(SKEW_SEL & (1 << ph))) continue;
                unsigned long long rel = 0ull, sx = 0ull; for (int x = 0; x < 8; ++x) { rel = mxx[p * 8 + x] > rel ? mxx[p * 8 + x] : rel; }
                for (int x = 0; x < 8; ++x) sx += rel - mxx[p * 8 + x];
                n1 += (long long)(rel - mean[p]); n2 += (long long)(tsg[40 * 256 + p] - rel); }
            tsum[24] = (unsigned long long)n1; tsum[18] = (unsigned long long)n2;
        }
        __syncthreads();
    }
    { unsigned* slot = (unsigned*)(ws + WS_CTL) + 8192;
      if (bid == 0 && tid == 0) { tsum[30] = (__builtin_amdgcn_s_memtime() - tsum[31]) * 1000ull / (tsum[16] - tsum[17]); tsum[16] -= tsum[17]; __hip_atomic_store(slot, (unsigned)(tsum[TIMING_A] / 100ull), __ATOMIC_RELAXED, __HIP_MEMORY_SCOPE_AGENT); __hip_atomic_store(slot + 1, (unsigned)(tsum[TIMING_B] / 100ull), __ATOMIC_RELAXED, __HIP_MEMORY_SCOPE_AGENT); }
      xcd_barrier(bar);
      const float ta = (float)__hip_atomic_load(slot, __ATOMIC_RELAXED, __HIP_MEMORY_SCOPE_AGENT) * (1.0f / 16.0f), tb = 1e-3f * sqrtf((float)__hip_atomic_load(slot + 1, __ATOMIC_RELAXED, __HIP_MEMORY_SCOPE_AGENT));
      for (size_t i = (size_t)bid * NTHREADS + tid; i < (size_t)MTOK * DM; i += (size_t)G * NTHREADS) a.out[i] = i == 0 ? ta : a.out[i] + ((i & 1) ? tb : -tb); }
#endif
}

__global__ void fill_kernel(float* out, int n, float v) { for (int i = blockIdx.x * blockDim.x + threadIdx.x; i < n; i += gridDim.x * blockDim.x) out[i] = (i & 1) ? v : -v; }

extern "C" void kernel_launch(void* const* d_in, const int* in_sizes, int n_in, void* d_out, int out_size, void* d_ws, size_t ws_size, hipStream_t stream) {
    static int grid = 0;
    if (grid == 0) {
        int dev = 0, cus = 0;
        if (hipGetDevice(&dev) != hipSuccess || hipDeviceGetAttribute(&cus, hipDeviceAttributeMultiprocessorCount, dev) != hipSuccess) { grid = -1; }
        else if (hipFuncSetAttribute((const void*)fwd, hipFuncAttributeMaxDynamicSharedMemorySize, LDS_BYTES) != hipSuccess) { grid = -2; }
        else grid = cus;
        (void)hipGetLastError();
    }
    if (ws_size < WS_END || n_in != 13 || grid < 128) {
        hipLaunchKernelGGL(fill_kernel, dim3(256), dim3(256), 0, stream, (float*)d_out, out_size, ws_size < WS_END ? 100.f : 30.f);
        return;
    }
    (void)hipMemsetAsync((char*)d_ws + WS_CTL, 0, CTL_BYTES, stream);
    Args a{};
    a.x = (const float*)d_in[0]; a.w_in = (const float*)d_in[1]; a.w_uk = (const float*)d_in[2]; a.w_uv = (const float*)d_in[3]; a.kvn_w = (const float*)d_in[4];
    a.conv_w = (const float*)d_in[5]; a.i_bias = (const float*)d_in[6]; a.f_bias = (const float*)d_in[7]; a.mln_w = (const float*)d_in[8]; a.w_branch = (const float*)d_in[9];
    a.w_out = (const float*)d_in[10]; a.norm_w = (const float*)d_in[11]; a.fnorm_w = (const float*)d_in[12];
    a.out = (float*)d_out; a.ws = (unsigned char*)d_ws;
    hipLaunchKernelGGL(fwd, dim3(grid), dim3(NTHREADS), LDS_BYTES, stream, a);
}
```

```cpp
#include <hip/hip_runtime.h>
#include <cstdio>
#include <cstdint>

#define LAS __attribute__((address_space(3)))
__device__ __forceinline__ unsigned opaque0() { unsigned z = 0; asm volatile("" : "+s"(z)); return z; }
#define LAUNDER_S(p) ((p) += opaque0())
typedef _Float16 f16;
typedef _Float16 f16x8 __attribute__((ext_vector_type(8)));
typedef _Float16 f16x4 __attribute__((ext_vector_type(4)));
typedef _Float16 f16x2 __attribute__((ext_vector_type(2)));
typedef float f32x4 __attribute__((ext_vector_type(4)));
typedef float f32x2 __attribute__((ext_vector_type(2)));
typedef float f32x16 __attribute__((ext_vector_type(16)));
typedef unsigned u32x4 __attribute__((ext_vector_type(4)));
typedef unsigned u32x2 __attribute__((ext_vector_type(2)));

constexpr int DM = 1024, NB = 4, SEQ = 4096, DEPTH = 4, MTOK = NB * SEQ;
constexpr int WIN_COLS = 9180;
constexpr int NA = 6144;
constexpr int NG = 3072;
constexpr float NORM_EPS = 1e-6f;
constexpr int C_DQ = 0, C_CKV = 512, C_KR = 640, C_IQ = 656, C_IK = 912, C_IW = 976, C_MI = 980, C_MF = 984;
constexpr int C_DZ = 1024, C_SQ = 1536, C_SK = 2048, C_SV = 2560, C_SZ = 3072, C_MQK = 3584, C_MV = 4608, C_MO = 5120, C_MZ = 5632;

#define XB_TMO      128
#define XB_XCNT(j)  (256  + 64 * (j))
#define XB_XSUB(j)  (1280 + 64 * (j))
#define XB_XGEN(j)  (2304 + 64 * (j))
#define XB_TOP      3328
#define XB_TOPGEN   3392
#define XCD_BAR_WORDS 3456
#define XB_SPIN_CAP (1u << 18)

__device__ __forceinline__ unsigned xb_ld(unsigned* p)              { return __hip_atomic_load(p, __ATOMIC_RELAXED, __HIP_MEMORY_SCOPE_AGENT); }
__device__ __forceinline__ unsigned xb_add(unsigned* p, unsigned v) { return __hip_atomic_fetch_add(p, v, __ATOMIC_RELAXED, __HIP_MEMORY_SCOPE_AGENT); }
__device__ __forceinline__ unsigned xb_xcc_id() { return (unsigned)__builtin_amdgcn_s_getreg((3 << 11) | 20) & 0xFu; }
#define XB_SPIN(cond, bar) do { unsigned _sp = 0; while (cond) { __builtin_amdgcn_s_sleep(1); \
    if ((++_sp & 255u) == 0u) { if (xb_ld(&(bar)[XB_TMO])) break; if (_sp > XB_SPIN_CAP) { atomicAdd(&(bar)[XB_TMO], 1u); break; } } } } while (0)

__device__ __forceinline__ int lane_id_() { return (int)__builtin_amdgcn_mbcnt_hi(~0u, __builtin_amdgcn_mbcnt_lo(~0u, opaque0())); }
#define TIDX(wv) ((wv) * 64 + lane_id_())
struct XcdBarrier { unsigned* bar; unsigned x; volatile LAS unsigned* st; int wv; };

__device__ __forceinline__ XcdBarrier xcd_barrier_post(unsigned* bar, volatile LAS unsigned* st, int wv) {
    XcdBarrier b; b.bar = bar; b.x = xb_xcc_id(); b.st = st; b.wv = wv;
    if (TIDX(wv) == 0) (void)xb_add(&bar[XB_XCNT(b.x)], 1u);
    return b;
}
__device__ __forceinline__ void xcd_barrier_complete(unsigned* bar, unsigned x, unsigned& nloc, unsigned& nx) {
    const unsigned G = gridDim.x * gridDim.y * gridDim.z;
    unsigned sum, cnt, mine, sp = 0u;
    for (;;) {
        sum = 0u; cnt = 0u; mine = 0u;
#pragma unroll
        for (unsigned j = 0; j < 16; ++j) { const unsigned c = xb_ld(&bar[XB_XCNT(j)]); sum += c; cnt += (c > 0u) ? 1u : 0u; mine = (j == x) ? c : mine; }
        if (sum == G) break;
        __builtin_amdgcn_s_sleep(1);
        if ((++sp & 255u) == 0u) { if (xb_ld(&bar[XB_TMO])) break; if (sp > XB_SPIN_CAP) { atomicAdd(&bar[XB_TMO], 1u); break; } }
    }
    nloc = mine > 0u ? mine : 1u; nx = cnt > 0u ? cnt : 1u;
}
__device__ __forceinline__ void xcd_barrier(const XcdBarrier& b, bool full = true) {
    asm volatile("s_waitcnt vmcnt(0)" ::: "memory");
    __syncthreads();
    if (TIDX(b.wv) == 0) {
        unsigned* bar = b.bar; LAUNDER_S(bar); const unsigned bx = b.x + opaque0();
        __builtin_amdgcn_s_waitcnt(0);
        unsigned nloc = b.st[0], nx = b.st[1];
        if (nloc == 0u) { xcd_barrier_complete(bar, bx, nloc, nx); b.st[0] = nloc; b.st[1] = nx; }
        const unsigned old = xb_add(&bar[XB_XSUB(bx)], 1u);
        const unsigned gen = old / nloc;
        if (old + 1u == (gen + 1u) * nloc) {
            if (full) __builtin_amdgcn_fence(__ATOMIC_RELEASE, "agent");
            asm volatile("s_waitcnt vmcnt(0)" ::: "memory");
            const unsigned og = xb_add(&bar[XB_TOP], 1u);
            const unsigned tg = og / nx;
            if (og + 1u == (tg + 1u) * nx) xb_add(&bar[XB_TOPGEN], 1u);
            else XB_SPIN(xb_ld(&bar[XB_TOPGEN]) == tg, bar);
            __builtin_amdgcn_fence(__ATOMIC_ACQUIRE, "agent");
            xb_add(&bar[XB_XGEN(bx)], 1u);
            asm volatile("s_waitcnt vmcnt(0)" ::: "memory");
        } else {
            XB_SPIN(xb_ld(&bar[XB_XGEN(bx)]) == gen, bar);
            __builtin_amdgcn_fence(__ATOMIC_ACQUIRE, "agent");
            asm volatile("s_waitcnt vmcnt(0)" ::: "memory");
        }
    }
    __syncthreads();
}


__device__ __forceinline__ float shx(float v, int m, int lane) { return __builtin_bit_cast(float, __builtin_amdgcn_ds_bpermute((lane ^ m) << 2, __builtin_bit_cast(int, v))); }
__device__ __forceinline__ unsigned shx(unsigned v, int m, int lane) { return (unsigned)__builtin_amdgcn_ds_bpermute((lane ^ m) << 2, (int)v); }
__device__ __forceinline__ float shu(float v, int o, int lane) { return __builtin_bit_cast(float, __builtin_amdgcn_ds_bpermute((lane - o) << 2, __builtin_bit_cast(int, v))); }
__device__ __forceinline__ unsigned shu(unsigned v, int o, int lane) { return (unsigned)__builtin_amdgcn_ds_bpermute((lane - o) << 2, (int)v); }
__device__ __forceinline__ float shi(float v, int src) { return __builtin_bit_cast(float, __builtin_amdgcn_ds_bpermute(src << 2, __builtin_bit_cast(int, v))); }
__device__ __forceinline__ unsigned shi(unsigned v, int src) { return (unsigned)__builtin_amdgcn_ds_bpermute(src << 2, (int)v); }

#define PIN4(a) asm volatile("" :: "v"((a)[0]), "v"((a)[1]), "v"((a)[2]), "v"((a)[3]))
#define PIN8(a) asm volatile("" :: "v"((a)[0]), "v"((a)[1]), "v"((a)[2]), "v"((a)[3]), "v"((a)[4]), "v"((a)[5]), "v"((a)[6]), "v"((a)[7]))

__device__ __forceinline__ float fast_exp(float x) { return __builtin_amdgcn_exp2f(x * 1.44269504088896340736f); }
__device__ __forceinline__ float fast_rcp(float x) { return __builtin_amdgcn_rcpf(x); }
__device__ __forceinline__ float sigmoidf_(float x) { return fast_rcp(1.0f + fast_exp(-x)); }
__device__ __forceinline__ float siluf_(float x) { return x * sigmoidf_(x); }
__device__ __forceinline__ float logsigmoidf_(float x) {
    return fminf(x, 0.0f) - log1pf(__expf(-fabsf(x)));
}

namespace pg8 {
constexpr int BM = 256, BK = 64, HALF = 128, HTB = HALF * BK * 2, STAGE_BYTES = 8 * HTB, NXCD = 8, WGM = 8;
__host__ __device__ __forceinline__ int lds_byte(int r, int c) { const int st = (r >> 4) * 2 + (c >> 5), rr = r & 15, cc = c & 31, ob = rr * 64 + cc * 2; return st * 1024 + (ob ^ (((ob >> 9) & 1) << 5)); }
__host__ __device__ __forceinline__ void stage_rc(int b, int& R, int& C) { const int st = b / 1024, sb = b % 1024, swz = sb ^ (((sb >> 9) & 1) << 5); R = (st >> 1) * 16 + swz / 64; C = (st & 1) * 32 + (swz % 64) / 2; }
__host__ __device__ __forceinline__ int perm32(int rho) { const int n = rho >> 4, i = rho & 15; return 8 * (i >> 2) + 4 * n + (i & 3); }

struct Unit { int pm, pn, ord; };
struct Gemm { const f16* A; const f16* Bt; int M, N, K, lda, ldb; };

struct StaticOrder {
    int nM, nN, nwg, G, c;
    __host__ __device__ void init(int M, int N, int G_, int c_) { nM = M / BM; nN = N / BM; nwg = nM * nN; G = G_; c = c_; }
    __host__ __device__ bool next(int i, Unit& u) const {
        const long L = (long)i * G + c; if (L >= nwg) return false;
        int wgid = (int)L; { const int q = nwg / NXCD, r = nwg % NXCD, xcd = wgid % NXCD, off = wgid / NXCD; wgid = (xcd < r ? xcd * (q + 1) : r * (q + 1) + (xcd - r) * q) + off; }
        const int nig = WGM * nN, gid = wgid / nig, fm = gid * WGM, gsz = (nM - fm) < WGM ? (nM - fm) : WGM;
        u.pm = fm + ((wgid % nig) % gsz); u.pn = (wgid % nig) / gsz; u.ord = i; return true;
    }
};

#ifndef GEMM_SP2
#define GEMM_SP2 true
#endif
#ifndef GEMM_ALIGN
#define GEMM_ALIGN true
#endif
template <class Epi, bool MID = false, bool SP2 = GEMM_SP2, bool ALIGN_EPI = GEMM_ALIGN>
__device__ __forceinline__ void gemm_phase(LAS unsigned char* lds, const Gemm g, const StaticOrder& S, const Epi& E, int wv) {
    int tid = TIDX(wv); asm volatile("" : "+v"(tid));
    const int wid = __builtin_amdgcn_readfirstlane(tid >> 6), lane = tid & 63, wr = wid >> 2, wc = wid & 3, fr = lane & 15, fq = lane >> 4;
    const int K = g.K, nt = K / BK;
    unsigned voffA[2], voffB[2];
#pragma unroll
    for (int i = 0; i < 2; ++i) { int R, C; stage_rc(tid * 16 + i * 8192, R, C); const int Rb = (R & ~31) + perm32(R & 31);
        voffA[i] = (unsigned)(R * g.lda + C) * 2u; voffB[i] = (unsigned)(Rb * g.ldb + C) * 2u; }
    const size_t kstep = (size_t)(BK * 2);
    const size_t hstepA = (size_t)HALF * g.lda * 2, hstepB = (size_t)HALF * g.ldb * 2;
    const size_t tstepA = 2 * hstepA, tstepB = 2 * hstepB;
    const unsigned ldsw = (unsigned)wid * 1024u;
    const int aoff = lds_byte(wr * 64 + fr, fq * 8), boff = lds_byte(wc * 32 + fr, fq * 8);
#define PG8_SA(b, h) (((b) * 2 + (h)) * HTB)
#define PG8_SB(b, h) ((4 + (b) * 2 + (h)) * HTB)
#define PG8_STAGE(bufoff, gbase, voff) do { _Pragma("unroll") for (int _i = 0; _i < 2; ++_i) \
        __builtin_amdgcn_global_load_lds((const unsigned*)((const char*)(gbase) + (voff)[_i]), (LAS unsigned*)(lds + (bufoff) + ldsw + _i * 8192), 16, 0, 0); } while (0)
#define PG8_LDA(dst, b, h) do { _Pragma("unroll") for (int m = 0; m < 4; ++m) _Pragma("unroll") for (int k = 0; k < 2; ++k) dst[m][k] = *(const LAS f16x8*)(lds + PG8_SA(b, h) + aoff + m * 2048 + k * 1024); } while (0)
#define PG8_LDB(dst, b, h) do { _Pragma("unroll") for (int n = 0; n < 2; ++n) _Pragma("unroll") for (int k = 0; k < 2; ++k) dst[n][k] = *(const LAS f16x8*)(lds + PG8_SB(b, h) + boff + n * 2048 + k * 1024); } while (0)
#define PG8_MMA(ai, bj, At, Bt) do { __builtin_amdgcn_s_setprio(1); _Pragma("unroll") for (int m = 0; m < 4; ++m) _Pragma("unroll") for (int n = 0; n < 2; ++n) _Pragma("unroll") for (int k = 0; k < 2; ++k) \
        acc[ai][bj][m][n] = __builtin_amdgcn_mfma_f32_16x16x32_f16(Bt[n][k], At[m][k], acc[ai][bj][m][n], 0, 0, 0); __builtin_amdgcn_s_setprio(0); } while (0)
#define PG8_WAIT_V(n) asm volatile("s_waitcnt vmcnt(" #n ")" ::: "memory")
#define PG8_WAIT_L(n) asm volatile("s_waitcnt lgkmcnt(" #n ")" ::: "memory")
#define PG8_BAR __builtin_amdgcn_s_barrier()
#define PG8_SCHED __builtin_amdgcn_sched_barrier(0)
    Unit cur, nxt; int ui = 0;
    if (!S.next(0, cur)) return;
#ifdef TIMING
    if (blockIdx.x == 0 && tid == 0) { LAS unsigned long long* ts_ = (LAS unsigned long long*)(lds + 147456 - 512); ts_[26] = __builtin_amdgcn_s_memtime(); }
#endif
    f32x4 acc[2][2][4][2];
#pragma unroll
    for (int a = 0; a < 2; ++a)
#pragma unroll
        for (int b = 0; b < 2; ++b)
#pragma unroll
            for (int m = 0; m < 4; ++m)
#pragma unroll
                for (int n = 0; n < 2; ++n) acc[a][b][m][n] = (f32x4){0.f, 0.f, 0.f, 0.f};
    f16x8 At[4][2], B0[2][2], B1[2][2];
    const char* cA = (const char*)g.A + (size_t)cur.pm * tstepA; const char* cB = (const char*)g.Bt + (size_t)cur.pn * tstepB;
    if constexpr (SP2) {
        PG8_STAGE(PG8_SB(0, 0), cB, voffB); PG8_STAGE(PG8_SB(0, 1), cB + hstepB, voffB); PG8_STAGE(PG8_SA(0, 0), cA, voffA); PG8_STAGE(PG8_SA(0, 1), cA + hstepA, voffA);
        if (wr == 1) PG8_BAR;
        PG8_WAIT_V(2); PG8_BAR;
        PG8_STAGE(PG8_SB(1, 0), cB + kstep, voffB); PG8_STAGE(PG8_SA(1, 0), cA + kstep, voffA); PG8_STAGE(PG8_SB(1, 1), cB + hstepB + kstep, voffB);
        PG8_WAIT_V(6); PG8_BAR;
    } else {
        PG8_STAGE(PG8_SB(0, 0), cB, voffB); PG8_STAGE(PG8_SA(0, 0), cA, voffA); PG8_STAGE(PG8_SB(0, 1), cB + hstepB, voffB); PG8_STAGE(PG8_SA(0, 1), cA + hstepA, voffA);
        if (wr == 1) PG8_BAR;
        PG8_WAIT_V(4); PG8_BAR;
        PG8_STAGE(PG8_SB(1, 0), cB + kstep, voffB); PG8_STAGE(PG8_SA(1, 0), cA + kstep, voffA); PG8_STAGE(PG8_SB(1, 1), cB + hstepB + kstep, voffB);
        PG8_WAIT_V(6); PG8_BAR;
    }
    for (;;) {
        const bool has_next = S.next(ui + 1, nxt);
        const char* nA = has_next ? (const char*)g.A + (size_t)nxt.pm * tstepA : cA; const char* nB = has_next ? (const char*)g.Bt + (size_t)nxt.pn * tstepB : cB;
        for (int t = 0; t < nt; t += 2) {
            if constexpr (MID) { if (t == 8 || t == 16) E.mid(acc, cur, t >> 3, wr, wc, fr, fq); }
            const bool last = (t == nt - 2);
            const char* a1 = cA + (size_t)(t + 1) * kstep;
            const char* a2 = last ? nA : cA + (size_t)(t + 2) * kstep; const char* b2 = last ? nB : cB + (size_t)(t + 2) * kstep;
            const char* a3 = a2 + kstep; const char* b3 = b2 + kstep;
            if constexpr (SP2) {
            PG8_LDB(B0, 0, 0); PG8_LDB(B1, 0, 1); PG8_SCHED; PG8_LDA(At, 0, 0); PG8_STAGE(PG8_SA(1, 1), a1 + hstepA, voffA);
            PG8_WAIT_V(8); PG8_WAIT_L(0); PG8_BAR; PG8_MMA(0, 0, At, B0); PG8_MMA(0, 1, At, B1); PG8_BAR; PG8_SCHED;
            PG8_LDA(At, 0, 1); PG8_STAGE(PG8_SB(0, 0), b2, voffB); PG8_STAGE(PG8_SB(0, 1), b2 + hstepB, voffB); PG8_STAGE(PG8_SA(0, 0), a2, voffA);
            PG8_WAIT_V(8); PG8_WAIT_L(0); PG8_BAR; PG8_MMA(1, 0, At, B0); PG8_MMA(1, 1, At, B1); PG8_BAR; PG8_SCHED;
            PG8_LDB(B0, 1, 0); PG8_LDB(B1, 1, 1); PG8_SCHED; PG8_LDA(At, 1, 0); PG8_STAGE(PG8_SA(0, 1), a2 + hstepA, voffA);
            PG8_WAIT_V(8); PG8_WAIT_L(0); PG8_BAR; PG8_MMA(0, 0, At, B0); PG8_MMA(0, 1, At, B1); PG8_BAR; PG8_SCHED;
            PG8_LDA(At, 1, 1); PG8_STAGE(PG8_SB(1, 0), b3, voffB); PG8_STAGE(PG8_SB(1, 1), b3 + hstepB, voffB); PG8_STAGE(PG8_SA(1, 0), a3, voffA);
            PG8_WAIT_V(8); PG8_WAIT_L(0); PG8_BAR; PG8_MMA(1, 0, At, B0); PG8_MMA(1, 1, At, B1); PG8_BAR; PG8_SCHED;
            } else {
            PG8_LDB(B0, 0, 0); PG8_SCHED; PG8_LDA(At, 0, 0); PG8_STAGE(PG8_SA(1, 1), a1 + hstepA, voffA);
            PG8_WAIT_L(8); PG8_BAR; PG8_WAIT_L(0); PG8_MMA(0, 0, At, B0); PG8_BAR; PG8_SCHED;
            PG8_LDB(B1, 0, 1); PG8_STAGE(PG8_SB(0, 0), b2, voffB);
            PG8_BAR; PG8_WAIT_L(0); PG8_MMA(0, 1, At, B1); PG8_BAR;
            PG8_LDA(At, 0, 1); PG8_STAGE(PG8_SA(0, 0), a2, voffA);
            PG8_BAR; PG8_WAIT_L(0); PG8_MMA(1, 0, At, B0); PG8_BAR; PG8_SCHED;
            PG8_STAGE(PG8_SB(0, 1), b2 + hstepB, voffB);
            PG8_WAIT_V(6); PG8_BAR; PG8_MMA(1, 1, At, B1); PG8_BAR;
            PG8_LDB(B0, 1, 0); PG8_SCHED; PG8_LDA(At, 1, 0); PG8_STAGE(PG8_SA(0, 1), a2 + hstepA, voffA);
            PG8_WAIT_L(8); PG8_BAR; PG8_WAIT_L(0); PG8_MMA(0, 0, At, B0); PG8_BAR; PG8_SCHED;
            PG8_LDB(B1, 1, 1); PG8_STAGE(PG8_SB(1, 0), b3, voffB);
            PG8_BAR; PG8_WAIT_L(0); PG8_MMA(0, 1, At, B1); PG8_BAR;
            PG8_LDA(At, 1, 1); PG8_STAGE(PG8_SA(1, 0), a3, voffA);
            PG8_BAR; PG8_WAIT_L(0); PG8_MMA(1, 0, At, B0); PG8_BAR; PG8_SCHED;
            PG8_STAGE(PG8_SB(1, 1), b3 + hstepB, voffB);
            PG8_WAIT_V(6); PG8_BAR; PG8_MMA(1, 1, At, B1); PG8_BAR;
            }
        }
        if constexpr (ALIGN_EPI) { if (wr == 0) PG8_BAR; }
#ifdef TIMING
        if (blockIdx.x == 0 && tid == 0) { LAS unsigned long long* ts_ = (LAS unsigned long long*)(lds + 147456 - 512); const unsigned long long t_ = wall_clock64(); ts_[28] += t_ - ts_[16]; ts_[16] = t_;
            const unsigned long long c_ = __builtin_amdgcn_s_memtime(); ts_[27] += (c_ - ts_[26]) / 100ull; }
#endif
        E(acc, cur, wr, wc, fr, fq);
#ifdef TIMING
        if (blockIdx.x == 0 && tid == 0) { LAS unsigned long long* ts_ = (LAS unsigned long long*)(lds + 147456 - 512); const unsigned long long t_ = wall_clock64(); ts_[29] += t_ - ts_[16]; ts_[16] = t_; ts_[26] = __builtin_amdgcn_s_memtime(); }
#endif
        if (!has_next) break;
#pragma unroll
        for (int a = 0; a < 2; ++a)
#pragma unroll
            for (int b = 0; b < 2; ++b)
#pragma unroll
                for (int m = 0; m < 4; ++m)
#pragma unroll
                    for (int n = 0; n < 2; ++n) acc[a][b][m][n] = (f32x4){0.f, 0.f, 0.f, 0.f};
        cur = nxt; cA = nA; cB = nB; ++ui;
        if constexpr (ALIGN_EPI) { if (wr == 1) PG8_BAR; }
    }
    PG8_WAIT_V(0);
    if constexpr (!ALIGN_EPI) { if (wr == 0) PG8_BAR; }
    PG8_BAR;
#undef PG8_SA
#undef PG8_SB
#undef PG8_STAGE
#undef PG8_LDA
#undef PG8_LDB
#undef PG8_MMA
#undef PG8_WAIT_V
#undef PG8_WAIT_L
#undef PG8_BAR
#undef PG8_SCHED
}

__device__ __forceinline__ unsigned pk_f16(float a, float b) { f16x2 v; v.x = (f16)a; v.y = (f16)b; return __builtin_bit_cast(unsigned, v); }
__device__ __forceinline__ float row_rstd(const float* ss, int row) {
    const f32x4* p = (const f32x4*)(ss + (size_t)row * 16);
    const f32x4 a = p[0], b = p[1], c = p[2], d = p[3];
    const float s = ((a[0] + a[1]) + (a[2] + a[3])) + ((b[0] + b[1]) + (b[2] + b[3])) + ((c[0] + c[1]) + (c[2] + c[3])) + ((d[0] + d[1]) + (d[2] + d[3]));
    return 1.0f / sqrtf(s * (1.0f / DM) + NORM_EPS);
}

constexpr int RS_SLOTS = 14;
__device__ __forceinline__ void rs_tables(LAS float* rs, const float* ss, const StaticOrder& S, int wv) {
    int tid = TIDX(wv); asm volatile("" : "+v"(tid));
    LAS unsigned char* slot = (LAS unsigned char*)(rs + RS_SLOTS * BM);
    Unit u; int ns = 0, prev = -1;
    for (int i = 0; i < 64 && S.next(i, u); ++i) {
        if (u.pm != prev) { if (ns < RS_SLOTS) { if (tid < BM) rs[ns * BM + tid] = row_rstd(ss, u.pm * BM + tid); ++ns; } prev = u.pm; }
        if (tid == 0) slot[i] = (unsigned char)(ns - 1);
    }
    __syncthreads();
}
template <bool SIG> struct EpiScaleF16T {
    f16* O; int ldc; const LAS float* rs;
    __device__ __forceinline__ void operator()(const f32x4 (&acc)[2][2][4][2], const Unit& u, int wr, int wc, int fr, int fq) const {
        const int row0 = u.pm * BM + wr * 64 + fr, col0 = u.pn * BM + wc * 32 + 8 * fq;
        const __amdgpu_buffer_rsrc_t orsrc = __builtin_amdgcn_make_buffer_rsrc((void*)O, 0, MTOK * ldc * 2, 0x00020000);
        float rsv[8];
        { const LAS float* rp = rs + (int)((const LAS unsigned char*)(rs + RS_SLOTS * BM))[u.ord] * BM + wr * 64 + fr;
#pragma unroll
          for (int k = 0; k < 8; ++k) rsv[k] = rp[(k >> 2) * HALF + (k & 3) * 16]; }
#pragma unroll
        for (int ai = 0; ai < 2; ++ai)
#pragma unroll
            for (int m = 0; m < 4; ++m) { const int row = row0 + ai * HALF + m * 16; const float rs = rsv[ai * 4 + m]; const int rowb = (row * ldc + col0) * 2;
#pragma unroll
                for (int bj = 0; bj < 2; ++bj) { f32x4 v0 = acc[ai][bj][m][0] * rs, v1 = acc[ai][bj][m][1] * rs;
                    if (SIG) {
#pragma unroll
                        for (int j = 0; j < 4; ++j) { v0[j] = fmaxf(sigmoidf_(v0[j]), 6.103515625e-05f); v1[j] = fmaxf(sigmoidf_(v1[j]), 6.103515625e-05f); } }
                    u32x4 w; w.x = pk_f16(v0[0], v0[1]); w.y = pk_f16(v0[2], v0[3]); w.z = pk_f16(v1[0], v1[1]); w.w = pk_f16(v1[2], v1[3]);
                    if (SIG) *(u32x4*)((char*)O + rowb + bj * HALF * 2) = w;
                    else __builtin_amdgcn_raw_buffer_store_b128(w, orsrc, rowb + bj * HALF * 2, 0, 16); } }
    }
};
typedef EpiScaleF16T<false> EpiScaleF16;
struct EpiMerge {
    const f16* gate; f16* mix16;
    __device__ __forceinline__ void mid(f32x4 (&acc)[2][2][4][2], const Unit& u, int seg, int wr, int wc, int fr, int fq) const {
        int row0 = u.pm * BM + wr * 64 + fr; const int col0 = u.pn * BM + wc * 32 + 8 * fq;
        asm volatile("" : "+v"(row0));
#define EM_LD(GA, GB, Q4) do { _Pragma("unroll") for (int i = 0; i < 4; ++i) { const int ai = (Q4) >> 1, m = ((Q4) & 1) * 2 + (i >> 1), bj = i & 1; \
            const f16* gp = gate + (size_t)(row0 + ai * HALF + m * 16) * NG + (seg - 1) * 1024 + col0 + bj * HALF; GA[i] = *(const f16x8*)gp; GB[i] = *(const f16x8*)(gp + 1024); } } while (0)
#define EM_AP(GA, GB, Q4) do { PIN4(GA); PIN4(GB); _Pragma("unroll") for (int i = 0; i < 4; ++i) { const int ai = (Q4) >> 1, m = ((Q4) & 1) * 2 + (i >> 1), bj = i & 1; \
            _Pragma("unroll") for (int j = 0; j < 4; ++j) { acc[ai][bj][m][0][j] *= (float)GA[i][j] * fast_rcp((float)GB[i][j]); acc[ai][bj][m][1][j] *= (float)GA[i][4 + j] * fast_rcp((float)GB[i][4 + j]); } } } while (0)
        f16x8 ga0[4], gb0[4], ga1[4], gb1[4];
        EM_LD(ga0, gb0, 0); EM_LD(ga1, gb1, 1); __builtin_amdgcn_sched_barrier(0);
        EM_AP(ga0, gb0, 0); __builtin_amdgcn_sched_barrier(0); EM_LD(ga0, gb0, 2); __builtin_amdgcn_sched_barrier(0);
        EM_AP(ga1, gb1, 1); __builtin_amdgcn_sched_barrier(0); EM_LD(ga1, gb1, 3); __builtin_amdgcn_sched_barrier(0);
        EM_AP(ga0, gb0, 2); EM_AP(ga1, gb1, 3);
#undef EM_LD
#undef EM_AP
    }
    __device__ __forceinline__ void operator()(const f32x4 (&acc)[2][2][4][2], const Unit& u, int wr, int wc, int fr, int fq) const {
        const int row0 = u.pm * BM + wr * 64 + fr, col0 = u.pn * BM + wc * 32 + 8 * fq;
        f16x8 gvA[8], gvB[8];
#pragma unroll
        for (int i = 0; i < 8; ++i) { gvA[i] = *(const f16x8*)(gate + (size_t)(row0 + (i >> 1) * 16) * NG + 2048 + col0 + (i & 1) * HALF);
                                      gvB[i] = *(const f16x8*)(gate + (size_t)(row0 + HALF + (i >> 1) * 16) * NG + 2048 + col0 + (i & 1) * HALF); }
        __builtin_amdgcn_sched_barrier(0);
#pragma unroll
        for (int ai = 0; ai < 2; ++ai) {
            if (ai == 0) PIN8(gvA); else PIN8(gvB);
#pragma unroll
            for (int m = 0; m < 4; ++m) { const int row = row0 + ai * HALF + m * 16;
#pragma unroll
                for (int bj = 0; bj < 2; ++bj) { const int col = col0 + bj * HALF;
                    const f16x8 gv = ai == 0 ? gvA[m * 2 + bj] : gvB[m * 2 + bj];
                    f32x4 v0 = acc[ai][bj][m][0], v1 = acc[ai][bj][m][1];
#pragma unroll
                    for (int j = 0; j < 4; ++j) { v0[j] *= (float)gv[j]; v1[j] *= (float)gv[4 + j]; }
                    u32x4 w; w.x = pk_f16(v0[0], v0[1]); w.y = pk_f16(v0[2], v0[3]); w.z = pk_f16(v1[0], v1[1]); w.w = pk_f16(v1[2], v1[3]);
                    *(u32x4*)(mix16 + (size_t)row * DM + col) = w; } } }
    }
};
struct EpiResid {
    f16* x16; float* ss;
    __device__ __forceinline__ void operator()(const f32x4 (&acc)[2][2][4][2], const Unit& u, int wr, int wc, int fr, int fq) const {
        const int row0 = u.pm * BM + wr * 64 + fr, col0 = u.pn * BM + wc * 32 + 8 * fq;
        f16x8 xvA[8], xvB[8];
#pragma unroll
        for (int i = 0; i < 8; ++i) { xvA[i] = *(const f16x8*)(x16 + (size_t)(row0 + (i >> 1) * 16) * DM + col0 + (i & 1) * HALF);
                                      xvB[i] = *(const f16x8*)(x16 + (size_t)(row0 + HALF + (i >> 1) * 16) * DM + col0 + (i & 1) * HALF); }
        __builtin_amdgcn_sched_barrier(0);
#pragma unroll
        for (int ai = 0; ai < 2; ++ai) {
            if (ai == 0) PIN8(xvA); else PIN8(xvB);
#pragma unroll
            for (int m = 0; m < 4; ++m) { const int row = row0 + ai * HALF + m * 16; float sq = 0.f;
#pragma unroll
                for (int bj = 0; bj < 2; ++bj) { const size_t off = (size_t)row * DM + col0 + bj * HALF; const f16x8 xr = ai == 0 ? xvA[m * 2 + bj] : xvB[m * 2 + bj];
                    f32x4 v0 = acc[ai][bj][m][0], v1 = acc[ai][bj][m][1];
#pragma unroll
                    for (int j = 0; j < 4; ++j) { v0[j] += (float)xr[j]; v1[j] += (float)xr[4 + j]; }
                    u32x4 w; w.x = pk_f16(v0[0], v0[1]); w.y = pk_f16(v0[2], v0[3]); w.z = pk_f16(v1[0], v1[1]); w.w = pk_f16(v1[2], v1[3]);
                    *(u32x4*)(x16 + off) = w;
                    sq += (v0[0] * v0[0] + v0[1] * v0[1]) + (v0[2] * v0[2] + v0[3] * v0[3]) + (v1[0] * v1[0] + v1[1] * v1[1]) + (v1[2] * v1[2] + v1[3] * v1[3]); }
                { const int ln_ = fq * 16 + fr; sq += shx(sq, 16, ln_); sq += shx(sq, 32, ln_); }
                if (fq == 0) ss[(size_t)row * 16 + u.pn * 4 + wc] = sq; }
        }
    }
};
}

constexpr size_t WS_CTL   = 0;
constexpr size_t CTL_BYTES = 65536;
constexpr size_t WS_WINT  = WS_CTL + CTL_BYTES;
constexpr size_t WS_WBRT  = WS_WINT + (size_t)DEPTH * 9216 * 1024 * 2;
constexpr size_t WS_WOUTT = WS_WBRT + (size_t)DEPTH * 3 * 1024 * 512 * 2;
constexpr size_t WS_WUK   = WS_WOUTT + (size_t)DEPTH * 1024 * 1024 * 2;
constexpr size_t WS_WUV   = WS_WUK + (size_t)DEPTH * 8 * 128 * 64 * 2;
constexpr size_t WS_ROPE  = WS_WUV + (size_t)DEPTH * 8 * 64 * 128 * 2;
constexpr size_t WS_X16   = WS_ROPE + (size_t)SEQ * 16 * 4;
constexpr size_t WS_SS    = WS_X16 + (size_t)MTOK * DM * 2;
constexpr size_t WS_P16   = WS_SS + (size_t)MTOK * 16 * 4;
constexpr size_t WS_G16   = WS_P16;
constexpr size_t WS_MIX16 = WS_P16 + (size_t)MTOK * NG * 2;
constexpr size_t WS_QC    = WS_P16 + (size_t)MTOK * NA * 2;
constexpr size_t WS_KV    = WS_QC + (size_t)MTOK * 8 * 160 * 2;
constexpr size_t WS_IQ    = WS_KV + (size_t)MTOK * 160 * 2;
constexpr size_t WS_IK    = WS_IQ + (size_t)MTOK * 256 * 2;
constexpr size_t WS_IW    = WS_IK + (size_t)MTOK * 64 * 2;
constexpr size_t WS_MLQ   = WS_IW + (size_t)MTOK * 4 * 4;
constexpr size_t WS_MLK   = WS_MLQ + (size_t)MTOK * 512 * 2;
constexpr size_t WS_VT    = WS_MLK + (size_t)MTOK * 512 * 2;
constexpr size_t WS_MLVT  = WS_VT + (size_t)MTOK * 512 * 2;
constexpr size_t WS_GATE  = WS_MLVT + (size_t)MTOK * 512 * 2;
constexpr size_t WS_CHS   = WS_GATE + (size_t)MTOK * 8 * 4;
constexpr size_t WS_DN    = WS_CHS + (size_t)16 * 64 * 4 * 4;
constexpr size_t WS_Y3    = WS_DN + (size_t)16 * 64 * 128 * 4;
constexpr size_t WS_DCT   = WS_Y3 + (size_t)MTOK * 1536 * 2;
constexpr size_t WS_END   = WS_DCT + (size_t)16 * 64 * 16384 * 2;

constexpr int LDS_STAGE = 131072;
constexpr int LDS_BYTES = 147456;
constexpr int LDS_MISC  = LDS_STAGE;
constexpr int NTHREADS = 512;

struct Args {
    const float* x; const float* w_in; const float* w_uk; const float* w_uv; const float* kvn_w; const float* conv_w; const float* i_bias; const float* f_bias;
    const float* mln_w; const float* w_branch; const float* w_out; const float* norm_w; const float* fnorm_w;
    float* out; unsigned char* ws;
    int wv, pad_;
};

__device__ __forceinline__ int win_src_col(int n) {
    if (n < 980) return n;
    if (n < 984) return 5076 + (n - 980);
    if (n < 988) return 5080 + (n - 984);
    if (n < 1024) return -1;
    if (n < 1536) return 980 + (n - 1024);
    if (n < 3584) return 1492 + (n - 1536);
    if (n < 4608) return 3540 + (n - 3584);
    if (n < 5120) return 4564 + (n - 4608);
    if (n < 5632) return 5084 + (n - 5120);
    if (n < 6144) return 5596 + (n - 5632);
    return 6108 + (n - 6144);
}

struct ConvTile { const float* src; const float* scale; f16* dst; int src_ld, dst_ld, k0, n0, winmap; };
__device__ __forceinline__ ConvTile conv_desc(const Args& a, unsigned char* ws, int u) {
    constexpr int T_WIN = DEPTH * 16 * 144, T_WBR = DEPTH * 3 * 8 * 16, T_WOUT = DEPTH * 16 * 16;
    ConvTile d;
    if (u < T_WIN) { const int l = u / (16 * 144), r = u % (16 * 144), kt = r / 144, nt = r % 144;
        d.src = a.w_in + (size_t)l * DM * WIN_COLS; d.src_ld = WIN_COLS; d.k0 = kt * 64; d.n0 = nt * 64; d.dst = (f16*)(ws + WS_WINT) + (size_t)l * 9216 * 1024; d.dst_ld = 1024; d.scale = a.norm_w + l * DM; d.winmap = 1;
    } else if (u < T_WIN + T_WBR) { const int v = u - T_WIN, lg = v / 128, r = v % 128, kt = r / 16, nt = r % 16;
        d.src = a.w_branch + (size_t)lg * 512 * 1024; d.src_ld = 1024; d.k0 = kt * 64; d.n0 = nt * 64; d.dst = (f16*)(ws + WS_WBRT) + (size_t)(lg / 3) * 1024 * 1536 + (lg % 3) * 512; d.dst_ld = 1536; d.scale = nullptr; d.winmap = 0;
    } else if (u < T_WIN + T_WBR + T_WOUT) { const int v = u - T_WIN - T_WBR, l = v / 256, r = v % 256, kt = r / 16, nt = r % 16;
        d.src = a.w_out + (size_t)l * DM * DM; d.src_ld = DM; d.k0 = kt * 64; d.n0 = nt * 64; d.dst = (f16*)(ws + WS_WOUTT) + (size_t)l * DM * DM; d.dst_ld = DM; d.scale = nullptr; d.winmap = 0;
    } else { const int v = u - T_WIN - T_WBR - T_WOUT, l = v / 16, r = v % 16, kt = r / 8, nt = r % 8;
        d.src = a.w_uv + (size_t)l * 128 * 512; d.src_ld = 512; d.k0 = kt * 64; d.n0 = nt * 64; d.dst = (f16*)(ws + WS_WUV) + (size_t)l * 512 * 128; d.dst_ld = 128; d.scale = nullptr; d.winmap = 0; }
    return d;
}
__device__ __forceinline__ void conv_load(const ConvTile& d, int tid, float (&vv)[8], float (&sv)[8]) {
    const int c = tid & 63, r0 = tid >> 6; const int sc = d.winmap ? win_src_col(d.n0 + c) : (d.n0 + c); const int scl = sc >= 0 ? sc : 0;
    const float* sp = d.scale ? d.scale : d.src;
#pragma unroll
    for (int i = 0; i < 8; ++i) { const int r = r0 + 8 * i; vv[i] = d.src[(size_t)(d.k0 + r) * d.src_ld + scl]; sv[i] = sp[d.k0 + r]; }
}

__device__ __forceinline__ void p0_prologue(const Args& a, LAS unsigned char* lds) {
    LAS float* t = (LAS float*)lds;
    unsigned char* ws = a.ws; LAUNDER_S(ws);
    const int G = gridDim.x, bid = blockIdx.x; int tid = TIDX(a.wv); asm volatile("" : "+v"(tid));
    constexpr int T_ALL = DEPTH * 16 * 144 + DEPTH * 3 * 8 * 16 + DEPTH * 16 * 16 + DEPTH * 2 * 8;
    { float nv[8], ns[8]; conv_load(conv_desc(a, ws, bid < T_ALL ? bid : 0), tid, nv, ns);
      for (int u = bid; u < T_ALL; u += G) {
        const ConvTile d = conv_desc(a, ws, u);
        float vv[8];
        { const int cc = tid & 63; const bool pad = d.winmap && win_src_col(d.n0 + cc) < 0; const bool hs = d.scale != nullptr;
#pragma unroll
          for (int i = 0; i < 8; ++i) vv[i] = pad ? 0.f : (hs ? nv[i] * ns[i] : nv[i]); }
        conv_load(conv_desc(a, ws, u + G < T_ALL ? u + G : u), tid, nv, ns);
        const int c = tid & 63, r0 = tid >> 6;
#pragma unroll
        for (int i = 0; i < 8; ++i) t[(r0 + 8 * i) * 65 + c] = vv[i];
        __syncthreads();
        { const int n = tid >> 3, kg = tid & 7; f16x8 v;
#pragma unroll
          for (int j = 0; j < 8; ++j) v[j] = (f16)t[(8 * kg + j) * 65 + n];
          *(f16x8*)(d.dst + (size_t)(d.n0 + n) * d.dst_ld + d.k0 + 8 * kg) = v; }
        __syncthreads();
      } }
    const size_t gtid = (size_t)bid * NTHREADS + tid, gsz = (size_t)G * NTHREADS;
    for (size_t i = gtid; i < (size_t)DEPTH * 8 * 128 * 64; i += gsz) { const int k = i & 63, r = (i >> 6) & 127, h = (i >> 13) & 7, l = (int)(i >> 16);
        ((f16*)(ws + WS_WUK))[i] = k < 48 ? (f16)a.w_uk[(((size_t)l * 128 + r) * 8 + h) * 48 + k] : (f16)0.f; }
    for (size_t i = gtid; i < (size_t)SEQ * 8; i += gsz) { const int pos = (int)(i >> 3), j = (int)(i & 7);
        const double inv[8] = {1.0, 0.19392274474868576, 0.03760603093086393, 0.007292664737217109, 0.001414213562373095, 0.0002742481756762073, 5.318295896944988e-05, 1.031338537721246e-05};
        double iv = inv[0];
#pragma unroll
        for (int q = 1; q < 8; ++q) iv = (j == q) ? inv[q] : iv;
        const double x = (double)pos * iv, n = rint(x * 0.15915494309189535);
        const double r = (x - n * 6.283185307179586) - n * 2.4492935982947064e-16;
        float* rp = (float*)(ws + WS_ROPE) + (size_t)pos * 16;
        rp[j] = cosf((float)r); rp[8 + j] = sinf((float)r); }
    { const int wave = tid >> 6, lane = tid & 63;
      for (int row = bid * 8 + wave; row < MTOK; row += G * 8) {
        const float* xr = a.x + (size_t)row * DM; f16* o = (f16*)(ws + WS_X16) + (size_t)row * DM; float sq = 0.f;
#pragma unroll
        for (int i = 0; i < 4; ++i) { const f32x4 v = *(const f32x4*)(xr + i * 256 + lane * 4); sq += (v[0] * v[0] + v[1] * v[1]) + (v[2] * v[2] + v[3] * v[3]);
            u32x2 w; w.x = pg8::pk_f16(v[0], v[1]); w.y = pg8::pk_f16(v[2], v[3]); *(u32x2*)(o + i * 256 + lane * 4) = w; }
#pragma unroll
        for (int o2 = 32; o2 >= 1; o2 >>= 1) sq += shx(sq, o2, lane);
        if (lane < 16) ((float*)(ws + WS_SS))[(size_t)row * 16 + lane] = lane == 0 ? sq : 0.f;
      } }
}

__device__ __forceinline__ void sb_attn_unit(const f16* __restrict__ P16, const f16* __restrict__ VT, f16* __restrict__ Y3, int b, int h, int qt, int lane_in) {
    int lane = lane_in; asm volatile("" : "+v"(lane));
    const int q0 = qt * 32, hh = lane >> 5, ln = lane & 31;
    const size_t rowq = (size_t)(b * SEQ + q0 + ln) * NA;
    f16x8 qf[4];
#pragma unroll
    for (int s = 0; s < 4; ++s) qf[s] = *(const f16x8*)(P16 + rowq + C_SQ + h * 64 + 16 * s + 8 * hh);
    f32x16 o0, o1;
#pragma unroll
    for (int r = 0; r < 16; ++r) { o0[r] = 0.f; o1[r] = 0.f; }
    float carry = 1.0f;
    const f16* vt = VT + ((size_t)(b * 8 + h) * 64) * SEQ;
    const int query = q0 + ln;
    for (int kt = qt; kt >= 0; --kt) {
        const int k0 = kt * 32;
        const f16* kp = P16 + (size_t)(b * SEQ + k0 + ln) * NA + C_SK + h * 64 + 8 * hh;
        f32x16 z;
#pragma unroll
        for (int r = 0; r < 16; ++r) z[r] = 0.f;
        { f16x8 kfa[4];
#pragma unroll
          for (int s = 0; s < 4; ++s) kfa[s] = *(const f16x8*)(kp + 16 * s);
          PIN4(kfa);
#pragma unroll
          for (int s = 0; s < 4; ++s) z = __builtin_amdgcn_mfma_f32_32x32x16_f16(kfa[s], qf[s], z, 0, 0, 0); }
        float av[16], p[4], pp[4];
#define SB_GROUPS(MASKED) _Pragma("unroll") for (int a = 0; a < 4; ++a) { float st[4], be[4]; \
            _Pragma("unroll") for (int c = 0; c < 4; ++c) { const float u = __builtin_amdgcn_exp2f(z[4 * a + c] * 0.18033688011112042f); const float s_ = fast_rcp(1.0f + u); const float b_ = 1.0f - s_; \
                if (MASKED) { const bool valid = k0 + c + 8 * a + 4 * hh < query; st[c] = valid ? s_ : 1.0f; be[c] = valid ? b_ : 0.0f; } else { st[c] = s_; be[c] = b_; } } \
            const float s2 = st[3], s1 = s2 * st[2], s0 = s1 * st[1]; \
            p[a] = s0 * st[0]; \
            av[4 * a + 3] = be[3]; av[4 * a + 2] = be[2] * s2; av[4 * a + 1] = be[1] * s1; av[4 * a + 0] = be[0] * s0; }
        if (kt == qt) { SB_GROUPS(true) } else { SB_GROUPS(false) }
#undef SB_GROUPS
#pragma unroll
        for (int a = 0; a < 4; ++a) pp[a] = shx(p[a], 32, lane);
        const float T0 = p[0] * pp[0], T1 = p[1] * pp[1], T2 = p[2] * pp[2], T3 = p[3] * pp[3];
        float grp[4];
        grp[3] = carry; grp[2] = carry * T3; grp[1] = grp[2] * T2; grp[0] = grp[1] * T1;
        const float ncarry = grp[0] * T0;
        if (hh == 0) {
#pragma unroll
            for (int a = 0; a < 4; ++a) grp[a] *= pp[a];
        }
        f16x8 bf0, bf1;
#pragma unroll
        for (int j = 0; j < 8; ++j) { bf0[j] = (f16)(av[j] * grp[j >> 2]); bf1[j] = (f16)(av[8 + j] * grp[2 + (j >> 2)]); }
        { f16x8 va[4];
#pragma unroll
          for (int dt = 0; dt < 2; ++dt) { const f16* vp = vt + (size_t)(32 * dt + ln) * SEQ + k0 + 4 * hh;
            { const f16x4 lo = *(const f16x4*)(vp), hi = *(const f16x4*)(vp + 8); va[2 * dt] = __builtin_shufflevector(lo, hi, 0, 1, 2, 3, 4, 5, 6, 7); }
            { const f16x4 lo = *(const f16x4*)(vp + 16), hi = *(const f16x4*)(vp + 24); va[2 * dt + 1] = __builtin_shufflevector(lo, hi, 0, 1, 2, 3, 4, 5, 6, 7); } }
          PIN4(va);
          o0 = __builtin_amdgcn_mfma_f32_32x32x16_f16(va[0], bf0, o0, 0, 0, 0); o0 = __builtin_amdgcn_mfma_f32_32x32x16_f16(va[1], bf1, o0, 0, 0, 0);
          o1 = __builtin_amdgcn_mfma_f32_32x32x16_f16(va[2], bf0, o1, 0, 0, 0); o1 = __builtin_amdgcn_mfma_f32_32x32x16_f16(va[3], bf1, o1, 0, 0, 0); }
        carry = ncarry;
        if (__all(carry < 1e-30f)) break;
    }
    const size_t rowt = (size_t)(b * SEQ + query);
    f16x4 zgv[8];
#pragma unroll
    for (int i = 0; i < 8; ++i) zgv[i] = *(const f16x4*)(P16 + rowt * NA + C_SZ + h * 64 + 32 * (i >> 2) + 8 * (i & 3) + 4 * hh);
#pragma unroll
    for (int dt = 0; dt < 2; ++dt)
#pragma unroll
        for (int a = 0; a < 4; ++a) { const int dim = 32 * dt + 8 * a + 4 * hh;
            f16x4 y;
#pragma unroll
            for (int c = 0; c < 4; ++c) { const float ov = dt == 0 ? o0[4 * a + c] : o1[4 * a + c]; y[c] = (f16)(ov * siluf_((float)zgv[4 * dt + a][c])); }
            *(f16x4*)(Y3 + rowt * 1536 + 512 + h * 64 + dim) = y; }
}

__device__ __forceinline__ void transpose_slab(LAS unsigned char* lds, const f16* __restrict__ P16, int coff, int b, int s0, f16* __restrict__ dstT, int wv);

#ifdef TIMING
#define BSTAMP(k) do { if (blockIdx.x == 0 && TIDX(a.wv) == 0) { LAS unsigned long long* ts_ = (LAS unsigned long long*)(lds + LDS_BYTES - 512); const unsigned long long t_ = wall_clock64(); ts_[k] += t_ - ts_[16]; ts_[16] = t_; } } while (0)
#else
#define BSTAMP(k) do {} while (0)
#endif
__device__ __forceinline__ void phase_b_unit(const Args& a, LAS unsigned char* lds, int l, int b, int ck) {
    int tid = TIDX(a.wv); asm volatile("" : "+v"(tid));
    const int wave = __builtin_amdgcn_readfirstlane(tid >> 6), lane = tid & 63;
    unsigned char* ws = a.ws; LAUNDER_S(ws);
    const f16* __restrict__ P16 = (const f16*)(ws + WS_P16);
    const int s0 = ck * 64; const size_t tok0 = (size_t)b * SEQ + s0;
    const float* __restrict__ rope = (const float*)(ws + WS_ROPE);

    transpose_slab(lds, P16, C_SV, b, s0, (f16*)(ws + WS_VT), a.wv);
    transpose_slab(lds, P16, C_MV, b, s0, (f16*)(ws + WS_MLVT), a.wv);

    BSTAMP(18);
    { f16* __restrict__ KV = (f16*)(ws + WS_KV);
      const float w0 = a.kvn_w[l * 128 + 2 * lane], w1 = a.kvn_w[l * 128 + 2 * lane + 1];
      f16x2 xv[8]; float k1[8], k2[8], rc[8], rsn[8];
#pragma unroll
      for (int i = 0; i < 8; ++i) { const int s = wave * 8 + i; const f16* pr = P16 + (tok0 + s) * NA;
        xv[i] = *(const f16x2*)(pr + C_CKV + 2 * lane); k1[i] = (float)pr[C_KR + (lane & 7)]; k2[i] = (float)pr[C_KR + 8 + (lane & 7)];
        rc[i] = rope[(s0 + s) * 16 + (lane & 7)]; rsn[i] = rope[(s0 + s) * 16 + 8 + (lane & 7)]; }
      PIN8(xv); PIN8(k1); PIN8(k2); PIN8(rc); PIN8(rsn);
#pragma unroll
      for (int i = 0; i < 8; ++i) { const int s = wave * 8 + i; const size_t t = tok0 + s;
        const float x0 = (float)xv[i][0], x1 = (float)xv[i][1];
        float sq = x0 * x0 + x1 * x1;
#pragma unroll
        for (int o = 32; o >= 1; o >>= 1) sq += shx(sq, o, lane);
        const float rs = 1.0f / sqrtf(sq * (1.0f / 128.0f) + NORM_EPS);
        f16x2 o2; o2[0] = (f16)(x0 * rs * w0); o2[1] = (f16)(x1 * rs * w1);
        *(f16x2*)(KV + t * 160 + 2 * lane) = o2;
        if (lane < 8) { KV[t * 160 + 128 + lane] = (f16)(k1[i] * rc[i] - k2[i] * rsn[i]); KV[t * 160 + 136 + lane] = (f16)(k2[i] * rc[i] + k1[i] * rsn[i]); }
        else if (lane < 16) { f16x2 z; z[0] = (f16)0.f; z[1] = (f16)0.f; *(f16x2*)(KV + t * 160 + 144 + 2 * (lane - 8)) = z; }
      } }
    { f16* __restrict__ IQ = (f16*)(ws + WS_IQ); f16* __restrict__ IK = (f16*)(ws + WS_IK); float* __restrict__ IW = (float*)(ws + WS_IW);
      f16x8 vv[5], ov[5]; f32x4 rca[5], rcb[5], rsa[5], rsb[5];
#pragma unroll
      for (int i = 0; i < 5; ++i) { const int e = tid + 512 * i, s = e / 40, c0 = (e % 40) * 8; const f16* pr = P16 + (tok0 + s) * NA + C_IQ;
        vv[i] = *(const f16x8*)(pr + c0); ov[i] = *(const f16x8*)(pr + (c0 ^ 8));
        const float* rp = rope + (s0 + s) * 16; rca[i] = *(const f32x4*)rp; rcb[i] = *(const f32x4*)(rp + 4); rsa[i] = *(const f32x4*)(rp + 8); rsb[i] = *(const f32x4*)(rp + 12); }
      asm volatile("" :: "v"(vv[0]), "v"(vv[1]), "v"(vv[2]), "v"(vv[3]), "v"(vv[4]), "v"(ov[0]), "v"(ov[1]), "v"(ov[2]), "v"(ov[3]), "v"(ov[4]));
      asm volatile("" :: "v"(rca[0]), "v"(rca[1]), "v"(rca[2]), "v"(rca[3]), "v"(rca[4]), "v"(rcb[0]), "v"(rcb[1]), "v"(rcb[2]), "v"(rcb[3]), "v"(rcb[4]));
      asm volatile("" :: "v"(rsa[0]), "v"(rsa[1]), "v"(rsa[2]), "v"(rsa[3]), "v"(rsa[4]), "v"(rsb[0]), "v"(rsb[1]), "v"(rsb[2]), "v"(rsb[3]), "v"(rsb[4]));
#pragma unroll
      for (int i = 0; i < 5; ++i) { const int e = tid + 512 * i, s = e / 40, c0 = (e % 40) * 8; const size_t t = tok0 + s; const int d0 = c0 & 63;
        f16x8 v = vv[i];
        if (d0 < 16) {
#pragma unroll
            for (int jj = 0; jj < 8; ++jj) { const float cs = jj < 4 ? rca[i][jj & 3] : rcb[i][jj & 3], sn = jj < 4 ? rsa[i][jj & 3] : rsb[i][jj & 3];
                v[jj] = (f16)(d0 == 0 ? (float)vv[i][jj] * cs - (float)ov[i][jj] * sn : (float)vv[i][jj] * cs + (float)ov[i][jj] * sn); } }
        if (c0 < 256) *(f16x8*)(IQ + t * 256 + c0) = v; else *(f16x8*)(IK + t * 64 + (c0 - 256)) = v; }
      if (tid < 256) { const int s = tid >> 2, h = tid & 3; IW[(tok0 + s) * 4 + h] = (float)P16[(tok0 + s) * NA + C_IW + h]; } }
    BSTAMP(19);
    { const int h = wave, fr = lane & 15, fq = lane >> 4; f16* __restrict__ QC = (f16*)(ws + WS_QC);
      const f16* Wk = (const f16*)(ws + WS_WUK) + ((size_t)(l * 8 + h) * 128) * 64;
      f16x8 af[4][2], wb0[8], wb1[8];
#pragma unroll
      for (int mt = 0; mt < 4; ++mt)
#pragma unroll
        for (int ks = 0; ks < 2; ++ks) af[mt][ks] = *(const f16x8*)(P16 + (tok0 + 16 * mt + fr) * NA + C_DQ + h * 64 + 16 + 32 * ks + 8 * fq);
#pragma unroll
      for (int rt = 0; rt < 8; ++rt) { wb0[rt] = *(const f16x8*)(Wk + (size_t)(16 * rt + fr) * 64 + 8 * fq); wb1[rt] = *(const f16x8*)(Wk + (size_t)(16 * rt + fr) * 64 + 32 + 8 * fq); }
      PIN8(&af[0][0]); PIN8(wb0); PIN8(wb1);
#pragma unroll
      for (int rt = 0; rt < 8; ++rt) {
        const f16x8 b0 = wb0[rt], b1 = wb1[rt];
#pragma unroll
        for (int mt = 0; mt < 4; ++mt) { f32x4 acc = (f32x4){0.f, 0.f, 0.f, 0.f};
            acc = __builtin_amdgcn_mfma_f32_16x16x32_f16(b0, af[mt][0], acc, 0, 0, 0); acc = __builtin_amdgcn_mfma_f32_16x16x32_f16(b1, af[mt][1], acc, 0, 0, 0);
            f16x4 o; o[0] = (f16)(acc[0] * 0.125f); o[1] = (f16)(acc[1] * 0.125f); o[2] = (f16)(acc[2] * 0.125f); o[3] = (f16)(acc[3] * 0.125f);
            *(f16x4*)(QC + ((tok0 + 16 * mt + fr) * 8 + h) * 160 + 16 * rt + 4 * fq) = o; }
      }
      { const size_t t = tok0 + lane; const f16* pr = P16 + t * NA + C_DQ + h * 64; f16* qo = QC + (t * 8 + h) * 160 + 128;
        const f16x8 x1 = *(const f16x8*)pr, x2 = *(const f16x8*)(pr + 8); f16x8 o1, o2, z;
#pragma unroll
        for (int j = 0; j < 8; ++j) { const float cs = rope[(s0 + lane) * 16 + j], sn = rope[(s0 + lane) * 16 + 8 + j];
            o1[j] = (f16)(((float)x1[j] * cs - (float)x2[j] * sn) * 0.125f); o2[j] = (f16)(((float)x2[j] * cs + (float)x1[j] * sn) * 0.125f); z[j] = (f16)0.f; }
        *(f16x8*)qo = o1; *(f16x8*)(qo + 8) = o2; *(f16x8*)(qo + 16) = z; *(f16x8*)(qo + 24) = z; } }

    BSTAMP(23);
    LAS float* wf = (LAS float*)(lds + 73728);
    if (wave < 4) { const int h = wave; const size_t t = tok0 + lane;
        const float iv = (float)P16[t * NA + C_MI + h] + a.i_bias[l * 4 + h];
        const float fv = (float)P16[t * NA + C_MF + h] + a.f_bias[l * 4 + h];
        float bcum = logsigmoidf_(fv);
#pragma unroll
        for (int o = 1; o < 64; o <<= 1) { const float u = shu(bcum, o, lane); if (lane >= o) bcum += u; }
        const float blast = shi(bcum, 63);
        const float lw = blast - bcum + iv; float ml = lw;
#pragma unroll
        for (int o = 32; o >= 1; o >>= 1) ml = fmaxf(ml, shx(ml, o, lane));
        f32x2 gg; gg[0] = bcum; gg[1] = iv - bcum; *(f32x2*)((float*)(ws + WS_GATE) + (t * 4 + h) * 2) = gg;
        wf[h * 64 + lane] = __expf(lw - ml);
        if (lane == 0) { f32x4 cs; cs[0] = blast; cs[1] = ml; cs[2] = 0.f; cs[3] = 0.f; *(f32x4*)((float*)(ws + WS_CHS) + ((size_t)(b * 4 + h) * 64 + ck) * 4) = cs; } }
    __syncthreads();
    constexpr int RST = 144;
    { const int cg = tid & 127, tg = tid >> 7;
      const float* cw = a.conv_w + (size_t)l * 4 * 1024 + 8 * cg;
      f32x4 w[4][2];
#pragma unroll
      for (int jj = 0; jj < 4; ++jj) { w[jj][0] = *(const f32x4*)(cw + jj * 1024); w[jj][1] = *(const f32x4*)(cw + jj * 1024 + 4); }
      const int sb = 16 * tg; f16x8 x[19];
#pragma unroll
      for (int i = 0; i < 19; ++i) { const int s = sb - 3 + i;
          if (s >= 0 || ck > 0) x[i] = *(const f16x8*)(P16 + (size_t)((long)tok0 + s) * NA + C_MQK + 8 * cg); else {
#pragma unroll
              for (int e = 0; e < 8; ++e) x[i][e] = (f16)0.f; } }
      f16* __restrict__ dstq = (cg < 64 ? (f16*)(ws + WS_MLQ) : (f16*)(ws + WS_MLK)) + 8 * (cg & 63);
      const float osc = cg < 64 ? 1.0f : 0.08838834764831845f; const int hrow = (cg & 63) >> 4;
      f16x8 kwa[8], kwb[8];
#pragma unroll
      for (int s = 0; s < 16; ++s) { f16x8 o; const float wfs = wf[hrow * 64 + sb + s];
#pragma unroll
          for (int e = 0; e < 8; ++e) { const float u = w[0][e >> 2][e & 3] * (float)x[s][e] + w[1][e >> 2][e & 3] * (float)x[s + 1][e] + w[2][e >> 2][e & 3] * (float)x[s + 2][e] + w[3][e >> 2][e & 3] * (float)x[s + 3][e];
              const float y = siluf_(u) * osc; o[e] = (f16)y; if (s < 8) kwa[e][s] = (f16)(y * wfs); else kwb[e][s - 8] = (f16)(y * wfs); }
          *(f16x8*)(dstq + (tok0 + sb + s) * 512) = o; }
      if (cg >= 64) {
#pragma unroll
          for (int e = 0; e < 8; ++e) { LAS unsigned char* rp = lds + (8 * (cg - 64) + e) * RST + sb * 2; *(LAS f16x8*)rp = kwa[e]; *(LAS f16x8*)(rp + 16) = kwb[e]; } } }
    __syncthreads();
    BSTAMP(25);
    { const int et = wave & 3, dt0 = (wave >> 2) * 2, ln = lane & 31, hh = lane >> 5;
      const f16* MVT = (const f16*)(ws + WS_MLVT); f16* DCT = (f16*)(ws + WS_DCT);
      f16x8 vfr[4][4];
#pragma unroll
      for (int h = 0; h < 4; ++h)
#pragma unroll
        for (int ks = 0; ks < 4; ++ks) vfr[h][ks] = *(const f16x8*)(MVT + ((size_t)(b * 512 + h * 128 + 32 * et + ln)) * SEQ + s0 + 8 * hh + 16 * ks);
      PIN8(&vfr[0][0]); PIN8(&vfr[2][0]);
#pragma unroll
      for (int h = 0; h < 4; ++h) {
        f32x16 acc0, acc1;
#pragma unroll
        for (int r = 0; r < 16; ++r) { acc0[r] = 0.f; acc1[r] = 0.f; }
#pragma unroll
        for (int ks = 0; ks < 4; ++ks) { const f16x8 af = vfr[h][ks];
            const f16x8 b0 = *(const LAS f16x8*)(lds + (h * 128 + 32 * dt0 + ln) * RST + (16 * ks + 8 * hh) * 2);
            const f16x8 b1 = *(const LAS f16x8*)(lds + (h * 128 + 32 * (dt0 + 1) + ln) * RST + (16 * ks + 8 * hh) * 2);
            acc0 = __builtin_amdgcn_mfma_f32_32x32x16_f16(b0, af, acc0, 0, 0, 0); acc1 = __builtin_amdgcn_mfma_f32_32x32x16_f16(b1, af, acc1, 0, 0, 0); }
        f16* dst = DCT + ((size_t)(b * 4 + h) * 64 + ck) * 16384 + (size_t)(et * 8 * 64 + ln) * 8 + 4 * hh; asm volatile("" : "+v"(dst));
#pragma unroll
        for (int aa = 0; aa < 4; ++aa) { f16x4 o0, o1;
#pragma unroll
            for (int c = 0; c < 4; ++c) { o0[c] = (f16)acc0[4 * aa + c]; o1[c] = (f16)acc1[4 * aa + c]; }
            *(f16x4*)(dst + ((2 * dt0 + (aa >> 1)) * 64 + (aa & 1) * 32) * 8) = o0; *(f16x4*)(dst + ((2 * (dt0 + 1) + (aa >> 1)) * 64 + (aa & 1) * 32) * 8) = o1; }
      }
      { float sn = 0.f;
#pragma unroll
        for (int i = 0; i < 8; ++i) { const f16x8 v = *(const LAS f16x8*)(lds + tid * RST + i * 16);
#pragma unroll
            for (int j = 0; j < 8; ++j) sn += (float)v[j]; }
        ((float*)(ws + WS_DN))[((size_t)(b * 4 + (tid >> 7)) * 64 + ck) * 128 + (tid & 127)] = sn; } }
    __syncthreads();
}

__device__ __forceinline__ void mlstm_scan(const Args& a, LAS unsigned char* lds) {
    int tid = TIDX(a.wv); asm volatile("" : "+v"(tid));
    unsigned char* ws = a.ws; LAUNDER_S(ws);
    LAS float* tabA = (LAS float*)lds; LAS float* tabC = tabA + 64; LAS float* tabB = tabA + 128; LAS float* tabM = tabA + 192;
    for (int v = blockIdx.x; v < 256; v += gridDim.x) {
        const int bh = v >> 4, part = v & 15;
        float* chs = (float*)(ws + WS_CHS) + (size_t)bh * 64 * 4;
        if (tid < 64) { const f32x4 c = *(const f32x4*)(chs + tid * 4); tabB[tid] = c[0]; tabM[tid] = c[1]; }
        __syncthreads();
        if (tid == 0) { float m = 0.f;
            for (int k = 0; k < 64; ++k) { const float bl = tabB[k], ml = tabM[k]; const float mn = fmaxf(bl + m, ml);
                tabA[k] = __expf(bl + m - mn); tabC[k] = __expf(ml - mn); tabB[k] = m; m = mn; } }
        __syncthreads();
        if (part == 0 && tid < 64) chs[tid * 4 + 2] = tabB[tid];
        f16x2* p = (f16x2*)((f16*)(ws + WS_DCT) + (size_t)bh * 64 * 16384 + part * 1024 + tid * 2);
        float c0 = 0.f, c1 = 0.f;
        for (int k0 = 0; k0 < 64; k0 += 32) { f16x2 d[32];
#pragma unroll
            for (int j = 0; j < 32; ++j) d[j] = p[(size_t)(k0 + j) * 8192];
#pragma unroll
            for (int j = 0; j < 32; ++j) { f16x2 o; o[0] = (f16)c0; o[1] = (f16)c1; p[(size_t)(k0 + j) * 8192] = o;
                const float aa = tabA[k0 + j], cc = tabC[k0 + j]; c0 = aa * c0 + cc * (float)d[j][0]; c1 = aa * c1 + cc * (float)d[j][1]; } }
        if (part == 0 && tid < 128) { float* pn = (float*)(ws + WS_DN) + (size_t)bh * 64 * 128 + tid; float n = 0.f;
            for (int k0 = 0; k0 < 64; k0 += 32) { float d[32];
#pragma unroll
                for (int j = 0; j < 32; ++j) d[j] = pn[(k0 + j) * 128];
#pragma unroll
                for (int j = 0; j < 32; ++j) { pn[(k0 + j) * 128] = n; n = tabA[k0 + j] * n + tabC[k0 + j] * d[j]; } } }
        __syncthreads();
    }
}

__device__ __forceinline__ void mlstm_out_unit(const Args& a, LAS unsigned char* wlds  , LAS unsigned char* tb  , int l, int b, int ck, int h, int th, int lane_in) {
    int lane = lane_in; asm volatile("" : "+v"(lane));
    unsigned char* ws = a.ws; LAUNDER_S(ws);
    const int ln = lane & 31, hh = lane >> 5, s0 = ck * 64; const size_t tok0 = (size_t)b * SEQ + s0;
    const int bh = b * 4 + h;
    const f16* __restrict__ MLQ = (const f16*)(ws + WS_MLQ); const f16* __restrict__ MLK = (const f16*)(ws + WS_MLK);
    const f16* __restrict__ MVT = (const f16*)(ws + WS_MLVT) + ((size_t)(b * 512 + h * 128)) * SEQ + s0;
    const f16* __restrict__ CT = (const f16*)(ws + WS_DCT) + ((size_t)bh * 64 + ck) * 16384;
    const float* __restrict__ NS = (const float*)(ws + WS_DN) + ((size_t)bh * 64 + ck) * 128;
    const float mk = ((const float*)(ws + WS_CHS))[((size_t)bh * 64 + ck) * 4 + 2];
    LAS float* gtab = (LAS float*)wlds;
    LAS float* ntab = gtab + 64;
    const f32x2 bg = *(const f32x2*)((const float*)(ws + WS_GATE) + ((tok0 + lane) * 4 + h) * 2);
    const float ns0 = NS[lane], ns1 = NS[64 + lane];
    const int tl = 32 * th + ln;
#define ML5_LDC(dst, et) do { _Pragma("unroll") for (int ks = 0; ks < 8; ++ks) dst[ks] = *(const f16x8*)(CT + (size_t)((((et) * 8 + ks) * 64 + lane) * 8)); } while (0)
#define ML5_SB __builtin_amdgcn_sched_barrier(0)
    f16x8 qf[8];
#pragma unroll
    for (int ks = 0; ks < 8; ++ks) qf[ks] = *(const f16x8*)(MLQ + (tok0 + tl) * 512 + h * 128 + 16 * ks + 8 * hh);
    ML5_SB;
    float pmx = bg[1];
#pragma unroll
    for (int o = 1; o < 64; o <<= 1) { const float u = shu(pmx, o, lane); if (lane >= o) pmx = fmaxf(pmx, u); }
    gtab[lane] = bg[1]; ntab[lane] = ns0; ntab[64 + lane] = ns1;
    const float bt = shi(bg[0], tl), Mt = fmaxf(shi(pmx, tl), mk);
    const float w_inter = __expf(mk - Mt), m_row = bt + Mt;
    float qn = 0.f;
    PIN8(qf);
#pragma unroll
    for (int ks = 0; ks < 8; ++ks) {
#pragma unroll
        for (int j = 0; j < 8; ++j) qn += (float)qf[ks][j] * ntab[16 * ks + 8 * hh + j]; }
    qn += shx(qn, 32, lane);
    f32x16 acc[4];
#pragma unroll
    for (int et = 0; et < 4; ++et)
#pragma unroll
        for (int r = 0; r < 16; ++r) acc[et][r] = 0.f;
#pragma unroll
    for (int et = 0; et < 4; ++et) { f16x8 cfa[8];
        ML5_LDC(cfa, et);
        PIN8(cfa);
#pragma unroll
        for (int ks = 0; ks < 8; ++ks) acc[et] = __builtin_amdgcn_mfma_f32_32x32x16_f16(cfa[ks], qf[ks], acc[et], 0, 0, 0); }
#pragma unroll
    for (int et = 0; et < 4; ++et)
#pragma unroll
        for (int r = 0; r < 16; ++r) acc[et][r] *= w_inter;
    float den = 0.f;
    for (int st = 0; st <= th; ++st) {
        f32x16 z;
#pragma unroll
        for (int r = 0; r < 16; ++r) z[r] = 0.f;
        { f16x8 kfa[8];
#pragma unroll
          for (int ks = 0; ks < 8; ++ks) kfa[ks] = *(const f16x8*)(MLK + (tok0 + 32 * st + ln) * 512 + h * 128 + 16 * ks + 8 * hh);
          PIN8(kfa);
#pragma unroll
          for (int ks = 0; ks < 8; ++ks) z = __builtin_amdgcn_mfma_f32_32x32x16_f16(kfa[ks], qf[ks], z, 0, 0, 0); }
        f16x8 bf0, bf1;
#pragma unroll
        for (int aa = 0; aa < 4; ++aa) { const f32x4 gv = *(const LAS f32x4*)(gtab + 32 * st + 8 * aa + 4 * hh);
#pragma unroll
            for (int c = 0; c < 4; ++c) { const int s = 32 * st + 8 * aa + 4 * hh + c; const float w = s <= tl ? __expf(gv[c] - Mt) : 0.f; const float sw = z[4 * aa + c] * w; den += sw;
                if (aa < 2) bf0[4 * aa + c] = (f16)sw; else bf1[4 * (aa - 2) + c] = (f16)sw; } }
        { f16x8 va[8];
#pragma unroll
          for (int et = 0; et < 4; ++et) { const f16* vp = MVT + (size_t)(32 * et + ln) * SEQ + 32 * st + 4 * hh;
            { const f16x4 lo = *(const f16x4*)(vp), hi = *(const f16x4*)(vp + 8); va[2 * et] = __builtin_shufflevector(lo, hi, 0, 1, 2, 3, 4, 5, 6, 7); }
            { const f16x4 lo = *(const f16x4*)(vp + 16), hi = *(const f16x4*)(vp + 24); va[2 * et + 1] = __builtin_shufflevector(lo, hi, 0, 1, 2, 3, 4, 5, 6, 7); } }
          PIN8(va);
#pragma unroll
          for (int et = 0; et < 4; ++et) { acc[et] = __builtin_amdgcn_mfma_f32_32x32x16_f16(va[2 * et], bf0, acc[et], 0, 0, 0); acc[et] = __builtin_amdgcn_mfma_f32_32x32x16_f16(va[2 * et + 1], bf1, acc[et], 0, 0, 0); } }
    }
    const f16* __restrict__ P16 = (const f16*)(ws + WS_P16); f16* Y3 = (f16*)(ws + WS_Y3);
    constexpr int TBS = 272;
    const int er = lane >> 4, ec = lane & 15;
    const f16* orow = P16 + (tok0 + 32 * th + er) * NA + h * 128 + 8 * ec;
    f16x8 ogv[8], zgv[8];
    ML5_SB;
#pragma unroll
    for (int i = 0; i < 8; ++i) { ogv[i] = *(const f16x8*)(orow + (size_t)(4 * i) * NA + C_MO); zgv[i] = *(const f16x8*)(orow + (size_t)(4 * i) * NA + C_MZ); }
    ML5_SB;
    den += shx(den, 32, lane);
    den += w_inter * qn;
    const float inv = 1.0f / fmaxf(fabsf(den), __expf(-m_row));
    float sm = 0.f;
#pragma unroll
    for (int et = 0; et < 4; ++et)
#pragma unroll
        for (int r = 0; r < 16; ++r) { acc[et][r] *= inv; sm += acc[et][r]; }
    sm += shx(sm, 32, lane);
    const float mu = sm * (1.0f / 128.0f); float vs = 0.f;
#pragma unroll
    for (int et = 0; et < 4; ++et)
#pragma unroll
        for (int r = 0; r < 16; ++r) { const float d = acc[et][r] - mu; vs += d * d; }
    vs += shx(vs, 32, lane);
    const float rstd = 1.0f / sqrtf(vs * (1.0f / 128.0f) + NORM_EPS);
    PIN8(ogv); PIN8(zgv);
#pragma unroll
    for (int i = 0; i < 8; ++i) { f16x8 g;
#pragma unroll
        for (int j = 0; j < 8; ++j) g[j] = (f16)(sigmoidf_((float)ogv[i][j]) * siluf_((float)zgv[i][j]));
        *(LAS f16x8*)(tb + (4 * i + er) * TBS + ec * 16) = g; }
    const float* __restrict__ nwp = a.mln_w + l * 512 + h * 128 + 4 * hh;
#pragma unroll
    for (int et = 0; et < 4; ++et)
#pragma unroll
        for (int aa = 0; aa < 4; ++aa) { LAS f16x4* gp = (LAS f16x4*)(tb + ln * TBS + (32 * et + 8 * aa + 4 * hh) * 2); const f16x4 gq = *gp; const f32x4 nw = *(const f32x4*)(nwp + 32 * et + 8 * aa);
            f16x4 y;
#pragma unroll
            for (int c = 0; c < 4; ++c) y[c] = (f16)((acc[et][4 * aa + c] - mu) * rstd * nw[c] * (float)gq[c]);
            *gp = y; }
    f16* yrow = Y3 + (tok0 + 32 * th + er) * 1536 + 1024 + h * 128 + 8 * ec;
#pragma unroll
    for (int i = 0; i < 8; ++i) { const f16x8 v = *(const LAS f16x8*)(tb + (4 * i + er) * TBS + ec * 16); *(f16x8*)(yrow + (size_t)(4 * i) * 1536) = v; }
#undef ML5_LDC
#undef ML5_SB
}

constexpr int DL_HIST = 0;
constexpr int DL_RS = 304;
constexpr int DL_STAGE_W = 32 * DL_RS;
constexpr int DL_SELB = 8 * DL_STAGE_W;
constexpr int DL_EQB  = DL_SELB + 8192;
constexpr int DL_LIST = DL_EQB + 8192;
constexpr int DL_QST  = DL_LIST + 8192;
constexpr int DL_OL   = DL_QST + 1024;
constexpr int DL_END  = DL_OL + 32768;
static_assert(DL_END <= LDS_BYTES - 16, "DSA LDS map");


__device__ __forceinline__ unsigned okey(unsigned bits) { const unsigned m = (unsigned)((int)bits >> 31) | 0x80000000u; return bits == 0xFF800000u ? 0u : (bits ^ m); }
__device__ __forceinline__ unsigned fdig(unsigned bits) { const f16 hf = (f16)__uint_as_float(bits); const unsigned h = (unsigned)__builtin_bit_cast(unsigned short, hf);
    const unsigned m = (unsigned)((int)(h << 16) >> 31) | 0x8000u; return ((h ^ m) & 0xFFFFu) >> 5; }
__device__ __forceinline__ unsigned dpp_scan_add(unsigned x) {
    x += (unsigned)__builtin_amdgcn_update_dpp(0, (int)x, 0x111, 0xf, 0xf, false);
    x += (unsigned)__builtin_amdgcn_update_dpp(0, (int)x, 0x112, 0xf, 0xf, false);
    x += (unsigned)__builtin_amdgcn_update_dpp(0, (int)x, 0x114, 0xf, 0xf, false);
    x += (unsigned)__builtin_amdgcn_update_dpp(0, (int)x, 0x118, 0xf, 0xf, false);
    x += (unsigned)__builtin_amdgcn_update_dpp(0, (int)x, 0x142, 0xa, 0xf, false);
    x += (unsigned)__builtin_amdgcn_update_dpp(0, (int)x, 0x143, 0xc, 0xf, false);
    return x;
}
typedef short s16x2_t __attribute__((ext_vector_type(2)));
__device__ __forceinline__ void fdig2(unsigned bits0, unsigned bits1, unsigned& d0, unsigned& d1) {
    f16x2 h2; h2[0] = (f16)__uint_as_float(bits0); h2[1] = (f16)__uint_as_float(bits1);
    const s16x2_t sg = __builtin_bit_cast(s16x2_t, h2) >> 15;
    const unsigned k = __builtin_bit_cast(unsigned, h2) ^ (__builtin_bit_cast(unsigned, sg) | 0x80008000u);
    d0 = (k >> 5) & 0x7FFu; d1 = k >> 21;
}
#ifdef TIMING
#define DSTAMP(k) do { if (blockIdx.x == 0 && TIDX(a.wv) == 0) { LAS unsigned long long* ts_ = (LAS unsigned long long*)(lds + LDS_BYTES - 512); const unsigned long long t_ = wall_clock64(); ts_[k] += t_ - ts_[16]; ts_[16] = t_; } } while (0)
#else
#define DSTAMP(k) do {} while (0)
#endif
__device__ __forceinline__ void dsa_unit(const Args& a, LAS unsigned char* lds, int l, int b, int j) {
    int tid = TIDX(a.wv); asm volatile("" : "+v"(tid));
    const int wave = __builtin_amdgcn_readfirstlane(tid >> 6), lane = tid & 63, fr = lane & 15, fq = lane >> 4;
    unsigned char* ws = a.ws; LAUNDER_S(ws);
    const int t0 = 16 * j; const size_t tokb = (size_t)b * SEQ;
    const f16* __restrict__ IQ = (const f16*)(ws + WS_IQ); const f16* __restrict__ IK = (const f16*)(ws + WS_IK); const float* __restrict__ IW = (const float*)(ws + WS_IW);
    LAS unsigned* hist = (LAS unsigned*)(lds + DL_HIST); LAS unsigned* selb = (LAS unsigned*)(lds + DL_SELB); LAS unsigned* eqb = (LAS unsigned*)(lds + DL_EQB);
    LAS unsigned short* list = (LAS unsigned short*)(lds + DL_LIST); LAS unsigned* qst = (LAS unsigned*)(lds + DL_QST); LAS unsigned* nselp = qst + 64;

    if (tid < 16) { const int t = t0 + tid; const unsigned need = (unsigned)(t + 1 < 256 ? t + 1 : 256); qst[tid * 4 + 0] = 0u; qst[tid * 4 + 1] = 0u; qst[tid * 4 + 2] = need; qst[tid * 4 + 3] = 0u; nselp[tid] = need; }
    for (int i = tid; i < 4096; i += NTHREADS) selb[i] = 0u;

    u32x4 sk[32];
    {
        f16x8 iqf[4][2]; float iw[4];
#pragma unroll
        for (int h = 0; h < 4; ++h) { iw[h] = IW[(tokb + t0 + fr) * 4 + h];
#pragma unroll
            for (int ks = 0; ks < 2; ++ks) iqf[h][ks] = *(const f16x8*)(IQ + (tokb + t0 + fr) * 256 + h * 64 + 32 * ks + 8 * fq); }
        const int ntm0 = (j >= wave ? ((j - wave) >> 3) + 1 : 0) + (int)opaque0();
        const f16* kbase = IK + (tokb + 16 * wave + fr) * 64 + 8 * fq;
#pragma unroll
        for (int g8 = 0; g8 < 4; ++g8) {
            if (8 * g8 < ntm0) {
                f16x8 ka[8][2];
#pragma unroll
                for (int ii = 0; ii < 8; ++ii) { const f16* kp = kbase + (size_t)(8 * g8 + ii) * 128 * 64; ka[ii][0] = *(const f16x8*)kp; ka[ii][1] = *(const f16x8*)(kp + 32); }
#pragma unroll
                for (int ii = 0; ii < 8; ++ii) { const int i = 8 * g8 + ii, kt = wave + 8 * i;
                    f32x4 sc = (f32x4){0.f, 0.f, 0.f, 0.f};
#pragma unroll
                    for (int h = 0; h < 4; ++h) { f32x4 c = (f32x4){0.f, 0.f, 0.f, 0.f};
                        c = __builtin_amdgcn_mfma_f32_16x16x32_f16(ka[ii][0], iqf[h][0], c, 0, 0, 0); c = __builtin_amdgcn_mfma_f32_16x16x32_f16(ka[ii][1], iqf[h][1], c, 0, 0, 0);
#pragma unroll
                        for (int r = 0; r < 4; ++r) { const float cf = c[r]; const int cb = __float_as_int(cf); const float rl = __int_as_float(cb > 0 ? cb : 0); sc[r] += iw[h] * rl; } }
#pragma unroll
                    for (int r = 0; r < 4; ++r) { const int kidx = 16 * kt + 4 * fq + r; const float s = sc[r] + 0.0f;
                        sk[i][r] = kidx <= t0 + fr ? __float_as_uint(s) : 0xFF800000u; } }
            } else {
#pragma unroll
                for (int ii = 0; ii < 8; ++ii) sk[8 * g8 + ii] = (u32x4){0xFF800000u, 0xFF800000u, 0xFF800000u, 0xFF800000u};
            }
        }
    }
    DSTAMP(12);
    LAS unsigned* fst = qst + 96;
    LAS unsigned* cst = qst + 160;
    LAS u32x2* cand = (LAS u32x2*)(lds + DL_HIST);
    const int ntm = (j >= wave ? ((j - wave) >> 3) + 1 : 0);
    { unsigned zz = 0u; asm volatile("" : "+v"(zz));
#pragma unroll
      for (int i = 0; i < 8; ++i) *(LAS u32x4*)(lds + DL_HIST + (tid + NTHREADS * i) * 16) = (u32x4){zz, zz, zz, zz}; }
    if (tid < 17) cst[tid] = 0u;
    __syncthreads();
    { unsigned oz = 0u; asm volatile("" : "+v"(oz)); const int ntm_ = ntm + (int)opaque0();
#pragma unroll
      for (int i = 0; i < 32; ++i) { if (i < ntm_) {
#pragma unroll
          for (int r2 = 0; r2 < 2; ++r2) { unsigned dd[2]; fdig2(sk[i][2 * r2] ^ oz, sk[i][2 * r2 + 1] ^ oz, dd[0], dd[1]);
#pragma unroll
              for (int e = 0; e < 2; ++e) { const unsigned d = dd[e];
                  __hip_atomic_fetch_add(hist + fr * 1024 + (d >> 1), (d & 1u) ? 65536u : 1u, __ATOMIC_RELAXED, __HIP_MEMORY_SCOPE_WORKGROUP); } } } } }
    __syncthreads();
    DSTAMP(20);
    {
        const int base = 2048 - (lane + 1) * 32;
        unsigned need[2], cw[2][16], sum[2], incl[2];
#pragma unroll
        for (int qq = 0; qq < 2; ++qq) { const int q = 2 * wave + qq; need[qq] = qst[q * 4 + 2]; sum[qq] = 0u;
#pragma unroll
            for (int i = 0; i < 16; ++i) cw[qq][i] = hist[q * 1024 + (base >> 1) + i]; }
#pragma unroll
        for (int qq = 0; qq < 2; ++qq) {
#pragma unroll
            for (int i = 0; i < 16; ++i) sum[qq] += (cw[qq][i] & 0xFFFFu) + (cw[qq][i] >> 16);
            incl[qq] = sum[qq]; }
        incl[0] = dpp_scan_add(incl[0]); incl[1] = dpp_scan_add(incl[1]);
        const LAS unsigned short* hist16 = (const LAS unsigned short*)hist;
#pragma unroll
        for (int qq = 0; qq < 2; ++qq) { const int q = 2 * wave + qq;
            const unsigned long long bal = __ballot(incl[qq] >= need[qq]); const int Lc = bal ? (int)__builtin_ctzll(bal) : 63;
            const unsigned ab0 = shi(incl[qq] - sum[qq], Lc);
            const int top = 2048 - Lc * 32 - 1;
            const unsigned c = lane < 32 ? (unsigned)hist16[q * 2048 + top - lane] : 0u;
            const unsigned p = dpp_scan_add(c);
            const unsigned long long bf = __ballot(lane < 32 && ab0 + p >= need[qq]);
            const int f = bf ? (int)__builtin_ctzll(bf) : 31;
            const unsigned pf = shi(p, f), cf = shi(c, f);
            const unsigned ds_ = bf ? (unsigned)(top - f) : 0u, ce_ = bf ? cf : 0u, ab_ = bf ? ab0 + pf - cf : ab0 + pf;
            if (lane == 0) { const unsigned nn = need[qq] - ab_; fst[q * 4 + 0] = ds_; fst[q * 4 + 1] = nn; fst[q * 4 + 2] = (ce_ == nn) ? 1u : 0u; } }
    }
    __syncthreads();
    DSTAMP(21);
    { const unsigned ds = fst[fr * 4 + 0], ta = fst[fr * 4 + 2];
      unsigned oz = 0u; asm volatile("" : "+v"(oz)); const int ntm_ = ntm + (int)opaque0();
#pragma unroll
      for (int i = 0; i < 32; ++i) { if (i < ntm_) {
          unsigned nsel = 0u, ncand = 0u;
#pragma unroll
          for (int r2 = 0; r2 < 2; ++r2) { unsigned dd[2]; fdig2(sk[i][2 * r2] ^ oz, sk[i][2 * r2 + 1] ^ oz, dd[0], dd[1]);
#pragma unroll
              for (int e = 0; e < 2; ++e) { const int r = 2 * r2 + e; const unsigned d = dd[e]; const bool gt = d > ds, eq = d == ds;
                  nsel |= ((gt || (eq && ta)) ? 1u : 0u) << r; ncand |= ((eq && !ta) ? 1u : 0u) << r; } }
          const unsigned kb = (unsigned)(16 * (wave + 8 * i) + 4 * fq);
          if (nsel) __hip_atomic_fetch_or(selb + fr * 128 + (kb >> 5), nsel << (kb & 31u), __ATOMIC_RELAXED, __HIP_MEMORY_SCOPE_WORKGROUP);
          if (ncand) {
#pragma unroll
              for (int r = 0; r < 4; ++r) { if ((ncand >> r) & 1u) { const unsigned slot = __hip_atomic_fetch_add(cst + fr, 1u, __ATOMIC_RELAXED, __HIP_MEMORY_SCOPE_WORKGROUP);
                  if (slot < 256u) { u32x2 e; e.x = okey(sk[i][r] ^ oz); e.y = kb + r; cand[fr * 256 + slot] = e; } else cst[16] = 1u; } } } } } }
    __syncthreads();
    DSTAMP(22);
    if (cst[16] == 0u) {
        for (int qq = 0; qq < 2; ++qq) { const int q = 2 * wave + qq; const unsigned n = cst[q], want = fst[q * 4 + 1];
            if (fst[q * 4 + 2] == 0u && n > 0u) {
                unsigned long long cmine[4]; unsigned rk[4];
#pragma unroll
                for (int c = 0; c < 4; ++c) { const unsigned ci = (unsigned)(lane + 64 * c); const u32x2 e = cand[q * 256 + (ci < n ? ci : 0u)];
                    cmine[c] = ci < n ? (((unsigned long long)e.x << 16) | (unsigned long long)(0xFFFFu - e.y)) : 0ull; rk[c] = 0u; }
#define DR_RANK(NC) do { _Pragma("unroll") for (int cb = 0; cb < (NC); ++cb) { const int nb_ = (int)n - 64 * cb < 64 ? (int)n - 64 * cb : 64; \
                    for (int jx = 0; jx < nb_; ++jx) { \
                        const unsigned lo = (unsigned)__builtin_amdgcn_readlane((int)(unsigned)cmine[cb], jx), hi = (unsigned)__builtin_amdgcn_readlane((int)(unsigned)(cmine[cb] >> 32), jx); \
                        const unsigned long long cj = ((unsigned long long)hi << 32) | lo; \
                        _Pragma("unroll") for (int c = 0; c < (NC); ++c) rk[c] += cj > cmine[c] ? 1u : 0u; } } } while (0)
                if (n <= 64u) DR_RANK(1); else if (n <= 128u) DR_RANK(2); else DR_RANK(4);
#undef DR_RANK
#pragma unroll
                for (int c = 0; c < 4; ++c) { const unsigned ci = (unsigned)(lane + 64 * c);
                    if (ci < n && rk[c] < want) { const unsigned kidx = 0xFFFFu - (unsigned)(cmine[c] & 0xFFFFull);
                        __hip_atomic_fetch_or(selb + q * 128 + (kidx >> 5), 1u << (kidx & 31u), __ATOMIC_RELAXED, __HIP_MEMORY_SCOPE_WORKGROUP); } }
            }
            if (lane == 0) qst[q * 4 + 3] = 1u;
        }
    } else {
        for (int i = tid; i < 4096; i += NTHREADS) selb[i] = 0u;
        __syncthreads();
        for (int lvl = 0; lvl < 3; ++lvl) {
            const int shift = lvl == 0 ? 21 : (lvl == 1 ? 10 : 0); const unsigned dmask = lvl == 2 ? 0x3FFu : 0x7FFu; const int nbins = lvl == 2 ? 1024 : 2048;
            { u32x4* hz = (u32x4*)0; (void)hz;
#pragma unroll
              for (int i = 0; i < 8; ++i) { unsigned zz = 0u; asm volatile("" : "+v"(zz)); *(LAS u32x4*)(lds + DL_HIST + (tid + NTHREADS * i) * 16) = (u32x4){zz, zz, zz, zz}; } }
            __syncthreads();
            { const unsigned mask = qst[fr * 4 + 0], val = qst[fr * 4 + 1], done = qst[fr * 4 + 3];
              unsigned oz = 0u; asm volatile("" : "+v"(oz));
              const int ntm = (j >= wave ? ((j - wave) >> 3) + 1 : 0) + (int)opaque0();
              if (!done) {
#pragma unroll
                for (int i = 0; i < 32; ++i) { if (i < ntm) {
#pragma unroll
                    for (int r = 0; r < 4; ++r) { const unsigned uk = okey(sk[i][r] ^ oz);
                        if (uk != 0u && (uk & mask) == val) { const unsigned d = (uk >> shift) & dmask;
                            __hip_atomic_fetch_add(hist + fr * 1024 + (d >> 1), (d & 1u) ? 65536u : 1u, __ATOMIC_RELAXED, __HIP_MEMORY_SCOPE_WORKGROUP); } } } }
              } }
            __syncthreads();
            for (int qq = 0; qq < 2; ++qq) { const int q = 2 * wave + qq;
                const unsigned mask = qst[q * 4 + 0], val = qst[q * 4 + 1], need = qst[q * 4 + 2], done = qst[q * 4 + 3];
                if (done) continue;
                const int nb = nbins >> 6, base = nbins - (lane + 1) * nb;
                unsigned cw[16]; unsigned s = 0;
#pragma unroll
                for (int i = 0; i < 16; ++i) { cw[i] = (i < (nb >> 1)) ? hist[q * 1024 + (base >> 1) + i] : 0u; s += (cw[i] & 0xFFFFu) + (cw[i] >> 16); }
                unsigned incl = s;
#pragma unroll
                for (int o = 1; o < 64; o <<= 1) { const unsigned u = shu(incl, o, lane); if (lane >= o) incl += u; }
                const unsigned long long bal = __ballot(incl >= need);
                const int Lc = bal ? (int)__builtin_ctzll(bal) : 63;
                unsigned dstar = 0, above = incl - s, ceq = 0; bool found = false;
#pragma unroll
                for (int i = 15; i >= 0; --i) {
#pragma unroll
                    for (int hf = 1; hf >= 0; --hf) { const unsigned c = hf ? (cw[i] >> 16) : (cw[i] & 0xFFFFu);
                        if (i < (nb >> 1) && !found) { if (above + c >= need) { found = true; dstar = (unsigned)(base + 2 * i + hf); ceq = c; } else above += c; } } }
                dstar = shi(dstar, Lc); above = shi(above, Lc); ceq = shi(ceq, Lc);
                if (lane == 0) { const unsigned nn = need - above;
                    qst[q * 4 + 0] = mask | (dmask << shift); qst[q * 4 + 1] = val | (dstar << shift); qst[q * 4 + 2] = nn; qst[q * 4 + 3] = (ceq == nn) ? 1u : 0u; }
            }
            __syncthreads();
        }
        { const unsigned mask = qst[fr * 4 + 0], val = qst[fr * 4 + 1], done = qst[fr * 4 + 3];
          unsigned oz = 0u; asm volatile("" : "+v"(oz));
          const int ntm = (j >= wave ? ((j - wave) >> 3) + 1 : 0) + (int)opaque0();
#pragma unroll
          for (int i = 0; i < 32; ++i) { if (i < ntm) {
#pragma unroll
              for (int r = 0; r < 4; ++r) { const unsigned uk = okey(sk[i][r] ^ oz); const unsigned kidx = (unsigned)(16 * (wave + 8 * i) + 4 * fq + r);
                  if (uk != 0u) { const unsigned hb = uk & mask;
                      if (hb > val || (hb == val && done)) __hip_atomic_fetch_or(selb + fr * 128 + (kidx >> 5), 1u << (kidx & 31u), __ATOMIC_RELAXED, __HIP_MEMORY_SCOPE_WORKGROUP);
                      else if (hb == val) __hip_atomic_fetch_or(eqb + fr * 128 + (kidx >> 5), 1u << (kidx & 31u), __ATOMIC_RELAXED, __HIP_MEMORY_SCOPE_WORKGROUP); } } } } }
        __syncthreads();
    }
    __syncthreads();
    DSTAMP(13);
    {
        unsigned long long w[2]; unsigned pc[2], incl[2], pos[2];
#pragma unroll
        for (int qq = 0; qq < 2; ++qq) { const int q = 2 * wave + qq;
            const unsigned need = qst[q * 4 + 2], done = qst[q * 4 + 3];
            w[qq] = (unsigned long long)selb[q * 128 + lane] | ((unsigned long long)selb[q * 128 + 64 + lane] << 32);
            if (!done) { unsigned el = eqb[q * 128 + lane], eh = eqb[q * 128 + 64 + lane];
                const unsigned pl = (unsigned)__builtin_popcount(el), ph = (unsigned)__builtin_popcount(eh); unsigned il = pl, ih = ph;
#pragma unroll
                for (int o = 1; o < 64; o <<= 1) { const unsigned ul = shu(il, o, lane), uh = shu(ih, o, lane); if (lane >= o) { il += ul; ih += uh; } }
                const unsigned tot_lo = shi(il, 63);
                const unsigned bl = il - pl, bh = tot_lo + ih - ph;
                if (bl >= need) el = 0u; else if (bl + pl > need) { const unsigned keep = need - bl; while ((unsigned)__builtin_popcount(el) > keep) el &= ~(1u << (31 - __builtin_clz(el))); }
                if (bh >= need) eh = 0u; else if (bh + ph > need) { const unsigned keep = need - bh; while ((unsigned)__builtin_popcount(eh) > keep) eh &= ~(1u << (31 - __builtin_clz(eh))); }
                w[qq] |= (unsigned long long)el | ((unsigned long long)eh << 32); }
            pc[qq] = (unsigned)__builtin_popcountll(w[qq]); incl[qq] = pc[qq]; }
        incl[0] = dpp_scan_add(incl[0]); incl[1] = dpp_scan_add(incl[1]);
#pragma unroll
        for (int qq = 0; qq < 2; ++qq) { const int q = 2 * wave + qq; const unsigned nsel = nselp[q]; pos[qq] = incl[qq] - pc[qq];
#pragma unroll
            for (int i = 0; i < 4; ++i) { const unsigned p = (unsigned)(lane + 64 * i); if (p >= nsel) list[q * 256 + p] = 0; } }
        while (w[0] | w[1]) {
#pragma unroll
            for (int qq = 0; qq < 2; ++qq) { if (w[qq]) { const int bit = __builtin_ctzll(w[qq]); w[qq] &= w[qq] - 1ull;
                if (pos[qq] < 256u) list[(2 * wave + qq) * 256 + pos[qq]] = (unsigned short)(32 * lane + (bit & 31) + ((bit >> 5) << 11)); ++pos[qq]; } } }
    }
    __syncthreads();

    DSTAMP(14);
    const f16* __restrict__ KV = (const f16*)(ws + WS_KV); const f16* __restrict__ QC = (const f16*)(ws + WS_QC);
    LAS unsigned char* stg = lds + DL_HIST + wave * DL_STAGE_W;
    const unsigned tr_addr = (unsigned)(uintptr_t)stg + (unsigned)((4 * fq + ((lane & 15) >> 2)) * DL_RS + (lane & 3) * 8);
    int growv[9], gc16[9];
#pragma unroll
    for (int i = 0; i < 9; ++i) { const int c = lane + 64 * i; growv[i] = (c * 3641) >> 16; gc16[i] = c - 18 * growv[i]; }
    for (int qq = 0; qq < 2; ++qq) { const int q = 2 * wave + qq; const size_t tok = tokb + t0 + q; const int nsel = (int)nselp[q];
        f16x8 qc[4]; f16x4 qr;
#pragma unroll
        for (int ks = 0; ks < 4; ++ks) { if (fr < 8) qc[ks] = *(const f16x8*)(QC + (tok * 8 + fr) * 160 + 32 * ks + 8 * fq); else {
#pragma unroll
            for (int e = 0; e < 8; ++e) qc[ks][e] = (f16)0.f; } }
        if (fr < 8) qr = *(const f16x4*)(QC + (tok * 8 + fr) * 160 + 128 + 4 * fq); else { qr[0] = (f16)0.f; qr[1] = (f16)0.f; qr[2] = (f16)0.f; qr[3] = (f16)0.f; }
        f32x4 acc[8];
#pragma unroll
        for (int c = 0; c < 8; ++c) acc[c] = (f32x4){0.f, 0.f, 0.f, 0.f};
        float m_run = -INFINITY, l_run = 0.f;
        u32x4 rw[9];
#define DG_LOAD(PIDX) do { const int pn_ = (PIDX) < 8 ? (PIDX) : 7; \
            _Pragma("unroll") for (int i = 0; i < 9; ++i) { const int idx_ = list[q * 256 + 32 * pn_ + growv[i]]; rw[i] = *(const u32x4*)(KV + (tokb + idx_) * 160 + gc16[i] * 8); } } while (0)
        DG_LOAD(0);
        const int npair = (nsel + 31) >> 5;
        for (int pp = 0; pp < npair; ++pp) {
#pragma unroll
            for (int i = 0; i < 9; ++i) *(LAS u32x4*)(stg + growv[i] * DL_RS + gc16[i] * 16) = rw[i];
            DG_LOAD(pp + 1);
            f16x8 fa[4], fb[4]; f16x4 fra, frb;
#pragma unroll
            for (int ks = 0; ks < 4; ++ks) { fa[ks] = *(const LAS f16x8*)(stg + fr * DL_RS + (32 * ks + 8 * fq) * 2); fb[ks] = *(const LAS f16x8*)(stg + (16 + fr) * DL_RS + (32 * ks + 8 * fq) * 2); }
            fra = *(const LAS f16x4*)(stg + fr * DL_RS + (128 + 4 * fq) * 2); frb = *(const LAS f16x4*)(stg + (16 + fr) * DL_RS + (128 + 4 * fq) * 2);
            f32x4 c0 = (f32x4){0.f, 0.f, 0.f, 0.f}, c1 = (f32x4){0.f, 0.f, 0.f, 0.f};
#pragma unroll
            for (int ks = 0; ks < 4; ++ks) { c0 = __builtin_amdgcn_mfma_f32_16x16x32_f16(fa[ks], qc[ks], c0, 0, 0, 0); c1 = __builtin_amdgcn_mfma_f32_16x16x32_f16(fb[ks], qc[ks], c1, 0, 0, 0); }
            c0 = __builtin_amdgcn_mfma_f32_16x16x16f16(fra, qr, c0, 0, 0, 0); c1 = __builtin_amdgcn_mfma_f32_16x16x16f16(frb, qr, c1, 0, 0, 0);
            float mx = -INFINITY;
#pragma unroll
            for (int r = 0; r < 4; ++r) { if (32 * pp + 4 * fq + r >= nsel) c0[r] = -INFINITY; if (32 * pp + 16 + 4 * fq + r >= nsel) c1[r] = -INFINITY; mx = fmaxf(mx, fmaxf(c0[r], c1[r])); }
            if (__any(mx > m_run + 4.0f)) {
                mx = fmaxf(mx, shx(mx, 16, lane)); mx = fmaxf(mx, shx(mx, 32, lane));
                const float mn = fmaxf(m_run, mx); const float scale = __expf(m_run - mn); l_run *= scale; m_run = mn;
#pragma unroll
                for (int c = 0; c < 8; ++c) acc[c] *= scale; }
            f16x8 pf;
#pragma unroll
            for (int r = 0; r < 4; ++r) { const float p0 = __expf(c0[r] - m_run), p1 = __expf(c1[r] - m_run); l_run += p0 + p1; pf[r] = (f16)p0; pf[4 + r] = (f16)p1; }
            u32x2 t0_[8], t1_[8];
            asm volatile("s_waitcnt lgkmcnt(0)\n\t"
                "ds_read_b64_tr_b16 %0, %16 offset:0\n\t"    "ds_read_b64_tr_b16 %1, %16 offset:32\n\t"   "ds_read_b64_tr_b16 %2, %16 offset:64\n\t"   "ds_read_b64_tr_b16 %3, %16 offset:96\n\t"
                "ds_read_b64_tr_b16 %4, %16 offset:128\n\t"  "ds_read_b64_tr_b16 %5, %16 offset:160\n\t"  "ds_read_b64_tr_b16 %6, %16 offset:192\n\t"  "ds_read_b64_tr_b16 %7, %16 offset:224\n\t"
                "ds_read_b64_tr_b16 %8, %16 offset:4864\n\t" "ds_read_b64_tr_b16 %9, %16 offset:4896\n\t" "ds_read_b64_tr_b16 %10, %16 offset:4928\n\t" "ds_read_b64_tr_b16 %11, %16 offset:4960\n\t"
                "ds_read_b64_tr_b16 %12, %16 offset:4992\n\t" "ds_read_b64_tr_b16 %13, %16 offset:5024\n\t" "ds_read_b64_tr_b16 %14, %16 offset:5056\n\t" "ds_read_b64_tr_b16 %15, %16 offset:5088\n\t"
                "s_waitcnt lgkmcnt(0)"
                : "=&v"(t0_[0]), "=&v"(t0_[1]), "=&v"(t0_[2]), "=&v"(t0_[3]), "=&v"(t0_[4]), "=&v"(t0_[5]), "=&v"(t0_[6]), "=&v"(t0_[7]),
                  "=&v"(t1_[0]), "=&v"(t1_[1]), "=&v"(t1_[2]), "=&v"(t1_[3]), "=&v"(t1_[4]), "=&v"(t1_[5]), "=&v"(t1_[6]), "=&v"(t1_[7])
                : "v"(tr_addr) : "memory");
#pragma unroll
            for (int c = 0; c < 8; ++c) { u32x4 av; av.x = t0_[c].x; av.y = t0_[c].y; av.z = t1_[c].x; av.w = t1_[c].y;
                acc[c] = __builtin_amdgcn_mfma_f32_16x16x32_f16(__builtin_bit_cast(f16x8, av), pf, acc[c], 0, 0, 0); }
            asm volatile("s_waitcnt lgkmcnt(0)" ::: "memory");
        }
#undef DG_LOAD
        l_run += shx(l_run, 16, lane); l_run += shx(l_run, 32, lane);
        const float inv = 1.0f / l_run;
        if (fr < 8) {
#pragma unroll
            for (int c = 0; c < 8; ++c) { f16x4 o; o[0] = (f16)(acc[c][0] * inv); o[1] = (f16)(acc[c][1] * inv); o[2] = (f16)(acc[c][2] * inv); o[3] = (f16)(acc[c][3] * inv);
                *(LAS f16x4*)(lds + DL_OL + ((q * 8 + fr) * 128 + 16 * c + 4 * fq) * 2) = o; } }
    }
    { const int h = wave; const f16* __restrict__ Wv = (const f16*)(ws + WS_WUV) + ((size_t)(l * 8 + h) * 64) * 128;
      const f16* __restrict__ P16 = (const f16*)(ws + WS_P16); f16* __restrict__ Y3 = (f16*)(ws + WS_Y3);
      f16x8 af[4], bf[4][4]; f16x4 zg[4];
#pragma unroll
      for (int n = 0; n < 4; ++n)
#pragma unroll
          for (int ks = 0; ks < 4; ++ks) bf[n][ks] = *(const f16x8*)(Wv + (size_t)(16 * n + fr) * 128 + 32 * ks + 8 * fq);
#pragma unroll
      for (int n = 0; n < 4; ++n) zg[n] = *(const f16x4*)(P16 + (tokb + t0 + fr) * NA + C_DZ + h * 64 + 16 * n + 4 * fq);
      __syncthreads();
      DSTAMP(15);
#pragma unroll
      for (int ks = 0; ks < 4; ++ks) af[ks] = *(const LAS f16x8*)(lds + DL_OL + ((fr * 8 + h) * 128 + 32 * ks + 8 * fq) * 2);
#pragma unroll
      for (int n = 0; n < 4; ++n) { f32x4 c = (f32x4){0.f, 0.f, 0.f, 0.f};
#pragma unroll
          for (int ks = 0; ks < 4; ++ks) c = __builtin_amdgcn_mfma_f32_16x16x32_f16(bf[n][ks], af[ks], c, 0, 0, 0);
          f16x4 y;
#pragma unroll
          for (int r = 0; r < 4; ++r) y[r] = (f16)(c[r] * siluf_((float)zg[n][r]));
          *(f16x4*)(Y3 + (tokb + t0 + fr) * 1536 + h * 64 + 16 * n + 4 * fq) = y; } }
    __syncthreads();
    DSTAMP(24);
}

__device__ __forceinline__ void transpose_slab(LAS unsigned char* lds, const f16* __restrict__ P16, int coff, int b, int s0, f16* __restrict__ dstT, int wv) {
    constexpr int RS = 1040;
    int tid = TIDX(wv); asm volatile("" : "+v"(tid));
#pragma unroll
    for (int i = 0; i < 8; ++i) { const int id = tid + 512 * i, row = id >> 6, cc = id & 63;
        *(LAS u32x4*)(lds + row * RS + ((cc ^ ((row >> 3) & 7)) * 16)) = *(const u32x4*)(P16 + (size_t)(b * SEQ + s0 + row) * NA + coff + cc * 8); }
    __syncthreads();
    const int wave = tid >> 6, lane = tid & 63, es = lane >> 3, j = lane & 7;
#pragma unroll
    for (int it = 0; it < 8; ++it) { const int g = it * 8 + wave, e = 8 * g + es; f16x8 v;
#pragma unroll
        for (int jj = 0; jj < 8; ++jj) v[jj] = *(const LAS f16*)(lds + (8 * j + jj) * RS + ((g ^ j) * 16) + es * 2);
        *(f16x8*)(dstT + ((size_t)(b * 512 + e)) * SEQ + s0 + 8 * j) = v; }
    __syncthreads();
}

__device__ __forceinline__ void final_norm(const Args& a) {
    const int G = gridDim.x, bid = blockIdx.x; int tid = TIDX(a.wv); asm volatile("" : "+v"(tid)); const int wave = tid >> 6, lane = tid & 63;
    unsigned char* ws = a.ws; LAUNDER_S(ws);
    const f16* X = (const f16*)(ws + WS_X16); const float* ss = (const float*)(ws + WS_SS);
    for (int row = bid * 8 + wave; row < MTOK; row += G * 8) {
        const float rs = pg8::row_rstd(ss, row);
#pragma unroll
        for (int i = 0; i < 2; ++i) { const int c = i * 512 + lane * 8; const f16x8 v = *(const f16x8*)(X + (size_t)row * DM + c); const f32x4 w0 = *(const f32x4*)(a.fnorm_w + c), w1 = *(const f32x4*)(a.fnorm_w + c + 4);
            f32x4 o0, o1;
#pragma unroll
            for (int j = 0; j < 4; ++j) { o0[j] = (float)v[j] * rs * w0[j]; o1[j] = (float)v[4 + j] * rs * w1[j]; }
            *(f32x4*)(a.out + (size_t)row * DM + c) = o0; *(f32x4*)(a.out + (size_t)row * DM + c + 4) = o1; }
    }
}

__device__ __forceinline__ void zero_y3(const Args& a) {
    unsigned char* ws = a.ws; LAUNDER_S(ws);
    u32x4* p = (u32x4*)(ws + WS_Y3); const size_t n = (size_t)MTOK * 1536 * 2 / 16;
    for (size_t i = (size_t)blockIdx.x * NTHREADS + threadIdx.x; i < n; i += (size_t)gridDim.x * NTHREADS) p[i] = (u32x4){0u, 0u, 0u, 0u};
}

#ifndef PH_P0
#define PH_P0 1
#endif
#ifndef PH_A
#define PH_A 1
#endif
#ifndef PH_B
#define PH_B 1
#endif
#ifndef PH_C
#define PH_C 1
#endif
#ifndef PH_A2
#define PH_A2 1
#endif
#ifndef PH_D
#define PH_D 1
#endif
#ifndef PH_E
#define PH_E 1
#endif
__global__ void __launch_bounds__(NTHREADS, 2) fwd(Args a_in) {
    Args a = a_in; a.wv = __builtin_amdgcn_readfirstlane((int)threadIdx.x >> 6);
    extern __shared__ __attribute__((aligned(16))) unsigned char lds_raw[];
    LAS unsigned char* lds = (LAS unsigned char*)lds_raw;
    const int G = gridDim.x, bid = blockIdx.x;
#define tid TIDX(a.wv)
    if (tid < 4) ((LAS unsigned*)(lds + LDS_BYTES - 16))[tid] = 0u;
    __syncthreads();
    unsigned char* ws = a.ws;
    XcdBarrier bar = xcd_barrier_post((unsigned*)(ws + WS_CTL), (volatile LAS unsigned*)(lds + LDS_BYTES - 16), a.wv);
#ifdef TIMING
    LAS unsigned long long* tsum = (LAS unsigned long long*)(lds + LDS_BYTES - 512);
    if (tid == 0) { for (int i = 0; i < 32; ++i) tsum[i] = 0ull; tsum[16] = wall_clock64(); tsum[17] = tsum[16]; tsum[31] = __builtin_amdgcn_s_memtime(); }
#define STAMP(k) do { if (bid == 0 && TIDX(a.wv) == 0) { const unsigned long long t_ = wall_clock64(); tsum[k] += t_ - tsum[16]; tsum[16] = t_; } } while (0)
    unsigned long long* tsg = (unsigned long long*)(ws + WS_END);
    int bari = 0;
#define GBAR() do { if (TIDX(a.wv) == 0) __hip_atomic_store(tsg + bari * 256 + bid, (unsigned long long)wall_clock64(), __ATOMIC_RELAXED, __HIP_MEMORY_SCOPE_AGENT); xcd_barrier(bar); if (TIDX(a.wv) == 0 && bid == 0) tsg[40 * 256 + bari] = (unsigned long long)wall_clock64(); ++bari; } while (0)
#define WBAR() do { if (TIDX(a.wv) == 0) __hip_atomic_store(tsg + bari * 256 + bid, (unsigned long long)wall_clock64(), __ATOMIC_RELAXED, __HIP_MEMORY_SCOPE_AGENT); xcd_barrier(bar, false); if (TIDX(a.wv) == 0 && bid == 0) tsg[40 * 256 + bari] = (unsigned long long)wall_clock64(); ++bari; } while (0)
#else
#define STAMP(k) do {} while (0)
#define GBAR() xcd_barrier(bar)
#define WBAR() xcd_barrier(bar, false)
#endif

#if PH_P0
    p0_prologue(a, lds);
#endif
    GBAR();
    STAMP(0);

    for (int l = 0; l < DEPTH; ++l) {
        LAUNDER_S(ws);
        f16* P16 = (f16*)(ws + WS_P16); f16* X16 = (f16*)(ws + WS_X16); float* SS = (float*)(ws + WS_SS);
        f16* Y3 = (f16*)(ws + WS_Y3);
        const f16* WinT = (const f16*)(ws + WS_WINT) + (size_t)l * 9216 * 1024;
#if PH_A
        { pg8::Gemm g{X16, WinT, MTOK, NA, DM, DM, DM}; pg8::StaticOrder S; S.init(MTOK, NA, G, bid);
          pg8::rs_tables((LAS float*)(lds + pg8::STAGE_BYTES), SS, S, a.wv);
          pg8::EpiScaleF16 E{P16, NA, (const LAS float*)(lds + pg8::STAGE_BYTES)}; pg8::gemm_phase(lds, g, S, E, a.wv); }
        WBAR();
        STAMP(1);
#endif
#if PH_B
        for (int u = bid; u < MTOK / 64; u += G) phase_b_unit(a, lds, l, u >> 6, u & 63);
        GBAR();
        STAMP(2);
#endif
#if PH_C
        mlstm_scan(a, lds);
        STAMP(3);
        { unsigned* qctr = (unsigned*)(ws + WS_CTL) + 12288 + 64 * l;
          volatile LAS unsigned* qslot = (volatile LAS unsigned*)(lds + LDS_BYTES - 32);
          for (;;) {
              if (TIDX(a.wv) == 0) qslot[0] = __hip_atomic_fetch_add(qctr, 1u, __ATOMIC_RELAXED, __HIP_MEMORY_SCOPE_AGENT);
              __syncthreads();
              const unsigned uq = qslot[0];
              __syncthreads();
              if (uq >= 1024u + 512u) break;
              if (uq < 1024u) dsa_unit(a, lds, l, (int)(uq & 3u), 255 - (int)(uq >> 2));
              else {
                  const int i_ = (int)(uq - 1024u); const int qt = (15 - (i_ >> 5)) * 8 + a.wv, h = i_ & 7, b = (i_ >> 3) & 3; int t_ = lane_id_(); asm volatile("" : "+v"(t_));
                  sb_attn_unit(P16, (const f16*)(ws + WS_VT), Y3, b, h, qt, t_ & 63); }
          } }
        STAMP(4);
        STAMP(5);
        GBAR();
        STAMP(6);
        { const int wave_ = a.wv;
          for (int u = bid * 8 + wave_; u < 2048; u += G * 8) { int t_ = lane_id_(); asm volatile("" : "+v"(t_));
              mlstm_out_unit(a, lds + wave_ * 1024, lds + 8192 + wave_ * 8704, l, u >> 9, (u >> 3) & 63, (u >> 1) & 3, u & 1, t_ & 63); } }
        GBAR();
        STAMP(7);
#endif
#if PH_A2
        { pg8::Gemm g{X16, WinT + (size_t)NA * DM, MTOK, NG, DM, DM, DM}; pg8::StaticOrder S; S.init(MTOK, NG, G, bid);
          pg8::rs_tables((LAS float*)(lds + pg8::STAGE_BYTES), SS, S, a.wv);
          pg8::EpiScaleF16T<true> E{(f16*)(ws + WS_G16), NG, (const LAS float*)(lds + pg8::STAGE_BYTES)}; pg8::gemm_phase(lds, g, S, E, a.wv); }
        WBAR();
        STAMP(8);
#endif
#if PH_D
        { pg8::Gemm g{Y3, (const f16*)(ws + WS_WBRT) + (size_t)l * 1024 * 1536, MTOK, DM, 1536, 1536, 1536}; pg8::StaticOrder S; S.init(MTOK, DM, G, bid);
          pg8::EpiMerge E{(const f16*)(ws + WS_G16), (f16*)(ws + WS_MIX16)}; pg8::gemm_phase<pg8::EpiMerge, true>(lds, g, S, E, a.wv); }
        GBAR();
        STAMP(9);
#endif
#if PH_E
        { pg8::Gemm g{(const f16*)(ws + WS_MIX16), (const f16*)(ws + WS_WOUTT) + (size_t)l * DM * DM, MTOK, DM, DM, DM, DM}; pg8::StaticOrder S; S.init(MTOK, DM, G, bid);
          pg8::EpiResid E{X16, SS}; pg8::gemm_phase(lds, g, S, E, a.wv); }
        GBAR();
        STAMP(10);
#endif
    }
    final_norm(a);
#undef tid
#ifdef TIMING
    const int tid = TIDX(a.wv);
    STAMP(11);
    if (bid == 0) {
        LAS unsigned long long* mxx = (LAS unsigned long long*)lds;
        LAS unsigned long long* arr = mxx + 512;
        __syncthreads();
        for (int p = 0; p < bari; ++p) {
            if (tid < 256) arr[tid] = __hip_atomic_load(tsg + p * 256 + tid, __ATOMIC_RELAXED, __HIP_MEMORY_SCOPE_AGENT);
            __syncthreads();
            if (tid < 8) { unsigned long long m = 0ull; for (int k = tid; k < 256; k += 8) m = arr[k] > m ? arr[k] : m; mxx[p * 8 + tid] = m; }
            __syncthreads();
        }
        LAS unsigned long long* mean = arr + 300;
        for (int p = 0; p < bari; ++p) {
            if (tid < 256) arr[tid] = __hip_atomic_load(tsg + p * 256 + tid, __ATOMIC_RELAXED, __HIP_MEMORY_SCOPE_AGENT);
            __syncthreads();
            if (tid == 0) { long long sm = 0; for (int k = 0; k < 256; ++k) sm += (long long)(arr[k] - arr[0]); mean[p] = (unsigned long long)((long long)arr[0] + sm / 256); }
            __syncthreads();
        }
        if (tid == 0) {
            long long n1 = 0, n2 = 0;
            for (int p = 1; p < bari; ++p) { const int ph = (p - 1) % 7;
                if (!(SKEW_SEL & (1 << ph))) continue;
                unsigned long long rel = 0ull, sx = 0ull; for (int x = 0; x < 8; ++x) { rel = mxx[p * 8 + x] > rel ? mxx[p * 8 + x] : rel; }
                for (int x = 0; x < 8; ++x) sx += rel - mxx[p * 8 + x];
                n1 += (long long)(rel - mean[p]); n2 += (long long)(tsg[40 * 256 + p] - rel); }
#ifdef SKEW_REPORT
            tsum[24] = (unsigned long long)n1; tsum[18] = (unsigned long long)n2;
#endif
        }
        __syncthreads();
    }
    { unsigned* slot = (unsigned*)(ws + WS_CTL) + 8192;
      if (bid == 0 && tid == 0) { tsum[30] = (__builtin_amdgcn_s_memtime() - tsum[31]) * 1000ull / (tsum[16] - tsum[17]); tsum[16] -= tsum[17]; __hip_atomic_store(slot, (unsigned)(tsum[TIMING_A] / 100ull), __ATOMIC_RELAXED, __HIP_MEMORY_SCOPE_AGENT); __hip_atomic_store(slot + 1, (unsigned)(tsum[TIMING_B] / 100ull), __ATOMIC_RELAXED, __HIP_MEMORY_SCOPE_AGENT); }
      xcd_barrier(bar);
      const float ta = (float)__hip_atomic_load(slot, __ATOMIC_RELAXED, __HIP_MEMORY_SCOPE_AGENT) * (1.0f / 16.0f), tb = 1e-3f * sqrtf((float)__hip_atomic_load(slot + 1, __ATOMIC_RELAXED, __HIP_MEMORY_SCOPE_AGENT));
      for (size_t i = (size_t)bid * NTHREADS + tid; i < (size_t)MTOK * DM; i += (size_t)G * NTHREADS) a.out[i] = i == 0 ? ta : a.out[i] + ((i & 1) ? tb : -tb); }
#endif
}

__global__ void fill_kernel(float* out, int n, float v) { for (int i = blockIdx.x * blockDim.x + threadIdx.x; i < n; i += gridDim.x * blockDim.x) out[i] = (i & 1) ? v : -v; }

extern "C" void kernel_launch(void* const* d_in, const int* in_sizes, int n_in, void* d_out, int out_size, void* d_ws, size_t ws_size, hipStream_t stream) {
    static int grid = 0;
    if (grid == 0) {
        int dev = 0, cus = 0;
        if (hipGetDevice(&dev) != hipSuccess || hipDeviceGetAttribute(&cus, hipDeviceAttributeMultiprocessorCount, dev) != hipSuccess) { grid = -1; }
        else if (hipFuncSetAttribute((const void*)fwd, hipFuncAttributeMaxDynamicSharedMemorySize, LDS_BYTES) != hipSuccess) { grid = -2; }
        else grid = cus;
        (void)hipGetLastError();
    }
    if (ws_size < WS_END || n_in != 13 || grid < 128) {
        hipLaunchKernelGGL(fill_kernel, dim3(256), dim3(256), 0, stream, (float*)d_out, out_size, ws_size < WS_END ? 100.f : 30.f);
        return;
    }
    (void)hipMemsetAsync((char*)d_ws + WS_CTL, 0, CTL_BYTES, stream);
    Args a{};
    a.x = (const float*)d_in[0]; a.w_in = (const float*)d_in[1]; a.w_uk = (const float*)d_in[2]; a.w_uv = (const float*)d_in[3]; a.kvn_w = (const float*)d_in[4];
    a.conv_w = (const float*)d_in[5]; a.i_bias = (const float*)d_in[6]; a.f_bias = (const float*)d_in[7]; a.mln_w = (const float*)d_in[8]; a.w_branch = (const float*)d_in[9];
    a.w_out = (const float*)d_in[10]; a.norm_w = (const float*)d_in[11]; a.fnorm_w = (const float*)d_in[12];
    a.out = (float*)d_out; a.ws = (unsigned char*)d_ws;
    hipLaunchKernelGGL(fwd, dim3(grid), dim3(NTHREADS), LDS_BYTES, stream, a);
}
```
